# Optimizing an MI355X kernel written in HIP

```python
import jax, jax.numpy as jnp
from jax import lax
import numpy as np

D_MODEL = 1024
BATCH = 2
SEQ = 8192
DEPTH = 2

HEAD_DIM = 64
ROT_DIM = HEAD_DIM // 4
ROPE_THETA = 500000.0
RMS_EPS = 1e-6
Q_BLOCK = 128
MACARON_WEIGHT = 0.5
D_FF = 2816

A_HEADS = 8
A_KV_RANK = 128
IDX_HEADS = 8
IDX_DIM = 64
TOPK_MAX = 256

B_GROUPS = ((128, 1), (512, 4), (2048, 16))
B_HEADS_PER_GROUP = 4
B_HEADS = B_HEADS_PER_GROUP * len(B_GROUPS)

C_HEADS = 4
C_HEAD_K = 64
C_HEAD_V = 128
C_ALPHA_RANK = 16
C_GATE_TAU = 16.0
C_CHUNK = 64

N_BRANCH = 3
IN_SIZES = (A_HEADS * HEAD_DIM, A_KV_RANK, IDX_HEADS * IDX_DIM, IDX_DIM, IDX_HEADS,
            3 * B_HEADS * HEAD_DIM,
            C_HEADS * C_HEAD_K, C_HEADS * C_HEAD_K, C_HEADS * C_HEAD_V, C_HEADS * C_HEAD_V,
            C_ALPHA_RANK)
D_IN = sum(IN_SIZES)

kernel_name = 'hybrid_dsa_dilated_gla_macaron'


def rms_norm(x, g):
    xf = x.astype(jnp.float32)
    y = xf * lax.rsqrt(jnp.mean(xf * xf, axis=-1, keepdims=True) + RMS_EPS)
    return (y * g.astype(jnp.float32)).astype(x.dtype)


def swiglu(x, w_in, w_out):
    gate, up = jnp.split(x @ w_in, 2, axis=-1)
    return (jax.nn.silu(gate) * up) @ w_out


def rope_tables(positions, rot_dim):
    inv_freq = ROPE_THETA ** (-jnp.arange(0, rot_dim, 2, dtype=jnp.float32) / rot_dim)
    ang = positions.astype(jnp.float32)[..., None] * inv_freq
    return jnp.cos(ang), jnp.sin(ang)


def partial_rope(x, cos, sin):
    half = cos.shape[-1]
    c = cos[:, :, None, :]
    s = sin[:, :, None, :]
    x1 = x[..., :half].astype(jnp.float32)
    x2 = x[..., half:2 * half].astype(jnp.float32)
    rot = jnp.concatenate([x1 * c - x2 * s, x2 * c + x1 * s], axis=-1).astype(x.dtype)
    return jnp.concatenate([rot, x[..., 2 * half:]], axis=-1)


def to_blocks(a):
    b, s = a.shape[:2]
    a = a.reshape((b, s // Q_BLOCK, Q_BLOCK) + a.shape[2:])
    return jnp.moveaxis(a, 1, 0)


def from_blocks(a):
    a = jnp.moveaxis(a, 0, 1)
    return a.reshape((a.shape[0], a.shape[1] * a.shape[2]) + a.shape[3:])


def dsa_attention(q, k, v, q_idx, k_idx, w_idx, top_k):
    seq = q.shape[1]
    key_pos = jnp.arange(seq, dtype=jnp.int32)
    k_idx_f = k_idx.astype(jnp.float32)
    scale = HEAD_DIM ** -0.5
    idx_scale = IDX_DIM ** -0.5
    head_w_scale = IDX_HEADS ** -0.5

    def block(args):
        qb, qib, wb, tb = args
        logits = jnp.einsum('bqhd,bsd->bqhs', qib.astype(jnp.float32), k_idx_f) * idx_scale
        score = jnp.einsum('bqhs,bqh->bqs', jax.nn.relu(logits),
                           wb.astype(jnp.float32) * head_w_scale)
        causal = key_pos[None, :] <= tb[:, None]
        score = jnp.where(causal[None], score, -jnp.inf)
        _, sel = lax.top_k(score, top_k)
        ks = jax.vmap(lambda kk, ii: kk[ii])(k, sel)
        vs = jax.vmap(lambda vv, ii: vv[ii])(v, sel)
        s = jnp.einsum('bqhd,bqkhd->bqhk', qb.astype(jnp.float32),
                       ks.astype(jnp.float32)) * scale
        valid = sel <= tb[None, :, None]
        s = jnp.where(valid[:, :, None, :], s, -jnp.inf)
        p = jax.nn.softmax(s, axis=-1)
        return jnp.einsum('bqhk,bqkhd->bqhd', p, vs.astype(jnp.float32)).astype(qb.dtype)

    pos_blocks = key_pos.reshape(seq // Q_BLOCK, Q_BLOCK)
    out = lax.map(block, (to_blocks(q), to_blocks(q_idx), to_blocks(w_idx), pos_blocks))
    return from_blocks(out)


def dilated_attention(q, k, v):
    seq = q.shape[1]
    hpg = B_HEADS_PER_GROUP
    scale = HEAD_DIM ** -0.5
    k_groups = [k[:, :, g * hpg:(g + 1) * hpg] for g in range(len(B_GROUPS))]
    v_groups = [v[:, :, g * hpg:(g + 1) * hpg] for g in range(len(B_GROUPS))]

    def block(args):
        qb, tb = args
        outs, lses = [], []
        for g, (window, dil) in enumerate(B_GROUPS):
            n_keys = window // dil + 1
            idx = tb[:, None] - dil * jnp.arange(n_keys, dtype=jnp.int32)[None, :]
            valid = idx >= 0
            idx_c = jnp.maximum(idx, 0)
            kg = jnp.take(k_groups[g], idx_c, axis=1).astype(jnp.float32)
            vg = jnp.take(v_groups[g], idx_c, axis=1).astype(jnp.float32)
            qg = qb[:, :, g * hpg:(g + 1) * hpg].astype(jnp.float32)
            s = jnp.einsum('bqhd,bqjhd->bqhj', qg, kg) * scale
            s = jnp.where(valid[None, :, None, :], s, -jnp.inf)
            lse = jax.nn.logsumexp(s, axis=-1)
            p = jnp.exp(s - lse[..., None])
            outs.append(jnp.einsum('bqhj,bqjhd->bqhd', p, vg))
            lses.append(lse)
        wgt = jax.nn.softmax(jnp.stack(lses, axis=0), axis=0)
        o = jnp.sum(wgt[..., None] * jnp.stack(outs, axis=0), axis=0)
        return o.astype(qb.dtype)

    pos_blocks = jnp.arange(seq, dtype=jnp.int32).reshape(seq // Q_BLOCK, Q_BLOCK)
    return from_blocks(lax.map(block, (to_blocks(q), pos_blocks)))


def gla_chunked(q, k, v, log_alpha):
    bsz, seq, nh, dk = q.shape
    dv = v.shape[-1]
    csz = min(C_CHUNK, seq)
    nc = seq // csz
    f32 = jnp.float32
    q = q.astype(f32).reshape(bsz, nc, csz, nh, dk) * dk ** -0.5
    k = k.astype(f32).reshape(bsz, nc, csz, nh, dk)
    v = v.astype(f32).reshape(bsz, nc, csz, nh, dv)
    b = jnp.cumsum(log_alpha.astype(f32).reshape(bsz, nc, csz, nh, dk), axis=2)
    b_last = b[:, :, -1]
    q_dec = q * jnp.exp(b)
    k_dec = k * jnp.exp(-b)
    attn = jnp.einsum('bnthd,bnshd->bnhts', q_dec, k_dec)
    attn = jnp.where(jnp.tril(jnp.ones((csz, csz), dtype=bool)), attn, 0.0)
    o_intra = jnp.einsum('bnhts,bnshv->bnthv', attn, v)
    k_to_end = k * jnp.exp(b_last[:, :, None] - b)
    kv = jnp.einsum('bnshk,bnshv->bnhkv', k_to_end, v)
    decay = jnp.exp(b_last)

    def step(state, inp):
        kv_n, dec_n = inp
        return dec_n[..., None] * state + kv_n, state

    init = jnp.zeros((bsz, nh, dk, dv), f32)
    _, s_prev = lax.scan(step, init, (jnp.moveaxis(kv, 1, 0), jnp.moveaxis(decay, 1, 0)))
    s_prev = jnp.moveaxis(s_prev, 0, 1)
    o_inter = jnp.einsum('bnthk,bnhkv->bnthv', q_dec, s_prev)
    return (o_intra + o_inter).reshape(bsz, seq, nh, dv)


def hybrid_mixer(u, cos, sin, top_k, w_in, a_kv_norm_g, a_w_kv_up, c_w_alpha_up, c_b_alpha,
                 c_norm_g, w_branch_a, w_branch_b, w_branch_c, w_gate, b_gate, w_out):
    bsz, seq, d = u.shape
    split_points = np.cumsum(IN_SIZES)[:-1].tolist()
    (a_q, a_ckv, i_q, i_k, i_w, b_qkv, c_q, c_k, c_v, c_g, c_a) = jnp.split(
        u @ w_in, split_points, axis=-1)

    q_a = partial_rope(a_q.reshape(bsz, seq, A_HEADS, HEAD_DIM), cos, sin)
    kv_a = (rms_norm(a_ckv, a_kv_norm_g) @ a_w_kv_up).reshape(bsz, seq, A_HEADS, 2, HEAD_DIM)
    k_a = partial_rope(kv_a[..., 0, :], cos, sin)
    v_a = kv_a[..., 1, :]
    q_i = partial_rope(i_q.reshape(bsz, seq, IDX_HEADS, IDX_DIM), cos, sin)
    k_i = partial_rope(i_k[:, :, None, :], cos, sin)[:, :, 0]
    y_a = dsa_attention(q_a, k_a, v_a, q_i, k_i, i_w, top_k).reshape(bsz, seq, A_HEADS * HEAD_DIM)

    qkv_b = b_qkv.reshape(bsz, seq, 3, B_HEADS, HEAD_DIM)
    q_b = partial_rope(qkv_b[:, :, 0], cos, sin)
    k_b = partial_rope(qkv_b[:, :, 1], cos, sin)
    y_b = dilated_attention(q_b, k_b, qkv_b[:, :, 2]).reshape(bsz, seq, B_HEADS_PER_GROUP * HEAD_DIM)

    log_alpha = jax.nn.log_sigmoid((c_a @ c_w_alpha_up + c_b_alpha).astype(jnp.float32)) / C_GATE_TAU
    o_c = gla_chunked(c_q.reshape(bsz, seq, C_HEADS, C_HEAD_K),
                      c_k.reshape(bsz, seq, C_HEADS, C_HEAD_K),
                      c_v.reshape(bsz, seq, C_HEADS, C_HEAD_V),
                      log_alpha.reshape(bsz, seq, C_HEADS, C_HEAD_K))
    o_c = rms_norm(o_c.astype(u.dtype), c_norm_g) * jax.nn.silu(c_g.reshape(bsz, seq, C_HEADS, C_HEAD_V))
    y_c = o_c.reshape(bsz, seq, C_HEADS * C_HEAD_V)

    gates = jax.nn.sigmoid(u @ w_gate + b_gate).reshape(bsz, seq, N_BRANCH, d)
    merged = (gates[:, :, 0] * (y_a @ w_branch_a)
              + gates[:, :, 1] * (y_b @ w_branch_b)
              + gates[:, :, 2] * (y_c @ w_branch_c))
    return merged @ w_out


def setup_inputs(seed: int = 0) -> dict:
    key = jax.random.key(seed)
    ks = jax.random.split(key, 24)

    def nrm(i, shape, fan_in):
        return jax.random.normal(ks[i], shape, jnp.float32) * fan_in ** -0.5

    def gain(i, n):
        return 1.0 + 0.02 * jax.random.normal(ks[i], (DEPTH, n), jnp.float32)

    x = jax.random.normal(ks[0], (BATCH, SEQ, D_MODEL), jnp.float32)
    positions = (jax.random.randint(ks[1], (BATCH, 1), 0, 4096, dtype=jnp.int32)
                 + jnp.arange(SEQ, dtype=jnp.int32)[None, :])
    return {
        'x': x,
        'positions': positions,
        'ffn1_pre_g': gain(2, D_MODEL),
        'ffn1_w_in': nrm(3, (DEPTH, D_MODEL, 2 * D_FF), D_MODEL),
        'ffn1_w_out': nrm(4, (DEPTH, D_FF, D_MODEL), D_FF),
        'ffn1_post_g': gain(5, D_MODEL),
        'mix_pre_g': gain(6, D_MODEL),
        'w_in': nrm(7, (DEPTH, D_MODEL, D_IN), D_MODEL),
        'a_kv_norm_g': gain(8, A_KV_RANK),
        'a_w_kv_up': nrm(9, (DEPTH, A_KV_RANK, 2 * A_HEADS * HEAD_DIM), A_KV_RANK),
        'c_w_alpha_up': nrm(10, (DEPTH, C_ALPHA_RANK, C_HEADS * C_HEAD_K), C_ALPHA_RANK),
        'c_b_alpha': 0.1 * jax.random.normal(ks[11], (DEPTH, C_HEADS * C_HEAD_K), jnp.float32),
        'c_norm_g': gain(12, C_HEAD_V),
        'w_branch_a': nrm(13, (DEPTH, A_HEADS * HEAD_DIM, D_MODEL), A_HEADS * HEAD_DIM),
        'w_branch_b': nrm(14, (DEPTH, B_HEADS_PER_GROUP * HEAD_DIM, D_MODEL), B_HEADS_PER_GROUP * HEAD_DIM),
        'w_branch_c': nrm(15, (DEPTH, C_HEADS * C_HEAD_V, D_MODEL), C_HEADS * C_HEAD_V),
        'w_gate': nrm(16, (DEPTH, D_MODEL, N_BRANCH * D_MODEL), D_MODEL),
        'b_gate': 0.02 * jax.random.normal(ks[17], (DEPTH, N_BRANCH * D_MODEL), jnp.float32),
        'w_out': nrm(18, (DEPTH, D_MODEL, D_MODEL), D_MODEL),
        'mix_post_g': gain(19, D_MODEL),
        'ffn2_pre_g': gain(20, D_MODEL),
        'ffn2_w_in': nrm(21, (DEPTH, D_MODEL, 2 * D_FF), D_MODEL),
        'ffn2_w_out': nrm(22, (DEPTH, D_FF, D_MODEL), D_FF),
        'ffn2_post_g': gain(23, D_MODEL),
    }


def reference(x, positions, ffn1_pre_g, ffn1_w_in, ffn1_w_out, ffn1_post_g, mix_pre_g, w_in,
              a_kv_norm_g, a_w_kv_up, c_w_alpha_up, c_b_alpha, c_norm_g, w_branch_a, w_branch_b,
              w_branch_c, w_gate, b_gate, w_out, mix_post_g, ffn2_pre_g, ffn2_w_in, ffn2_w_out,
              ffn2_post_g):
    top_k = min(TOPK_MAX, x.shape[1] // 4)
    cos, sin = rope_tables(positions, ROT_DIM)
    h = x
    for l in range(DEPTH):
        f1 = swiglu(rms_norm(h, ffn1_pre_g[l]), ffn1_w_in[l], ffn1_w_out[l])
        h = h + MACARON_WEIGHT * rms_norm(f1, ffn1_post_g[l])
        m = hybrid_mixer(rms_norm(h, mix_pre_g[l]), cos, sin, top_k, w_in[l], a_kv_norm_g[l],
                         a_w_kv_up[l], c_w_alpha_up[l], c_b_alpha[l], c_norm_g[l], w_branch_a[l],
                         w_branch_b[l], w_branch_c[l], w_gate[l], b_gate[l], w_out[l])
        h = h + rms_norm(m, mix_post_g[l])
        f2 = swiglu(rms_norm(h, ffn2_pre_g[l]), ffn2_w_in[l], ffn2_w_out[l])
        h = h + MACARON_WEIGHT * rms_norm(f2, ffn2_post_g[l])
    return h
```

```cpp
#include <hip/hip_runtime.h>
#include <cstdio>
#include <cstdint>
#define GAS __attribute__((address_space(1)))
#define LAS __attribute__((address_space(3)))
#ifndef MK_ONE_LAUNCH
#define MK_ONE_LAUNCH 0
#endif
namespace pg8 {
#define PG8_LAS __attribute__((address_space(3)))
typedef unsigned short bf16_t;
typedef short bf16x8 __attribute__((ext_vector_type(8)));
typedef float f32x4 __attribute__((ext_vector_type(4)));
typedef unsigned u32x4 __attribute__((ext_vector_type(4)));
constexpr int BM = 256, BK = 64, HALF = 128, HTB = HALF * BK * 2  , STAGE_BYTES = 8 * HTB, NXCD = 8, WGM = 8;

__host__ __device__ __forceinline__ int lds_byte(int r, int c) { const int st = (r >> 4) * 2 + (c >> 5), rr = r & 15, cc = c & 31, ob = rr * 64 + cc * 2; return st * 1024 + (ob ^ (((ob >> 9) & 1) << 5)); }
__host__ __device__ __forceinline__ void stage_rc(int b, int& R, int& C) { const int st = b / 1024, sb = b % 1024, swz = sb ^ (((sb >> 9) & 1) << 5); R = (st >> 1) * 16 + swz / 64; C = (st & 1) * 32 + (swz % 64) / 2; }
__host__ __device__ __forceinline__ int perm32(int rho) { const int n = rho >> 4, i = rho & 15; return 8 * (i >> 2) + 4 * n + (i & 3); }

struct Unit { int pm, pn; };
struct Gemm { const bf16_t* A; const bf16_t* Bt; int M, N, K; };

struct StaticOrder {
    int nM, nN, nwg, G, c;
    __host__ __device__ void init(int M, int N, int G_, int c_) { nM = M / BM; nN = N / BM; nwg = nM * nN; G = G_; c = c_; }
    __host__ __device__ bool next(int i, Unit& u) const {
        const long L = (long)i * G + c; if (L >= nwg) return false;
        int wgid = (int)L; { const int q = nwg / NXCD, r = nwg % NXCD, xcd = wgid % NXCD, off = wgid / NXCD; wgid = (xcd < r ? xcd * (q + 1) : r * (q + 1) + (xcd - r) * q) + off; }
        const int nig = WGM * nN, gid = wgid / nig, fm = gid * WGM, gsz = (nM - fm) < WGM ? (nM - fm) : WGM;
        u.pm = fm + ((wgid % nig) % gsz); u.pn = (wgid % nig) / gsz; return true;
    }
    __device__ __forceinline__ void a_ready(const Unit&) const {}
    __device__ __forceinline__ void done(const Unit&) const {}
};

typedef float f32x2_t_ __attribute__((ext_vector_type(2))); typedef __bf16 bf16x2_t_ __attribute__((ext_vector_type(2)));
__device__ __forceinline__ unsigned cvt_pk_bf16(float lo, float hi) { const f32x2_t_ v = {lo, hi}; const bf16x2_t_ b = __builtin_convertvector(v, bf16x2_t_); return __builtin_bit_cast(unsigned, b); }
typedef float f32x2 __attribute__((ext_vector_type(2)));
__device__ __forceinline__ float bflo(unsigned w) { return __uint_as_float(w << 16); }
__device__ __forceinline__ float bfhi(unsigned w) { return __uint_as_float(w & 0xffff0000u); }
__device__ __forceinline__ u32x4 pack8(const f32x4 a, const f32x4 b) { u32x4 w; w.x = cvt_pk_bf16(a[0], a[1]); w.y = cvt_pk_bf16(a[2], a[3]); w.z = cvt_pk_bf16(b[0], b[1]); w.w = cvt_pk_bf16(b[2], b[3]); return w; }
__device__ __forceinline__ float fast_sigmoid(float x) { return __builtin_amdgcn_rcpf(1.0f + __expf(-x)); }

struct EpiSwiglu {
    static constexpr bool PERM = true, AFTER_DRAIN = false;
    bf16_t* O; int ldc;
    __device__ __forceinline__ void operator()(const f32x4 (&acc)[2][2][4][2], const Unit& u, int wr, int wc, int fr, int fq) const {
        const int row0 = u.pm * BM + wr * 64 + fr, col0 = u.pn * HALF + wc * 32 + 8 * fq;
#pragma unroll
        for (int ai = 0; ai < 2; ++ai)
#pragma unroll
            for (int m = 0; m < 4; ++m) { bf16_t* rowp = O + (size_t)(row0 + ai * HALF + m * 16) * ldc + col0;
                f32x4 o0, o1;
#pragma unroll
                for (int j = 0; j < 4; ++j) { const float g0 = acc[ai][0][m][0][j], g1 = acc[ai][0][m][1][j];
                    o0[j] = g0 * fast_sigmoid(g0) * acc[ai][1][m][0][j]; o1[j] = g1 * fast_sigmoid(g1) * acc[ai][1][m][1][j]; }
                *(u32x4*)rowp = pack8(o0, o1); asm volatile("" ::: "memory"); }
    }
};
struct EpiStore {
    static constexpr bool PERM = true, AFTER_DRAIN = false;
    bf16_t* O; int ldc;
    __device__ __forceinline__ void operator()(const f32x4 (&acc)[2][2][4][2], const Unit& u, int wr, int wc, int fr, int fq) const {
        const int row0 = u.pm * BM + wr * 64 + fr, col0 = u.pn * BM + wc * 32 + 8 * fq;
#pragma unroll
        for (int ai = 0; ai < 2; ++ai)
#pragma unroll
            for (int m = 0; m < 4; ++m) { bf16_t* rowp = O + (size_t)(row0 + ai * HALF + m * 16) * ldc + col0;
#pragma unroll
                for (int bj = 0; bj < 2; ++bj) *(u32x4*)(rowp + bj * HALF) = pack8(acc[ai][bj][m][0], acc[ai][bj][m][1]); }
    }
};
enum { PM_PLAIN = 0, PM_ROPE64 = 1, PM_ROPE16 = 2, PM_SIGMOID = 3 };
template <int RANGE> __device__ __forceinline__ int proj_mode(int gcol) {
    if (RANGE == 0) return gcol < 1536 ? PM_ROPE64 : PM_PLAIN;
    if (RANGE == 1) { if (gcol < 1024) return PM_PLAIN; const int g2 = gcol - 1024;
        return g2 < 128 ? PM_ROPE16 : (g2 < 704 ? PM_ROPE64 : PM_PLAIN); }
    return PM_SIGMOID;
}
template <int RANGE> struct EpiProj {
    static constexpr bool PERM = true, AFTER_DRAIN = false;
    bf16_t* d0; int ld0; int nt0; bf16_t* d1; int ld1; const float* cs; const float* bias;
    __device__ __forceinline__ void operator()(const f32x4 (&acc)[2][2][4][2], const Unit& u, int wr, int wc, int fr, int fq) const {
        const int row0 = u.pm * BM + wr * 64 + fr;
        bf16_t* dbase; int ld;
        if (u.pn < nt0) { dbase = d0 + u.pn * BM; ld = ld0; } else { dbase = d1 + (u.pn - nt0) * BM; ld = ld1; }
#pragma unroll
        for (int bj = 0; bj < 2; ++bj) {
            const int gcol = u.pn * BM + bj * HALF + wc * 32;
            const int mode = proj_mode<RANGE>(gcol);
            const bool rope = (mode == PM_ROPE16) || (mode == PM_ROPE64 && (wc & 1) == 0);
            const bool lane_rope = (mode == PM_ROPE16) || (fq < 2);
            f32x4 b0 = (f32x4){0.f, 0.f, 0.f, 0.f}, b1 = b0;
#ifndef MK_NOBIAS
            if (mode == PM_SIGMOID) { b0 = *(const f32x4*)(bias + gcol + 8 * fq); b1 = *(const f32x4*)(bias + gcol + 8 * fq + 4); }
#endif
#pragma unroll
            for (int ai = 0; ai < 2; ++ai)
#pragma unroll
                for (int m = 0; m < 4; ++m) {
                    const int r = row0 + ai * HALF + m * 16;
                    f32x4 v0 = acc[ai][bj][m][0], v1 = acc[ai][bj][m][1];
                    if (rope) {
                        const f32x4 c0 = *(const f32x4*)(cs + (size_t)r * 16), c1 = *(const f32x4*)(cs + (size_t)r * 16 + 4), s0 = *(const f32x4*)(cs + (size_t)r * 16 + 8), s1 = *(const f32x4*)(cs + (size_t)r * 16 + 12);
                        f32x4 p0, p1;
#pragma unroll
                        for (int j = 0; j < 4; ++j) { p0[j] = __shfl_xor(v0[j], 16); p1[j] = __shfl_xor(v1[j], 16); }
                        const float sg = (fq & 1) ? 1.0f : -1.0f;
                        if (lane_rope) { v0 = v0 * c0 + sg * (p0 * s0); v1 = v1 * c1 + sg * (p1 * s1); }
                    }
                    if (mode == PM_SIGMOID) {
#pragma unroll
                        for (int j = 0; j < 4; ++j) { v0[j] = fast_sigmoid(v0[j] + b0[j]); v1[j] = fast_sigmoid(v1[j] + b1[j]); }
                    }
                    *(u32x4*)(dbase + (size_t)r * ld + bj * HALF + wc * 32 + 8 * fq) = pack8(v0, v1);
                    asm volatile("" ::: "memory");
                }
        }
    }
};
template <bool FIRST> struct EpiMerge {
    static constexpr bool PERM = true, AFTER_DRAIN = false;
    bf16_t* O; int ldc; const bf16_t* G; int ldg; int gcol;
    __device__ __forceinline__ void operator()(const f32x4 (&acc)[2][2][4][2], const Unit& u, int wr, int wc, int fr, int fq) const {
        const int row0 = u.pm * BM + wr * 64 + fr, col0 = u.pn * BM + wc * 32 + 8 * fq;
#pragma unroll
        for (int ai = 0; ai < 2; ++ai)
#pragma unroll
            for (int m = 0; m < 4; ++m) { const int r = row0 + ai * HALF + m * 16;
#pragma unroll
                for (int bj = 0; bj < 2; ++bj) {
                    const u32x4 g = *(const u32x4*)(G + (size_t)r * ldg + gcol + col0 + bj * HALF);
                    f32x4 o0, o1;
                    o0[0] = bflo(g.x) * acc[ai][bj][m][0][0]; o0[1] = bfhi(g.x) * acc[ai][bj][m][0][1]; o0[2] = bflo(g.y) * acc[ai][bj][m][0][2]; o0[3] = bfhi(g.y) * acc[ai][bj][m][0][3];
                    o1[0] = bflo(g.z) * acc[ai][bj][m][1][0]; o1[1] = bfhi(g.z) * acc[ai][bj][m][1][1]; o1[2] = bflo(g.w) * acc[ai][bj][m][1][2]; o1[3] = bfhi(g.w) * acc[ai][bj][m][1][3];
                    bf16_t* op = O + (size_t)r * ldc + col0 + bj * HALF;
                    if (!FIRST) { const u32x4 p = *(const u32x4*)op;
                        o0[0] += bflo(p.x); o0[1] += bfhi(p.x); o0[2] += bflo(p.y); o0[3] += bfhi(p.y); o1[0] += bflo(p.z); o1[1] += bfhi(p.z); o1[2] += bflo(p.w); o1[3] += bfhi(p.w); }
                    *(u32x4*)op = pack8(o0, o1); asm volatile("" ::: "memory"); } }
    }
};

template <class Epi, class Sched, bool ALIGN_EPI = false, bool SP2 = false>
__device__ __forceinline__ void gemm_phase(PG8_LAS unsigned char* lds, const Gemm g, const Sched& S, const Epi& E) {
    int tid_o = threadIdx.x; asm volatile("" : "+v"(tid_o));
    const int tid = tid_o, wid = __builtin_amdgcn_readfirstlane(tid >> 6), lane = tid & 63, wr = wid >> 2, wc = wid & 3, fr = lane & 15, fq = lane >> 4;
    const int K = g.K, nt = K / BK;
    unsigned voffA[2], voffB[2];
#pragma unroll
    for (int i = 0; i < 2; ++i) { int R, C; stage_rc(tid * 16 + i * 8192, R, C); const int Rb = Epi::PERM ? ((R & ~31) + perm32(R & 31)) : R;
        voffA[i] = (unsigned)(R * K + C) * 2u; voffB[i] = (unsigned)(Rb * K + C) * 2u; }
    const size_t kstep = (size_t)(BK * 2);
    const size_t hstep = (size_t)HALF * K * 2;
    const size_t tstep = 2 * hstep;
    const unsigned ldsw = (unsigned)wid * 1024u;
    const int aoff = lds_byte(wr * 64 + fr, fq * 8), boff = lds_byte(wc * 32 + fr, fq * 8);
#define PG8_SA(b, h) (((b) * 2 + (h)) * HTB)
#define PG8_SB(b, h) ((4 + (b) * 2 + (h)) * HTB)
#define PG8_STAGE(bufoff, gbase, voff) do { _Pragma("unroll") for (int _i = 0; _i < 2; ++_i) \
        __builtin_amdgcn_global_load_lds((const unsigned*)((const char*)(gbase) + (voff)[_i]), (PG8_LAS unsigned*)(lds + (bufoff) + ldsw + _i * 8192), 16, 0, 0); } while (0)
#define PG8_LDA(dst, b, h) do { _Pragma("unroll") for (int m = 0; m < 4; ++m) _Pragma("unroll") for (int k = 0; k < 2; ++k) dst[m][k] = *(const PG8_LAS bf16x8*)(lds + PG8_SA(b, h) + aoff + m * 2048 + k * 1024); } while (0)
#define PG8_LDB(dst, b, h) do { _Pragma("unroll") for (int n = 0; n < 2; ++n) _Pragma("unroll") for (int k = 0; k < 2; ++k) dst[n][k] = *(const PG8_LAS bf16x8*)(lds + PG8_SB(b, h) + boff + n * 2048 + k * 1024); } while (0)
#define PG8_MMA(ai, bj, At, Bt) do { __builtin_amdgcn_s_setprio(1); _Pragma("unroll") for (int m = 0; m < 4; ++m) _Pragma("unroll") for (int n = 0; n < 2; ++n) _Pragma("unroll") for (int k = 0; k < 2; ++k) \
        acc[ai][bj][m][n] = __builtin_amdgcn_mfma_f32_16x16x32_bf16(Bt[n][k], At[m][k], acc[ai][bj][m][n], 0, 0, 0); __builtin_amdgcn_s_setprio(0); } while (0)
#define PG8_WAIT_V(n) asm volatile("s_waitcnt vmcnt(" #n ")" ::: "memory")
#define PG8_WAIT_L(n) asm volatile("s_waitcnt lgkmcnt(" #n ")" ::: "memory")
#define PG8_BAR __builtin_amdgcn_s_barrier()
#define PG8_SCHED __builtin_amdgcn_sched_barrier(0)
    Unit cur, nxt; int ui = 0;
    if (!S.next(0, cur)) return;
    f32x4 acc[2][2][4][2];
#pragma unroll
    for (int a = 0; a < 2; ++a)
#pragma unroll
        for (int b = 0; b < 2; ++b)
#pragma unroll
            for (int m = 0; m < 4; ++m)
#pragma unroll
                for (int n = 0; n < 2; ++n) acc[a][b][m][n] = (f32x4){0.f, 0.f, 0.f, 0.f};
    bf16x8 At[4][2], B0[2][2], B1[2][2];
    const char* cA = (const char*)g.A + (size_t)cur.pm * tstep; const char* cB = (const char*)g.Bt + (size_t)cur.pn * tstep;
    S.a_ready(cur);
    if constexpr (SP2) {
        PG8_STAGE(PG8_SB(0, 0), cB, voffB); PG8_STAGE(PG8_SB(0, 1), cB + hstep, voffB); PG8_STAGE(PG8_SA(0, 0), cA, voffA); PG8_STAGE(PG8_SA(0, 1), cA + hstep, voffA);
        if (wr == 1) PG8_BAR;
        PG8_WAIT_V(2); PG8_BAR;
        PG8_STAGE(PG8_SB(1, 0), cB + kstep, voffB); PG8_STAGE(PG8_SA(1, 0), cA + kstep, voffA); PG8_STAGE(PG8_SB(1, 1), cB + hstep + kstep, voffB);
        PG8_WAIT_V(6); PG8_BAR;
    } else {
        PG8_STAGE(PG8_SB(0, 0), cB, voffB); PG8_STAGE(PG8_SA(0, 0), cA, voffA); PG8_STAGE(PG8_SB(0, 1), cB + hstep, voffB); PG8_STAGE(PG8_SA(0, 1), cA + hstep, voffA);
        if (wr == 1) PG8_BAR;
        PG8_WAIT_V(4); PG8_BAR;
        PG8_STAGE(PG8_SB(1, 0), cB + kstep, voffB); PG8_STAGE(PG8_SA(1, 0), cA + kstep, voffA); PG8_STAGE(PG8_SB(1, 1), cB + hstep + kstep, voffB);
        PG8_WAIT_V(6); PG8_BAR;
    }
    for (;;) {
        const bool has_next = S.next(ui + 1, nxt);
        const char* nA = has_next ? (const char*)g.A + (size_t)nxt.pm * tstep : cA; const char* nB = has_next ? (const char*)g.Bt + (size_t)nxt.pn * tstep : cB;
        for (int t = 0; t < nt; t += 2) {
            const bool last = (t == nt - 2);
            const char* a1 = cA + (size_t)(t + 1) * kstep;
            const char* a2 = last ? nA : cA + (size_t)(t + 2) * kstep; const char* b2 = last ? nB : cB + (size_t)(t + 2) * kstep;
            const char* a3 = a2 + kstep; const char* b3 = b2 + kstep;
            if (last && has_next) S.a_ready(nxt);
            if constexpr (SP2) {
            PG8_LDB(B0, 0, 0); PG8_LDB(B1, 0, 1); PG8_SCHED; PG8_LDA(At, 0, 0); PG8_STAGE(PG8_SA(1, 1), a1 + hstep, voffA);
            PG8_WAIT_V(8); PG8_WAIT_L(0); PG8_BAR; PG8_MMA(0, 0, At, B0); PG8_MMA(0, 1, At, B1); PG8_BAR; PG8_SCHED;
            PG8_LDA(At, 0, 1); PG8_STAGE(PG8_SB(0, 0), b2, voffB); PG8_STAGE(PG8_SB(0, 1), b2 + hstep, voffB); PG8_STAGE(PG8_SA(0, 0), a2, voffA);
            PG8_WAIT_V(8); PG8_WAIT_L(0); PG8_BAR; PG8_MMA(1, 0, At, B0); PG8_MMA(1, 1, At, B1); PG8_BAR; PG8_SCHED;
            PG8_LDB(B0, 1, 0); PG8_LDB(B1, 1, 1); PG8_SCHED; PG8_LDA(At, 1, 0); PG8_STAGE(PG8_SA(0, 1), a2 + hstep, voffA);
            PG8_WAIT_V(8); PG8_WAIT_L(0); PG8_BAR; PG8_MMA(0, 0, At, B0); PG8_MMA(0, 1, At, B1); PG8_BAR; PG8_SCHED;
            PG8_LDA(At, 1, 1); PG8_STAGE(PG8_SB(1, 0), b3, voffB); PG8_STAGE(PG8_SB(1, 1), b3 + hstep, voffB); PG8_STAGE(PG8_SA(1, 0), a3, voffA);
            PG8_WAIT_V(8); PG8_WAIT_L(0); PG8_BAR; PG8_MMA(1, 0, At, B0); PG8_MMA(1, 1, At, B1); PG8_BAR; PG8_SCHED;
            } else {
            PG8_LDB(B0, 0, 0); PG8_SCHED; PG8_LDA(At, 0, 0); PG8_STAGE(PG8_SA(1, 1), a1 + hstep, voffA);
            PG8_WAIT_L(8); PG8_BAR; PG8_WAIT_L(0); PG8_MMA(0, 0, At, B0); PG8_BAR; PG8_SCHED;
            PG8_LDB(B1, 0, 1); PG8_STAGE(PG8_SB(0, 0), b2, voffB);
            PG8_BAR; PG8_WAIT_L(0); PG8_MMA(0, 1, At, B1); PG8_BAR;
            PG8_LDA(At, 0, 1); PG8_STAGE(PG8_SA(0, 0), a2, voffA);
            PG8_BAR; PG8_WAIT_L(0); PG8_MMA(1, 0, At, B0); PG8_BAR; PG8_SCHED;
            PG8_STAGE(PG8_SB(0, 1), b2 + hstep, voffB);
            PG8_WAIT_V(6); PG8_BAR; PG8_MMA(1, 1, At, B1); PG8_BAR;
            PG8_LDB(B0, 1, 0); PG8_SCHED; PG8_LDA(At, 1, 0); PG8_STAGE(PG8_SA(0, 1), a2 + hstep, voffA);
            PG8_WAIT_L(8); PG8_BAR; PG8_WAIT_L(0); PG8_MMA(0, 0, At, B0); PG8_BAR; PG8_SCHED;
            PG8_LDB(B1, 1, 1); PG8_STAGE(PG8_SB(1, 0), b3, voffB);
            PG8_BAR; PG8_WAIT_L(0); PG8_MMA(0, 1, At, B1); PG8_BAR;
            PG8_LDA(At, 1, 1); PG8_STAGE(PG8_SA(1, 0), a3, voffA);
            PG8_BAR; PG8_WAIT_L(0); PG8_MMA(1, 0, At, B0); PG8_BAR; PG8_SCHED;
            PG8_STAGE(PG8_SB(1, 1), b3 + hstep, voffB);
            PG8_WAIT_V(6); PG8_BAR; PG8_MMA(1, 1, At, B1); PG8_BAR;
            }
        }
        if constexpr (ALIGN_EPI) { if (wr == 0) PG8_BAR; }
        if constexpr (!Epi::AFTER_DRAIN) { E(acc, cur, wr, wc, fr, fq); S.done(cur); }
        if (!has_next) break;
#pragma unroll
        for (int a = 0; a < 2; ++a)
#pragma unroll
            for (int b = 0; b < 2; ++b)
#pragma unroll
                for (int m = 0; m < 4; ++m)
#pragma unroll
                    for (int n = 0; n < 2; ++n) acc[a][b][m][n] = (f32x4){0.f, 0.f, 0.f, 0.f};
        cur = nxt; cA = nA; cB = nB; ++ui;
        if constexpr (ALIGN_EPI) { if (wr == 1) PG8_BAR; }
    }
    PG8_WAIT_V(0);
    if constexpr (!ALIGN_EPI) { if (wr == 0) PG8_BAR; }
    PG8_BAR;
    if constexpr (Epi::AFTER_DRAIN) { E.fused(acc, cur, wr, wc, fr, fq, lds, wid, lane); S.done(cur); }
#undef PG8_SA
#undef PG8_SB
#undef PG8_STAGE
#undef PG8_LDA
#undef PG8_LDB
#undef PG8_MMA
#undef PG8_WAIT_V
#undef PG8_WAIT_L
#undef PG8_BAR
#undef PG8_SCHED
}
}
#define XB_TMO      128
#define XB_XCNT(j)  (256  + 64 * (j))
#define XB_XSUB(j)  (1280 + 64 * (j))
#define XB_XGEN(j)  (2304 + 64 * (j))
#define XB_TOP      3328
#define XB_TOPGEN   3392
#define XCD_BAR_WORDS 3456
#define XB_SPIN_CAP (1u << 18)

__device__ __forceinline__ unsigned xb_ld(unsigned* p)              { return __hip_atomic_load(p, __ATOMIC_RELAXED, __HIP_MEMORY_SCOPE_AGENT); }
__device__ __forceinline__ unsigned xb_add(unsigned* p, unsigned v) { return __hip_atomic_fetch_add(p, v, __ATOMIC_RELAXED, __HIP_MEMORY_SCOPE_AGENT); }
__device__ __forceinline__ unsigned xb_xcc_id() { return (unsigned)__builtin_amdgcn_s_getreg((3 << 11) | 20) & 0xFu; }
#define XB_SPIN(cond, bar) do { unsigned _sp = 0; while (cond) { __builtin_amdgcn_s_sleep(1); \
    if ((++_sp & 255u) == 0u) { if (xb_ld(&(bar)[XB_TMO])) break; if (_sp > XB_SPIN_CAP) { atomicAdd(&(bar)[XB_TMO], 1u); break; } } } } while (0)

struct XcdBarrier {
    unsigned* bar; unsigned x;
    volatile LAS unsigned* st;
};

__device__ __forceinline__ XcdBarrier xcd_barrier_post(unsigned* bar, volatile LAS unsigned* st) {
    XcdBarrier b; b.bar = bar; b.x = xb_xcc_id(); b.st = st;
    if (threadIdx.x == 0) (void)xb_add(&bar[XB_XCNT(b.x)], 1u);
    return b;
}
__device__ __forceinline__ void xcd_barrier_complete(unsigned* bar, unsigned x, unsigned& nloc, unsigned& nx) {
    const unsigned G = gridDim.x * gridDim.y * gridDim.z;
    unsigned sum, cnt, mine, sp = 0u;
    for (;;) {
        sum = 0u; cnt = 0u; mine = 0u;
#pragma unroll
        for (unsigned j = 0; j < 16; ++j) { const unsigned c = xb_ld(&bar[XB_XCNT(j)]); sum += c; cnt += (c > 0u) ? 1u : 0u; mine = (j == x) ? c : mine; }
        if (sum == G) break;
        __builtin_amdgcn_s_sleep(1);
        if ((++sp & 255u) == 0u) { if (xb_ld(&bar[XB_TMO])) break; if (sp > XB_SPIN_CAP) { atomicAdd(&bar[XB_TMO], 1u); break; } }
    }
    nloc = mine > 0u ? mine : 1u; nx = cnt > 0u ? cnt : 1u;
}

__device__ __forceinline__ void xcd_barrier(const XcdBarrier& b) {
    asm volatile("s_waitcnt vmcnt(0)" ::: "memory");
    __syncthreads();
    if (threadIdx.x == 0) {
        unsigned* bar = b.bar;
        __builtin_amdgcn_s_waitcnt(0);
        unsigned nloc = b.st[0], nx = b.st[1];
        if (nloc == 0u) { xcd_barrier_complete(bar, b.x, nloc, nx); b.st[0] = nloc; b.st[1] = nx; }
        const unsigned old = xb_add(&bar[XB_XSUB(b.x)], 1u);
        const unsigned gen = old / nloc;
        if (old + 1u == (gen + 1u) * nloc) {
            __builtin_amdgcn_fence(__ATOMIC_RELEASE, "agent");
            asm volatile("s_waitcnt vmcnt(0)" ::: "memory");
            const unsigned og = xb_add(&bar[XB_TOP], 1u);
            const unsigned tg = og / nx;
            if (og + 1u == (tg + 1u) * nx) xb_add(&bar[XB_TOPGEN], 1u);
            else XB_SPIN(xb_ld(&bar[XB_TOPGEN]) == tg, bar);
            __builtin_amdgcn_fence(__ATOMIC_ACQUIRE, "agent");
            xb_add(&bar[XB_XGEN(b.x)], 1u);
            asm volatile("s_waitcnt vmcnt(0)" ::: "memory");
        } else {
            XB_SPIN(xb_ld(&bar[XB_XGEN(b.x)]) == gen, bar);
            __builtin_amdgcn_fence(__ATOMIC_ACQUIRE, "agent");
            asm volatile("s_waitcnt vmcnt(0)" ::: "memory");
        }
    }
    __syncthreads();
}
typedef unsigned short bf16;
typedef unsigned v4u __attribute__((ext_vector_type(4)));
typedef unsigned v2u __attribute__((ext_vector_type(2)));
typedef float f32x4 __attribute__((ext_vector_type(4)));
typedef short bf16x8 __attribute__((ext_vector_type(8)));
constexpr int NB = 2, S = 8192, T = NB * S, D = 1024, DEPTH = 2, DFF = 2816, DIN = 5080;
constexpr int NWAVES = 8, NTHR = 512;
constexpr float RMS_EPS = 1e-6f;
constexpr int WI_AQ = 0, WI_CKV = 512, WI_IQ = 640, WI_IK = 1152, WI_IW = 1216, WI_BQKV = 1224, WI_CQ = 3528, WI_CK = 3784, WI_CV = 4040, WI_CG = 4552, WI_CA = 5064;
constexpr int NBIG = 9216, RB0 = 0, NRB = 2304, RAC0 = 2304, NRAC = 3840, RG0 = 6144, NRG = 3072;
constexpr int LA2 = 2816, A2_QR = 0, A2_IQ = 128, A2_IK = 640, A2_IW = 704, A2_CKV = 768, A2_KR = 896, A2_CQ = 1024, A2_CK = 1280, A2_CV = 1536, A2_CG = 2048, A2_CAL = 2560;
constexpr int LPB = 2304;
constexpr float QSCALE = 0.18033688011112042f;

constexpr size_t MiB = 1u << 20;
constexpr size_t WS_CTL = 0, CTL_ZERO_BYTES = 1 * MiB;
constexpr size_t WS_W = 1 * MiB;
constexpr size_t WS_CS = 25 * MiB;
constexpr size_t WS_XN = 26 * MiB;
constexpr size_t WS_FB = 58 * MiB;
constexpr size_t WS_YB = 90 * MiB;
constexpr size_t WS_YA = 98 * MiB;
constexpr size_t WS_YC = 130 * MiB;
constexpr size_t WS_BIG = 146 * MiB;
constexpr size_t WS_DEC = 242 * MiB;
constexpr size_t WS_END = 243 * MiB;
constexpr size_t WO_W1 = 0, WO_W2 = (size_t)2 * DFF * D;
constexpr size_t WO_BIG = 0, WO_MA = (size_t)NBIG * D, WO_MB = WO_MA + (size_t)D * 1024, WO_MC = WO_MB + (size_t)D * 256, WO_WO = WO_MC + (size_t)D * 512;
static_assert((WO_WO + (size_t)D * D) * 2 <= 24 * MiB && (WO_W2 + (size_t)D * DFF) * 2 <= 24 * MiB, "weights region");
constexpr int CW_BAR = 4096;

constexpr int RING_BYTES = 131072, MISC_OFF = RING_BYTES + 320, LDS_BYTES = 147456;

#define RLX_AGENT __ATOMIC_RELAXED, __HIP_MEMORY_SCOPE_AGENT
#define LDS_WAIT() asm volatile("s_waitcnt lgkmcnt(0)" ::: "memory")
#define VM_WAIT() asm volatile("s_waitcnt vmcnt(0)" ::: "memory")
__device__ __forceinline__ unsigned char* opaque_ptr(unsigned char* p) { GAS unsigned char* g = (GAS unsigned char*)p; asm volatile("" : "+s"(g)); return (unsigned char*)g; }
__device__ __forceinline__ unsigned f2bf(float f) { unsigned u = __builtin_bit_cast(unsigned, f); return (u + 0x7fffu + ((u >> 16) & 1u)) >> 16; }
__device__ __forceinline__ unsigned pk2(float lo, float hi) { return f2bf(lo) | (f2bf(hi) << 16); }
__device__ __forceinline__ float bf2f(bf16 v) { return __uint_as_float((unsigned)v << 16); }
__device__ __forceinline__ float blo(unsigned w) { return __uint_as_float(w << 16); }
__device__ __forceinline__ float bhi(unsigned w) { return __uint_as_float(w & 0xffff0000u); }
__device__ __forceinline__ float wave_sum(float v) {
#pragma unroll
    for (int o = 1; o < 64; o <<= 1) v += __shfl_xor(v, o);
    return v;
}
__device__ __forceinline__ float wave_max(float v) {
#pragma unroll
    for (int o = 1; o < 64; o <<= 1) v = fmaxf(v, __shfl_xor(v, o));
    return v;
}

struct Args {
    const float* in[24]; float* out; unsigned char* ws; int ph_lo, ph_hi;
};
enum { I_X = 0, I_POS, I_F1PRE, I_F1WIN, I_F1WOUT, I_F1POST, I_MIXPRE, I_WIN, I_AKVG, I_AWKV, I_CWAL, I_CBAL, I_CNORM, I_WBA, I_WBB, I_WBC, I_WGATE, I_BGATE, I_WOUT, I_MIXPOST, I_F2PRE, I_F2WIN, I_F2WOUT, I_F2POST };

__device__ __forceinline__ void cvt_tile(const float* src, int ld, int col0, int ncols, int k0, bf16* dst, int K, int drow0, float scale, bool zfill, LAS float* scr, int tid) {
    __syncthreads();
#pragma unroll
    for (int i = 0; i < 8; ++i) { const int kk = (tid >> 6) + 8 * i, n = tid & 63; scr[kk * 65 + n] = (n < ncols) ? src[(size_t)(k0 + kk) * ld + col0 + n] * scale : 0.f; }
    __syncthreads();
    const int n = tid >> 3, c = tid & 7;
    if (n < ncols || zfill) { const LAS float* s = scr + (8 * c) * 65 + n;
        v4u o; o.x = pk2(s[0], s[65]); o.y = pk2(s[2 * 65], s[3 * 65]); o.z = pk2(s[4 * 65], s[5 * 65]); o.w = pk2(s[6 * 65], s[7 * 65]);
        *(v4u*)(dst + (size_t)(drow0 + n) * K + k0 + 8 * c) = o; }
}
__device__ __forceinline__ void cvt_block(const float* src, int ld, int col0, int ncols, int K, bf16* dst, int drow0, float scale, bool zfill, LAS float* scr, int& rot) {
    const int G = gridDim.x, nct = (ncols + 63) / 64, nkt = K / 64, nt = nct * nkt;
    for (int t = ((int)blockIdx.x - rot % G + G) % G; t < nt; t += G) { const int ct = t / nkt, kt = t % nkt; const int nc = ncols - 64 * ct < 64 ? ncols - 64 * ct : 64;
        cvt_tile(src, ld, col0 + 64 * ct, nc, 64 * kt, dst, K, drow0 + 64 * ct, scale, zfill, scr, threadIdx.x); }
    rot += nt;
}
__device__ __forceinline__ void cvt_ffn(const float* w_in, const float* w_out, bf16* W1t, bf16* W2t, LAS float* scr) {
    const int G = gridDim.x;
    constexpr int NRT = 2 * DFF / 64, NKT = D / 64;
    for (int t = blockIdx.x; t < NRT * NKT; t += G) { const int rt = t / NKT, kt = t % NKT; const int pn = rt >> 2, w = (rt & 3) * 64;
        const int col = (w < 128) ? 128 * pn + w : DFF + 128 * pn + (w - 128);
        cvt_tile(w_in, 2 * DFF, col, 64, 64 * kt, W1t, D, 64 * rt, 1.0f, false, scr, threadIdx.x); }
    int rot = NRT * NKT;
    cvt_block(w_out, D, 0, D, DFF, W2t, 0, 1.0f, false, scr, rot);
}
__device__ __forceinline__ void cvt_mixer(const Args& a, int l, bf16* W, LAS float* scr) {
    const float* w_in = a.in[I_WIN] + (size_t)l * D * DIN;
    const float* wkv = a.in[I_AWKV] + (size_t)l * 128 * 1024;
    bf16* Wbig = W + WO_BIG;
    int rot = 0;
    cvt_block(w_in, DIN, WI_BQKV, 768, D, Wbig, RB0, QSCALE, false, scr, rot);
    cvt_block(w_in, DIN, WI_BQKV + 768, 1536, D, Wbig, RB0 + 768, 1.0f, false, scr, rot);
    const int R2 = RAC0 + 1024;
#pragma unroll 1
    for (int h = 0; h < 8; ++h) cvt_block(w_in, DIN, WI_AQ + 64 * h, 16, D, Wbig, R2 + A2_QR + 16 * h, QSCALE, false, scr, rot);
    cvt_block(w_in, DIN, WI_IQ, 512, D, Wbig, R2 + A2_IQ, 1.0f, false, scr, rot);
    cvt_block(w_in, DIN, WI_IK, 64, D, Wbig, R2 + A2_IK, 1.0f, false, scr, rot);
    cvt_block(w_in, DIN, WI_IW, 8, D, Wbig, R2 + A2_IW, 1.0f, true, scr, rot);
    cvt_block(w_in, DIN, WI_CKV, 128, D, Wbig, R2 + A2_CKV, 1.0f, false, scr, rot);
    cvt_block(w_in, DIN, WI_CQ, 256, D, Wbig, R2 + A2_CQ, 0.125f, false, scr, rot);
    cvt_block(w_in, DIN, WI_CK, 256 + 512 + 512, D, Wbig, R2 + A2_CK, 1.0f, false, scr, rot);
    cvt_block(a.in[I_WGATE] + (size_t)l * D * 3072, 3072, 0, 3072, D, Wbig, RG0, 1.0f, false, scr, rot);
    cvt_block(a.in[I_WBB] + (size_t)l * 256 * D, D, 0, D, 256, W + WO_MB, 0, 1.0f, false, scr, rot);
    cvt_block(a.in[I_WBC] + (size_t)l * 512 * D, D, 0, D, 512, W + WO_MC, 0, 1.0f, false, scr, rot);
    cvt_block(a.in[I_WOUT] + (size_t)l * D * D, D, 0, D, D, W + WO_WO, 0, 1.0f, false, scr, rot);
    const int gt = blockIdx.x * NTHR + threadIdx.x, GT = gridDim.x * NTHR;
    for (int e = gt; e < 1024 * D; e += GT) { const int d = e & 1023, rc = e >> 10, h = rc >> 7, c = rc & 127;
        const float* wi = w_in + (size_t)d * DIN + WI_AQ + 64 * h; const float* wk = wkv + (size_t)c * 1024 + 128 * h; float s = 0.f;
#pragma unroll 8
        for (int j = 16; j < 64; ++j) s += wi[j] * wk[j];
        Wbig[(size_t)(RAC0 + rc) * D + d] = (bf16)f2bf(s * QSCALE); }
    const float* gkv = a.in[I_AKVG] + (size_t)l * 128;
    for (int e = gt; e < 128 * D; e += GT) { const int d = e & 1023, rc = e >> 10, h = rc >> 4, i = rc & 15;
        const float* wi = w_in + (size_t)d * DIN + WI_CKV; float s = 0.f;
#pragma unroll 8
        for (int c = 0; c < 128; ++c) s += wi[c] * gkv[c] * wkv[(size_t)c * 1024 + 128 * h + i];
        Wbig[(size_t)(R2 + A2_KR + rc) * D + d] = (bf16)f2bf(s); }
    const float* wal = a.in[I_CWAL] + (size_t)l * 16 * 256;
    for (int e = gt; e < 256 * D; e += GT) { const int d = e & 1023, n = e >> 10;
        const float* wi = w_in + (size_t)d * DIN + WI_CA; float s = 0.f;
#pragma unroll
        for (int r = 0; r < 16; ++r) s += wi[r] * wal[r * 256 + n];
        Wbig[(size_t)(R2 + A2_CAL + n) * D + d] = (bf16)f2bf(s); }
    const float* wba = a.in[I_WBA] + (size_t)l * 512 * D;
    for (int e = gt; e < 1024 * 1024; e += GT) { const int k = e & 1023, n = e >> 10, h = k >> 7, c = k & 127;
        const float* wk = wkv + (size_t)c * 1024 + 128 * h + 64; const float* wb = wba + (size_t)(64 * h) * D + n; float s = 0.f;
#pragma unroll 8
        for (int j = 0; j < 64; ++j) s += wk[j] * wb[(size_t)j * D];
        (W + WO_MA)[(size_t)n * 1024 + k] = (bf16)f2bf(s); }
}

__device__ __forceinline__ void cs_phase(const int* pos, float* cs) {
    const int gt = blockIdx.x * NTHR + threadIdx.x, GT = gridDim.x * NTHR;
    for (int e = gt; e < T * 8; e += GT) { const int t = e >> 3, i = e & 7;
        const double frev = (i == 0) ? 0.15915494309189535 : (i == 1) ? 0.03086376340470123 : (i == 2) ? 0.005985185712713705 : (i == 3) ? 0.001160663641240061 :
                            (i == 4) ? 0.00022507907903927653 : (i == 5) ? 4.364795279280289e-05 : (i == 6) ? 8.464330808241401e-06 : 1.6414262627950345e-06;
        const double rev = (double)pos[t] * frev; const float fr = (float)(rev - __builtin_floor(rev));
        cs[(size_t)t * 16 + i] = __builtin_amdgcn_cosf(fr); cs[(size_t)t * 16 + 8 + i] = __builtin_amdgcn_sinf(fr); }
}
__device__ __forceinline__ void resid_phase(const float* hin, float* hout, const bf16* f, float w, const float* gpost, const float* gpre, bf16* xn) {
    const int lane = threadIdx.x & 63, gw = blockIdx.x * NWAVES + (threadIdx.x >> 6), NGW = gridDim.x * NWAVES;
    for (int r = gw; r < T; r += NGW) {
        f32x4 v[4];
#pragma unroll
        for (int j = 0; j < 4; ++j) v[j] = *(const f32x4*)(hin + (size_t)r * D + 256 * j + 4 * lane);
        if (f) { f32x4 fv[4]; float s = 0.f;
#pragma unroll
            for (int j = 0; j < 4; ++j) { const v2u p = *(const v2u*)(f + (size_t)r * D + 256 * j + 4 * lane); fv[j] = (f32x4){blo(p.x), bhi(p.x), blo(p.y), bhi(p.y)};
                s += (fv[j][0] * fv[j][0] + fv[j][1] * fv[j][1]) + (fv[j][2] * fv[j][2] + fv[j][3] * fv[j][3]); }
            const float rstd = w * __builtin_amdgcn_rsqf(wave_sum(s) * (1.0f / D) + RMS_EPS);
#pragma unroll
            for (int j = 0; j < 4; ++j) { const f32x4 g = *(const f32x4*)(gpost + 256 * j + 4 * lane); v[j] = v[j] + fv[j] * rstd * g; }
        }
#pragma unroll
        for (int j = 0; j < 4; ++j) *(f32x4*)(hout + (size_t)r * D + 256 * j + 4 * lane) = v[j];
        if (xn) { float s = 0.f;
#pragma unroll
            for (int j = 0; j < 4; ++j) s += (v[j][0] * v[j][0] + v[j][1] * v[j][1]) + (v[j][2] * v[j][2] + v[j][3] * v[j][3]);
            const float rstd = __builtin_amdgcn_rsqf(wave_sum(s) * (1.0f / D) + RMS_EPS);
#pragma unroll
            for (int j = 0; j < 4; ++j) { const f32x4 g = *(const f32x4*)(gpre + 256 * j + 4 * lane); const f32x4 o = v[j] * rstd * g;
                v2u p; p.x = pk2(o[0], o[1]); p.y = pk2(o[2], o[3]); *(v2u*)(xn + (size_t)r * D + 256 * j + 4 * lane) = p; }
        }
    }
}
__device__ __forceinline__ void rec_phase(const bf16* pA2, const float* gkv, const float* cs, bf16* rec) {
    const int lane = threadIdx.x & 63, gw = blockIdx.x * NWAVES + (threadIdx.x >> 6), NGW = gridDim.x * NWAVES;
    for (int r = gw; r < T; r += NGW) {
        const unsigned pc = *(const unsigned*)(pA2 + (size_t)r * LA2 + A2_CKV + 2 * lane), pk = *(const unsigned*)(pA2 + (size_t)r * LA2 + A2_KR + 2 * lane);
        const float c0 = blo(pc), c1 = bhi(pc);
        const float rstd = __builtin_amdgcn_rsqf(wave_sum(c0 * c0 + c1 * c1) * (1.0f / 128.0f) + RMS_EPS);
        *(unsigned*)(rec + (size_t)r * 256 + 2 * lane) = pk2(c0 * rstd * gkv[2 * lane], c1 * rstd * gkv[2 * lane + 1]);
        const float k0 = blo(pk) * rstd, k1 = bhi(pk) * rstd;
        const float q0 = __shfl_xor(k0, 4), q1 = __shfl_xor(k1, 4);
        const int i0 = (2 * lane) & 7; const bool hi = ((2 * lane) & 8) != 0;
        const float cc0 = cs[(size_t)r * 16 + i0], cc1 = cs[(size_t)r * 16 + i0 + 1], ss0 = cs[(size_t)r * 16 + 8 + i0], ss1 = cs[(size_t)r * 16 + 8 + i0 + 1];
        const float o0 = hi ? k0 * cc0 + q0 * ss0 : k0 * cc0 - q0 * ss0, o1 = hi ? k1 * cc1 + q1 * ss1 : k1 * cc1 - q1 * ss1;
        *(unsigned*)(rec + (size_t)r * 256 + 128 + 2 * lane) = pk2(o0, o1);
    }
}
__device__ __forceinline__ unsigned pack_score(float sc, int idx) {
    const unsigned u = __float_as_uint(sc); const unsigned m = u ^ ((u >> 31) ? 0xffffffffu : 0x80000000u);
    return (m & 0xffffe000u) | (unsigned)idx;
}
__device__ __forceinline__ void nv_idx_phase(const bf16* pA2, unsigned short* sel, LAS unsigned char* lds) {
    LAS float* qs = (LAS float*)lds;
    LAS float* ws_ = qs + 512;
    LAS unsigned* ctr = (LAS unsigned*)(ws_ + 8);
    LAS unsigned* pk = (LAS unsigned*)(lds + 4096);
    const int tid = threadIdx.x;
    for (int q0 = blockIdx.x; q0 < T; q0 += gridDim.x) {
        const int q = ((q0 & 1) ? (T - 1 - (q0 >> 1)) : (q0 >> 1));
        const int b = q / S, t = q % S, n = t + 1;
        __syncthreads();
        qs[tid] = bf2f(pA2[(size_t)q * LA2 + A2_IQ + tid]);
        if (tid < 8) ws_[tid] = bf2f(pA2[(size_t)q * LA2 + A2_IW + tid]);
        if (tid < 8) ctr[tid] = 0u;
        __syncthreads();
        for (int s = tid; s < n; s += NTHR) {
            const v4u* kp = (const v4u*)(pA2 + (size_t)(b * S + s) * LA2 + A2_IK);
            v4u kq[8];
#pragma unroll
            for (int c = 0; c < 8; ++c) kq[c] = kp[c];
            float sc = 0.f;
#pragma unroll 1
            for (int h = 0; h < 8; ++h) { float d = 0.f; const LAS float* qh = qs + h * 64;
#pragma unroll
                for (int c = 0; c < 8; ++c) d += qh[8 * c] * blo(kq[c].x) + qh[8 * c + 1] * bhi(kq[c].x) + qh[8 * c + 2] * blo(kq[c].y) + qh[8 * c + 3] * bhi(kq[c].y) + qh[8 * c + 4] * blo(kq[c].z) + qh[8 * c + 5] * bhi(kq[c].z) + qh[8 * c + 6] * blo(kq[c].w) + qh[8 * c + 7] * bhi(kq[c].w);
                sc += ws_[h] * fmaxf(d, 0.f); }
            pk[s] = pack_score(sc, s);
        }
        __syncthreads();
        unsigned thr = 0u;
        if (n > 256) {
            unsigned lo = 0u, hi = 0xffffffffu; int it = 0;
            for (;;) {
                const unsigned mid = lo + ((hi - lo) >> 1);
                unsigned c = 0;
                for (int s = tid; s < n; s += NTHR) c += (pk[s] >= mid) ? 1u : 0u;
#pragma unroll
                for (int o = 1; o < 64; o <<= 1) c += __shfl_xor(c, o);
                const int slot = 1 + (it & 3);
                if ((tid & 63) == 0) atomicAdd((unsigned*)&ctr[slot], c);
                __syncthreads();
                const unsigned tot = ctr[slot];
                if (tid == 0) ctr[1 + ((it + 2) & 3)] = 0u;
                ++it;
                if (tot == 256u || hi - lo <= 1u || it > 40) { thr = mid; break; }
                if (tot > 256u) lo = mid; else hi = mid;
            }
        }
        __syncthreads();
        unsigned base = 0u;
        for (int s0 = 0; s0 < n; s0 += NTHR) { const int s = s0 + tid; const bool keep = (s < n) && (pk[s] >= thr);
            const unsigned long long bm = __ballot(keep); const unsigned wc_ = (unsigned)__popcll(bm);
            __syncthreads();
            if ((tid & 63) == 0) ctr[tid >> 6] = wc_;
            __syncthreads();
            unsigned off = base, tot = 0u;
#pragma unroll
            for (int w = 0; w < 8; ++w) { const unsigned c = ctr[w]; if (w < (tid >> 6)) off += c; tot += c; }
            if (keep) { const unsigned p = off + (unsigned)__popcll(bm & ((1ull << (tid & 63)) - 1ull)); if (p < 256u) sel[(size_t)q * 256 + p] = (unsigned short)s; }
            base += tot; }
        const unsigned cnt = base < 256u ? base : 256u;
        if (tid < 256 && (unsigned)tid >= cnt) sel[(size_t)q * 256 + tid] = 0xffffu;
    }
}
__device__ __forceinline__ void nv_atta_phase(const bf16* pA2, bf16* ya, const bf16* rec, const unsigned short* sel, LAS unsigned char* lds) {
    LAS float* qa = (LAS float*)lds;
    LAS float* qr = qa + 1024;
    LAS float* P = qr + 128;
    LAS int* sl = (LAS int*)(P + 2048);
    const int tid = threadIdx.x, lane = tid & 63, wv = tid >> 6;
    for (int q = blockIdx.x; q < T; q += gridDim.x) {
        const int b = q / S;
        __syncthreads();
        qa[tid] = bf2f(ya[(size_t)q * 1024 + tid]); qa[tid + 512] = bf2f(ya[(size_t)q * 1024 + 512 + tid]);
        if (tid < 128) qr[tid] = bf2f(pA2[(size_t)q * LA2 + A2_QR + tid]);
        if (tid < 256) sl[tid] = sel[(size_t)q * 256 + tid];
        __syncthreads();
        { const int k = tid & 255, hh = tid >> 8; const int key = sl[k]; const bool valid = key != 0xffff;
          const bf16* rp = rec + (size_t)(b * S + (valid ? key : 0)) * 256;
          float s4[4] = {0.f, 0.f, 0.f, 0.f};
          for (int c8 = 0; c8 < 16; ++c8) { const v4u w = *(const v4u*)(rp + 8 * c8); const float x[8] = {blo(w.x), bhi(w.x), blo(w.y), bhi(w.y), blo(w.z), bhi(w.z), blo(w.w), bhi(w.w)};
#pragma unroll
              for (int h = 0; h < 4; ++h)
#pragma unroll
                  for (int e = 0; e < 8; ++e) s4[h] += qa[(hh * 4 + h) * 128 + 8 * c8 + e] * x[e]; }
#pragma unroll
          for (int h = 0; h < 4; ++h) { const int hd = hh * 4 + h; const v4u w0 = *(const v4u*)(rp + 128 + 16 * hd), w1 = *(const v4u*)(rp + 128 + 16 * hd + 8);
              const float x[16] = {blo(w0.x), bhi(w0.x), blo(w0.y), bhi(w0.y), blo(w0.z), bhi(w0.z), blo(w0.w), bhi(w0.w), blo(w1.x), bhi(w1.x), blo(w1.y), bhi(w1.y), blo(w1.z), bhi(w1.z), blo(w1.w), bhi(w1.w)};
#pragma unroll
              for (int e = 0; e < 16; ++e) s4[h] += qr[hd * 16 + e] * x[e];
              P[hd * 256 + k] = valid ? s4[h] : -INFINITY; } }
        __syncthreads();
        { float v[4]; float m = -INFINITY;
#pragma unroll
          for (int j = 0; j < 4; ++j) { v[j] = P[wv * 256 + lane + 64 * j]; m = fmaxf(m, v[j]); }
          m = wave_max(m); float sum = 0.f;
#pragma unroll
          for (int j = 0; j < 4; ++j) { v[j] = exp2f(v[j] - m); sum += v[j]; }
          sum = wave_sum(sum); const float inv = 1.0f / sum;
#pragma unroll
          for (int j = 0; j < 4; ++j) P[wv * 256 + lane + 64 * j] = v[j] * inv; }
        __syncthreads();
        { const int c = tid & 127, hq = tid >> 7; float o0 = 0.f, o1 = 0.f;
          for (int k = 0; k < 256; ++k) { const int key = sl[k]; if (key == 0xffff) continue; const float x = bf2f(rec[(size_t)(b * S + key) * 256 + c]); o0 += P[(2 * hq) * 256 + k] * x; o1 += P[(2 * hq + 1) * 256 + k] * x; }
          ya[(size_t)q * 1024 + (2 * hq) * 128 + c] = (bf16)f2bf(o0); ya[(size_t)q * 1024 + (2 * hq + 1) * 128 + c] = (bf16)f2bf(o1); }
    }
}
__device__ __forceinline__ void nv_attb_phase(const bf16* pB, bf16* yb, LAS unsigned char* lds) {
    const int tid = threadIdx.x, lane = tid & 63, wv = tid >> 6;
    LAS float* qv = (LAS float*)lds + wv * 64;
    const int gw = blockIdx.x * NWAVES + wv, NGW = gridDim.x * NWAVES;
    for (int item = gw; item < T * 4; item += NGW) {
        const int tg = item >> 2, hs = item & 3, b = tg / S, t = tg % S;
        float m = -INFINITY, l = 0.f, o = 0.f;
#pragma unroll 1
        for (int g = 0; g < 3; ++g) {
            const int dil = (g == 0) ? 1 : (g == 1) ? 4 : 16, head = g * 4 + hs;
            LDS_WAIT();
            qv[lane] = bf2f(pB[(size_t)tg * LPB + head * 64 + lane]);
            LDS_WAIT();
#pragma unroll 1
            for (int pass = 0; pass < 3; ++pass) {
                const int j = pass * 64 + lane, pos = t - dil * j; const bool valid = (j <= 128) && (pos >= 0);
                float s = -INFINITY;
                if (valid) { const v4u* kp = (const v4u*)(pB + (size_t)(b * S + pos) * LPB + 768 + head * 64); float d = 0.f;
#pragma unroll
                    for (int c = 0; c < 8; ++c) { const v4u w = kp[c]; d += qv[8 * c] * blo(w.x) + qv[8 * c + 1] * bhi(w.x) + qv[8 * c + 2] * blo(w.y) + qv[8 * c + 3] * bhi(w.y) + qv[8 * c + 4] * blo(w.z) + qv[8 * c + 5] * bhi(w.z) + qv[8 * c + 6] * blo(w.w) + qv[8 * c + 7] * bhi(w.w); }
                    s = d; }
                const float mx = wave_max(s);
                if (mx == -INFINITY) continue;
                const float mn = fmaxf(m, mx), p = valid ? exp2f(s - mn) : 0.f, scl = exp2f(m - mn);
                l = l * scl + wave_sum(p); o *= scl; m = mn;
                const int nj = (pass == 2) ? 1 : 64;
                for (int jj = 0; jj < nj; ++jj) { const float pj = __shfl(p, jj); const int pj_pos = t - dil * (pass * 64 + jj);
                    if (pj_pos >= 0) o += pj * bf2f(pB[(size_t)(b * S + pj_pos) * LPB + 1536 + head * 64 + lane]); }
            }
        }
        yb[(size_t)tg * 256 + hs * 64 + lane] = (bf16)f2bf(o / l);
    }
}
__device__ __forceinline__ float logsigmoid_f(float x) { return fminf(x, 0.f) - log1pf(__expf(-fabsf(x))); }
__device__ __forceinline__ void nv_gla_phase(const bf16* pA2, const float* cbal, bf16* yc) {
    const int lane = threadIdx.x & 63, gw = blockIdx.x * NWAVES + (threadIdx.x >> 6), NGW = gridDim.x * NWAVES;
    for (int item = gw; item < NB * 4 * 128; item += NGW) {
        const int b = item >> 9, h = (item >> 7) & 3, dv = item & 127;
        const float bias = cbal[h * 64 + lane];
        float St = 0.f;
        for (int t = 0; t < S; ++t) { const bf16* rp = pA2 + (size_t)(b * S + t) * LA2;
            const float a = __expf(logsigmoid_f(bf2f(rp[A2_CAL + h * 64 + lane]) + bias) * (1.0f / 16.0f));
            const float k = bf2f(rp[A2_CK + h * 64 + lane]), qv = bf2f(rp[A2_CQ + h * 64 + lane]), v = bf2f(rp[A2_CV + h * 128 + dv]);
            St = a * St + k * v;
            const float o = wave_sum(qv * St);
            if (lane == 0) yc[(size_t)(b * S + t) * 512 + h * 128 + dv] = (bf16)f2bf(o); }
    }
}
__device__ __forceinline__ void nv_gla_out_phase(const bf16* pA2, const float* cng, bf16* yc) {
    const int lane = threadIdx.x & 63, gw = blockIdx.x * NWAVES + (threadIdx.x >> 6), NGW = gridDim.x * NWAVES;
    for (int item = gw; item < T * 4; item += NGW) { const int r = item >> 2, h = item & 3;
        const unsigned po = *(const unsigned*)(yc + (size_t)r * 512 + h * 128 + 2 * lane), pg = *(const unsigned*)(pA2 + (size_t)r * LA2 + A2_CG + h * 128 + 2 * lane);
        const float o0 = blo(po), o1 = bhi(po), g0 = blo(pg), g1 = bhi(pg);
        const float rstd = __builtin_amdgcn_rsqf(wave_sum(o0 * o0 + o1 * o1) * (1.0f / 128.0f) + RMS_EPS);
        const float y0 = o0 * rstd * cng[2 * lane] * (g0 / (1.0f + __expf(-g0))), y1 = o1 * rstd * cng[2 * lane + 1] * (g1 / (1.0f + __expf(-g1)));
        *(unsigned*)(yc + (size_t)r * 512 + h * 128 + 2 * lane) = pk2(y0, y1); }
}
constexpr int NPH = 19;
template <int MASK> __device__ __forceinline__ void mk_body(const Args& args) {
    extern __shared__ __attribute__((aligned(16))) unsigned char lds_raw[];
    LAS unsigned char* lds = (LAS unsigned char*)lds_raw;
    volatile LAS unsigned* MISC = (volatile LAS unsigned*)(lds + MISC_OFF);
    const int tid = threadIdx.x;
    unsigned char* ws = args.ws;
    unsigned* ctl = (unsigned*)(ws + WS_CTL);
    for (int u = tid; u < (LDS_BYTES - RING_BYTES) / 4; u += NTHR) ((LAS unsigned*)(lds + RING_BYTES))[u] = 0u;
    __syncthreads();
    const bool multi = (args.ph_hi - args.ph_lo) > 1;
    XcdBarrier bar; bar.bar = ctl + CW_BAR; bar.x = 0; bar.st = nullptr;
    if (multi) bar = xcd_barrier_post(ctl + CW_BAR, MISC + 8);
    const int lo = args.ph_lo, hi = args.ph_hi;

    float* out = args.out;
    LAS float* scr = (LAS float*)lds;
#define PTRS unsigned char* wq_ = opaque_ptr(args.ws); bf16* W = (bf16*)(wq_ + WS_W); float* cs = (float*)(wq_ + WS_CS); bf16* XN = (bf16*)(wq_ + WS_XN); bf16* FB = (bf16*)(wq_ + WS_FB); \
    unsigned short* SEL = (unsigned short*)(wq_ + WS_FB); bf16* REC = (bf16*)(wq_ + WS_FB + 8 * MiB); bf16* YB = (bf16*)(wq_ + WS_YB); bf16* YA = (bf16*)(wq_ + WS_YA); bf16* YC = (bf16*)(wq_ + WS_YC); bf16* BIG = (bf16*)(wq_ + WS_BIG); \
    (void)W; (void)cs; (void)XN; (void)FB; (void)SEL; (void)REC; (void)YB; (void)YA; (void)YC; (void)BIG;

#define IN(k) ((((MASK) >> (k)) & 1) && lo <= (pb + (k)) && (pb + (k)) < hi)
#define SEAM(k) do { if (IN(k) && (pb + (k) + 1) < hi) xcd_barrier(bar); } while (0)
#pragma unroll 1
    for (int l = 0; l < DEPTH; ++l) {
        const int pb = l * NPH;
        if (IN(0)) { PTRS if (l == 0) { cs_phase((const int*)args.in[I_POS], cs); resid_phase(args.in[I_X], out, nullptr, 0.f, nullptr, args.in[I_F1PRE] + l * D, XN);
                cvt_ffn(args.in[I_F1WIN], args.in[I_F1WOUT], W + WO_W1, W + WO_W2, scr); } }
        SEAM(0);
        if (IN(1)) { PTRS pg8::Gemm g{XN, W + WO_W1, T, 2 * DFF, D}; pg8::StaticOrder So; So.init(T, 2 * DFF, gridDim.x, blockIdx.x); pg8::EpiSwiglu E{BIG, DFF};
            pg8::gemm_phase<pg8::EpiSwiglu, pg8::StaticOrder, true, true>(lds, g, So, E); }
        SEAM(1);
        if (IN(2)) { PTRS pg8::Gemm g{BIG, W + WO_W2, T, D, DFF}; pg8::StaticOrder So; So.init(T, D, gridDim.x, blockIdx.x); pg8::EpiStore E{FB, D};
            pg8::gemm_phase<pg8::EpiStore, pg8::StaticOrder, true, true>(lds, g, So, E); }
        SEAM(2);
        if (IN(3)) { PTRS resid_phase(out, out, FB, 0.5f, args.in[I_F1POST] + l * D, args.in[I_MIXPRE] + l * D, XN); cvt_mixer(args, l, W, scr); }
        SEAM(3);
        if (IN(4)) { PTRS pg8::Gemm g{XN, W + WO_BIG + (size_t)RB0 * D, T, NRB, D}; pg8::StaticOrder So; So.init(T, NRB, gridDim.x, blockIdx.x);
            pg8::EpiProj<0> E{BIG, LPB, 1000, BIG, LPB, cs, nullptr};
            pg8::gemm_phase<pg8::EpiProj<0>, pg8::StaticOrder, true, true>(lds, g, So, E); }
        SEAM(4);
        if (IN(5)) { PTRS nv_attb_phase(BIG, YB, lds); }
        SEAM(5);
        if (IN(6)) { PTRS pg8::Gemm g{XN, W + WO_BIG + (size_t)RAC0 * D, T, NRAC, D}; pg8::StaticOrder So; So.init(T, NRAC, gridDim.x, blockIdx.x);
            pg8::EpiProj<1> E{YA, 1024, 4, BIG, LA2, cs, nullptr};
            pg8::gemm_phase<pg8::EpiProj<1>, pg8::StaticOrder, true, true>(lds, g, So, E); }
        SEAM(6);
        if (IN(7)) { PTRS rec_phase(BIG, args.in[I_AKVG] + l * 128, cs, REC); nv_gla_phase(BIG, args.in[I_CBAL] + l * 256, YC); }
        SEAM(7);
        if (IN(8)) { PTRS nv_gla_out_phase(BIG, args.in[I_CNORM] + l * 128, YC); }
        SEAM(8);
        SEAM(9);
        if (IN(10)) { PTRS nv_idx_phase(BIG, SEL, lds); }
        SEAM(10);
        if (IN(11)) { PTRS nv_atta_phase(BIG, YA, REC, SEL, lds); }
        SEAM(11);
        if (IN(12)) { PTRS pg8::Gemm g{XN, W + WO_BIG + (size_t)RG0 * D, T, NRG, D}; pg8::StaticOrder So; So.init(T, NRG, gridDim.x, blockIdx.x);
            pg8::EpiProj<2> E{BIG, 3072, 1000, BIG, 3072, cs, args.in[I_BGATE] + l * 3072};
            pg8::gemm_phase<pg8::EpiProj<2>, pg8::StaticOrder, true, true>(lds, g, So, E); }
        SEAM(12);
        if (IN(13)) { PTRS pg8::StaticOrder So; So.init(T, D, gridDim.x, blockIdx.x);
            { pg8::Gemm g{YA, W + WO_MA, T, D, 1024}; pg8::EpiMerge<true> E{XN, D, BIG, 3072, 0}; pg8::gemm_phase<pg8::EpiMerge<true>, pg8::StaticOrder, true, true>(lds, g, So, E); }
            VM_WAIT(); __syncthreads();
            { pg8::Gemm g{YB, W + WO_MB, T, D, 256}; pg8::EpiMerge<false> E{XN, D, BIG, 3072, 1024}; pg8::gemm_phase<pg8::EpiMerge<false>, pg8::StaticOrder, true, true>(lds, g, So, E); }
            VM_WAIT(); __syncthreads();
            { pg8::Gemm g{YC, W + WO_MC, T, D, 512}; pg8::EpiMerge<false> E{XN, D, BIG, 3072, 2048}; pg8::gemm_phase<pg8::EpiMerge<false>, pg8::StaticOrder, true, true>(lds, g, So, E); } }
        SEAM(13);
        if (IN(14)) { PTRS pg8::Gemm g{XN, W + WO_WO, T, D, D}; pg8::StaticOrder So; So.init(T, D, gridDim.x, blockIdx.x); pg8::EpiStore E{FB, D};
            pg8::gemm_phase<pg8::EpiStore, pg8::StaticOrder, true, true>(lds, g, So, E); }
        SEAM(14);
        if (IN(15)) { PTRS resid_phase(out, out, FB, 1.0f, args.in[I_MIXPOST] + l * D, args.in[I_F2PRE] + l * D, XN);
            cvt_ffn(args.in[I_F2WIN] + (size_t)l * D * 2 * DFF, args.in[I_F2WOUT] + (size_t)l * DFF * D, W + WO_W1, W + WO_W2, scr); }
        SEAM(15);
        if (IN(16)) { PTRS pg8::Gemm g{XN, W + WO_W1, T, 2 * DFF, D}; pg8::StaticOrder So; So.init(T, 2 * DFF, gridDim.x, blockIdx.x); pg8::EpiSwiglu E{BIG, DFF};
            pg8::gemm_phase<pg8::EpiSwiglu, pg8::StaticOrder, true, true>(lds, g, So, E); }
        SEAM(16);
        if (IN(17)) { PTRS pg8::Gemm g{BIG, W + WO_W2, T, D, DFF}; pg8::StaticOrder So; So.init(T, D, gridDim.x, blockIdx.x); pg8::EpiStore E{FB, D};
            pg8::gemm_phase<pg8::EpiStore, pg8::StaticOrder, true, true>(lds, g, So, E); }
        SEAM(17);
        if (IN(18)) { PTRS if (l + 1 < DEPTH) { resid_phase(out, out, FB, 0.5f, args.in[I_F2POST] + l * D, args.in[I_F1PRE] + (l + 1) * D, XN);
                cvt_ffn(args.in[I_F1WIN] + (size_t)(l + 1) * D * 2 * DFF, args.in[I_F1WOUT] + (size_t)(l + 1) * DFF * D, W + WO_W1, W + WO_W2, scr); }
            else resid_phase(out, out, FB, 0.5f, args.in[I_F2POST] + l * D, nullptr, nullptr); }
        SEAM(18);
    }
#undef IN
#undef SEAM
}
template <int MASK> __global__ void __launch_bounds__(NTHR, 2) mk_fwd(Args args) { mk_body<MASK>(args); }

#define MK_PHASES(X) X(0) X(1) X(2) X(3) X(4) X(5) X(6) X(7) X(8) X(10) X(11) X(12) X(13) X(14) X(15) X(16) X(17) X(18)
static void launch_phase(int k, int grid, hipStream_t stream, const Args& a) {
    switch (k) {
#define X(K) case K: hipLaunchKernelGGL(mk_fwd<(1 << K)>, dim3(grid), dim3(NTHR), LDS_BYTES, stream, a); break;
        MK_PHASES(X)
#undef X
        default: break;
    }
}
static bool set_lds_attr() {
    bool ok = true;
#define X(K) ok = ok && (hipFuncSetAttribute((const void*)mk_fwd<(1 << K)>, hipFuncAttributeMaxDynamicSharedMemorySize, LDS_BYTES) == hipSuccess);
    MK_PHASES(X)
#undef X
#if MK_ONE_LAUNCH
    ok = ok && (hipFuncSetAttribute((const void*)mk_fwd<0x7ffff>, hipFuncAttributeMaxDynamicSharedMemorySize, LDS_BYTES) == hipSuccess);
#endif
    return ok;
}
extern "C" void kernel_launch(void* const* d_in, const int* in_sizes, int n_in, void* d_out, int out_size, void* d_ws, size_t ws_size, hipStream_t stream) {
    static int grid = 0;
    if (grid == 0) {
        if (n_in != 24 || out_size != T * D || ws_size < WS_END) { fprintf(stderr, "kernel_launch: unexpected shapes (n_in %d out %d ws %zu)\n", n_in, out_size, ws_size); grid = -1; return; }
        int dev = 0, cus = 0;
        if (hipGetDevice(&dev) != hipSuccess || hipDeviceGetAttribute(&cus, hipDeviceAttributeMultiprocessorCount, dev) != hipSuccess) { grid = -1; return; }
        if (!set_lds_attr()) { fprintf(stderr, "kernel_launch: hipFuncSetAttribute failed\n"); grid = -1; return; }
        int per_cu = 0;
        if (hipOccupancyMaxActiveBlocksPerMultiprocessor(&per_cu, (const void*)mk_fwd<MK_ONE_LAUNCH ? 0x7ffff : 2>, NTHR, LDS_BYTES) != hipSuccess || per_cu < 1) fprintf(stderr, "kernel_launch: occupancy query reports %d\n", per_cu);
        (void)hipGetLastError();
        grid = cus;
    }
    if (grid < 0) return;
    (void)hipMemsetAsync((char*)d_ws + WS_CTL, 0, CTL_ZERO_BYTES, stream);
#ifdef MK_SKIP
    if ((MK_SKIP >> 12) & 1) (void)hipMemsetAsync((char*)d_ws + WS_BIG, 0x3f, 96 * MiB, stream);
    if ((MK_SKIP >> 6) & 1) (void)hipMemsetAsync((char*)d_ws + WS_YA, 0x3c, 32 * MiB, stream);
    (void)hipMemsetAsync((char*)d_ws + WS_YB, 0, 8 * MiB, stream); (void)hipMemsetAsync((char*)d_ws + WS_YC, 0, 16 * MiB, stream);
#endif
    Args a{};
    for (int i = 0; i < 24; ++i) a.in[i] = (const float*)d_in[i];
    a.out = (float*)d_out; a.ws = (unsigned char*)d_ws;
#if MK_ONE_LAUNCH
    a.ph_lo = 0; a.ph_hi = DEPTH * NPH;
    hipLaunchKernelGGL(mk_fwd<0x7ffff>, dim3(grid), dim3(NTHR), LDS_BYTES, stream, a);
#else
    for (int p = 0; p < DEPTH * NPH; ++p) {
        const int k = p % NPH, l = p / NPH;
        if ((k == 0 && l > 0) || k == 9) continue;
#ifdef MK_SKIP
        if ((MK_SKIP >> k) & 1) continue;
#endif
        a.ph_lo = p; a.ph_hi = p + 1;
        launch_phase(k, grid, stream, a);
    }
#endif
}
```

```cpp
#define MK_ONE_LAUNCH 2
#include <hip/hip_runtime.h>
#include <cstdio>
#include <cstdint>
#define GAS __attribute__((address_space(1)))
#define LAS __attribute__((address_space(3)))
#ifndef MK_ONE_LAUNCH
#define MK_ONE_LAUNCH 0
#endif
namespace pg8 {
#define PG8_LAS __attribute__((address_space(3)))
typedef unsigned short bf16_t;
typedef short bf16x8 __attribute__((ext_vector_type(8)));
typedef float f32x4 __attribute__((ext_vector_type(4)));
typedef unsigned u32x4 __attribute__((ext_vector_type(4)));
constexpr int BM = 256, BK = 64, HALF = 128, HTB = HALF * BK * 2  , STAGE_BYTES = 8 * HTB, NXCD = 8, WGM = 8;

__host__ __device__ __forceinline__ int lds_byte(int r, int c) { const int st = (r >> 4) * 2 + (c >> 5), rr = r & 15, cc = c & 31, ob = rr * 64 + cc * 2; return st * 1024 + (ob ^ (((ob >> 9) & 1) << 5)); }
__host__ __device__ __forceinline__ void stage_rc(int b, int& R, int& C) { const int st = b / 1024, sb = b % 1024, swz = sb ^ (((sb >> 9) & 1) << 5); R = (st >> 1) * 16 + swz / 64; C = (st & 1) * 32 + (swz % 64) / 2; }
__host__ __device__ __forceinline__ int perm32(int rho) { const int n = rho >> 4, i = rho & 15; return 8 * (i >> 2) + 4 * n + (i & 3); }

struct Unit { int pm, pn; };
struct Gemm { const bf16_t* A; const bf16_t* Bt; int M, N, K; };

struct StaticOrder {
    int nM, nN, nwg, G, c;
    __host__ __device__ void init(int M, int N, int G_, int c_) { nM = M / BM; nN = N / BM; nwg = nM * nN; G = G_; c = c_; }
    __host__ __device__ bool next(int i, Unit& u) const {
        const long L = (long)i * G + c; if (L >= nwg) return false;
        int wgid = (int)L; { const int q = nwg / NXCD, r = nwg % NXCD, xcd = wgid % NXCD, off = wgid / NXCD; wgid = (xcd < r ? xcd * (q + 1) : r * (q + 1) + (xcd - r) * q) + off; }
        const int nig = WGM * nN, gid = wgid / nig, fm = gid * WGM, gsz = (nM - fm) < WGM ? (nM - fm) : WGM;
        u.pm = fm + ((wgid % nig) % gsz); u.pn = (wgid % nig) / gsz; return true;
    }
    __device__ __forceinline__ void a_ready(const Unit&) const {}
    __device__ __forceinline__ void done(const Unit&) const {}
};

typedef float f32x2_t_ __attribute__((ext_vector_type(2))); typedef __bf16 bf16x2_t_ __attribute__((ext_vector_type(2)));
__device__ __forceinline__ unsigned cvt_pk_bf16(float lo, float hi) { const f32x2_t_ v = {lo, hi}; const bf16x2_t_ b = __builtin_convertvector(v, bf16x2_t_); return __builtin_bit_cast(unsigned, b); }
typedef float f32x2 __attribute__((ext_vector_type(2)));
__device__ __forceinline__ float bflo(unsigned w) { return __uint_as_float(w << 16); }
__device__ __forceinline__ float bfhi(unsigned w) { return __uint_as_float(w & 0xffff0000u); }
__device__ __forceinline__ u32x4 pack8(const f32x4 a, const f32x4 b) { u32x4 w; w.x = cvt_pk_bf16(a[0], a[1]); w.y = cvt_pk_bf16(a[2], a[3]); w.z = cvt_pk_bf16(b[0], b[1]); w.w = cvt_pk_bf16(b[2], b[3]); return w; }
__device__ __forceinline__ float fast_sigmoid(float x) { return __builtin_amdgcn_rcpf(1.0f + __expf(-x)); }

struct EpiSwiglu {
    static constexpr bool PERM = true, AFTER_DRAIN = false;
    bf16_t* O; int ldc;
    __device__ __forceinline__ void operator()(const f32x4 (&acc)[2][2][4][2], const Unit& u, int wr, int wc, int fr, int fq) const {
        const int row0 = u.pm * BM + wr * 64 + fr, col0 = u.pn * HALF + wc * 32 + 8 * fq;
#pragma unroll
        for (int ai = 0; ai < 2; ++ai)
#pragma unroll
            for (int m = 0; m < 4; ++m) { bf16_t* rowp = O + (size_t)(row0 + ai * HALF + m * 16) * ldc + col0;
                f32x4 o0, o1;
#pragma unroll
                for (int j = 0; j < 4; ++j) { const float g0 = acc[ai][0][m][0][j], g1 = acc[ai][0][m][1][j];
                    o0[j] = g0 * fast_sigmoid(g0) * acc[ai][1][m][0][j]; o1[j] = g1 * fast_sigmoid(g1) * acc[ai][1][m][1][j]; }
                *(u32x4*)rowp = pack8(o0, o1); asm volatile("" ::: "memory"); }
    }
};
struct EpiStore {
    static constexpr bool PERM = true, AFTER_DRAIN = false;
    bf16_t* O; int ldc;
    __device__ __forceinline__ void operator()(const f32x4 (&acc)[2][2][4][2], const Unit& u, int wr, int wc, int fr, int fq) const {
        const int row0 = u.pm * BM + wr * 64 + fr, col0 = u.pn * BM + wc * 32 + 8 * fq;
#pragma unroll
        for (int ai = 0; ai < 2; ++ai)
#pragma unroll
            for (int m = 0; m < 4; ++m) { bf16_t* rowp = O + (size_t)(row0 + ai * HALF + m * 16) * ldc + col0;
#pragma unroll
                for (int bj = 0; bj < 2; ++bj) *(u32x4*)(rowp + bj * HALF) = pack8(acc[ai][bj][m][0], acc[ai][bj][m][1]); }
    }
};
enum { PM_PLAIN = 0, PM_ROPE64 = 1, PM_ROPE16 = 2, PM_SIGMOID = 3 };
template <int RANGE> __device__ __forceinline__ int proj_mode(int gcol) {
    if (RANGE == 0) return gcol < 1536 ? PM_ROPE64 : PM_PLAIN;
    if (RANGE == 1) { if (gcol < 1024) return PM_PLAIN; const int g2 = gcol - 1024;
        return g2 < 128 ? PM_ROPE16 : (g2 < 704 ? PM_ROPE64 : PM_PLAIN); }
    return PM_SIGMOID;
}
template <int RANGE> struct EpiProj {
    static constexpr bool PERM = true, AFTER_DRAIN = false;
    bf16_t* d0; int ld0; int nt0; bf16_t* d1; int ld1; const float* cs; const float* bias;
    __device__ __forceinline__ void operator()(const f32x4 (&acc)[2][2][4][2], const Unit& u, int wr, int wc, int fr, int fq) const {
        const int row0 = u.pm * BM + wr * 64 + fr;
        bf16_t* dbase; int ld;
        if (u.pn < nt0) { dbase = d0 + u.pn * BM; ld = ld0; } else { dbase = d1 + (u.pn - nt0) * BM; ld = ld1; }
#pragma unroll
        for (int bj = 0; bj < 2; ++bj) {
            const int gcol = u.pn * BM + bj * HALF + wc * 32;
            const int mode = proj_mode<RANGE>(gcol);
            const bool rope = (mode == PM_ROPE16) || (mode == PM_ROPE64 && (wc & 1) == 0);
            const bool lane_rope = (mode == PM_ROPE16) || (fq < 2);
            f32x4 b0 = (f32x4){0.f, 0.f, 0.f, 0.f}, b1 = b0;
#ifndef MK_NOBIAS
            if (mode == PM_SIGMOID) { b0 = *(const f32x4*)(bias + gcol + 8 * fq); b1 = *(const f32x4*)(bias + gcol + 8 * fq + 4); }
#endif
#pragma unroll
            for (int ai = 0; ai < 2; ++ai)
#pragma unroll
                for (int m = 0; m < 4; ++m) {
                    const int r = row0 + ai * HALF + m * 16;
                    f32x4 v0 = acc[ai][bj][m][0], v1 = acc[ai][bj][m][1];
                    if (rope) {
                        const float sg = (fq & 1) ? 1.0f : -1.0f;
                        { const f32x4 c0 = *(const f32x4*)(cs + (size_t)r * 16), s0 = *(const f32x4*)(cs + (size_t)r * 16 + 8); f32x4 p0;
#pragma unroll
                          for (int j = 0; j < 4; ++j) p0[j] = __shfl_xor(v0[j], 16);
                          if (lane_rope) v0 = v0 * c0 + sg * (p0 * s0); }
                        asm volatile("" ::: "memory");
                        { const f32x4 c1 = *(const f32x4*)(cs + (size_t)r * 16 + 4), s1 = *(const f32x4*)(cs + (size_t)r * 16 + 12); f32x4 p1;
#pragma unroll
                          for (int j = 0; j < 4; ++j) p1[j] = __shfl_xor(v1[j], 16);
                          if (lane_rope) v1 = v1 * c1 + sg * (p1 * s1); }
                    }
                    if (mode == PM_SIGMOID) {
#pragma unroll
                        for (int j = 0; j < 4; ++j) { v0[j] = fast_sigmoid(v0[j] + b0[j]); v1[j] = fast_sigmoid(v1[j] + b1[j]); }
                    }
                    *(u32x4*)(dbase + (size_t)r * ld + bj * HALF + wc * 32 + 8 * fq) = pack8(v0, v1);
                    asm volatile("" ::: "memory");
                }
        }
    }
};
template <bool FIRST> struct EpiMerge {
    static constexpr bool PERM = true, AFTER_DRAIN = false;
    bf16_t* O; int ldc; const bf16_t* G; int ldg; int gcol;
    __device__ __forceinline__ void operator()(const f32x4 (&acc)[2][2][4][2], const Unit& u, int wr, int wc, int fr, int fq) const {
        const int row0 = u.pm * BM + wr * 64 + fr, col0 = u.pn * BM + wc * 32 + 8 * fq;
#pragma unroll
        for (int ai = 0; ai < 2; ++ai)
#pragma unroll
            for (int m = 0; m < 4; ++m) { const int r = row0 + ai * HALF + m * 16;
#pragma unroll
                for (int bj = 0; bj < 2; ++bj) {
                    const u32x4 g = *(const u32x4*)(G + (size_t)r * ldg + gcol + col0 + bj * HALF);
                    f32x4 o0, o1;
                    o0[0] = bflo(g.x) * acc[ai][bj][m][0][0]; o0[1] = bfhi(g.x) * acc[ai][bj][m][0][1]; o0[2] = bflo(g.y) * acc[ai][bj][m][0][2]; o0[3] = bfhi(g.y) * acc[ai][bj][m][0][3];
                    o1[0] = bflo(g.z) * acc[ai][bj][m][1][0]; o1[1] = bfhi(g.z) * acc[ai][bj][m][1][1]; o1[2] = bflo(g.w) * acc[ai][bj][m][1][2]; o1[3] = bfhi(g.w) * acc[ai][bj][m][1][3];
                    bf16_t* op = O + (size_t)r * ldc + col0 + bj * HALF;
                    if (!FIRST) { const u32x4 p = *(const u32x4*)op;
                        o0[0] += bflo(p.x); o0[1] += bfhi(p.x); o0[2] += bflo(p.y); o0[3] += bfhi(p.y); o1[0] += bflo(p.z); o1[1] += bfhi(p.z); o1[2] += bflo(p.w); o1[3] += bfhi(p.w); }
                    *(u32x4*)op = pack8(o0, o1); asm volatile("" ::: "memory"); } }
    }
};

template <class Epi, class Sched, bool ALIGN_EPI = false, bool SP2 = false>
__device__ __forceinline__ void gemm_phase(PG8_LAS unsigned char* lds, const Gemm g, const Sched& S, const Epi& E) {
    int tid_o = threadIdx.x; asm volatile("" : "+v"(tid_o));
    const int tid = tid_o, wid = __builtin_amdgcn_readfirstlane(tid >> 6), lane = tid & 63, wr = wid >> 2, wc = wid & 3, fr = lane & 15, fq = lane >> 4;
    const int K = g.K, nt = K / BK;
    unsigned voffA[2], voffB[2];
#pragma unroll
    for (int i = 0; i < 2; ++i) { int R, C; stage_rc(tid * 16 + i * 8192, R, C); const int Rb = Epi::PERM ? ((R & ~31) + perm32(R & 31)) : R;
        voffA[i] = (unsigned)(R * K + C) * 2u; voffB[i] = (unsigned)(Rb * K + C) * 2u; }
    const size_t kstep = (size_t)(BK * 2);
    const size_t hstep = (size_t)HALF * K * 2;
    const size_t tstep = 2 * hstep;
    const unsigned ldsw = (unsigned)wid * 1024u;
    const int aoff = lds_byte(wr * 64 + fr, fq * 8), boff = lds_byte(wc * 32 + fr, fq * 8);
#define PG8_SA(b, h) (((b) * 2 + (h)) * HTB)
#define PG8_SB(b, h) ((4 + (b) * 2 + (h)) * HTB)
#define PG8_STAGE(bufoff, gbase, voff) do { _Pragma("unroll") for (int _i = 0; _i < 2; ++_i) \
        __builtin_amdgcn_global_load_lds((const unsigned*)((const char*)(gbase) + (voff)[_i]), (PG8_LAS unsigned*)(lds + (bufoff) + ldsw + _i * 8192), 16, 0, 0); } while (0)
#define PG8_LDA(dst, b, h) do { _Pragma("unroll") for (int m = 0; m < 4; ++m) _Pragma("unroll") for (int k = 0; k < 2; ++k) dst[m][k] = *(const PG8_LAS bf16x8*)(lds + PG8_SA(b, h) + aoff + m * 2048 + k * 1024); } while (0)
#define PG8_LDB(dst, b, h) do { _Pragma("unroll") for (int n = 0; n < 2; ++n) _Pragma("unroll") for (int k = 0; k < 2; ++k) dst[n][k] = *(const PG8_LAS bf16x8*)(lds + PG8_SB(b, h) + boff + n * 2048 + k * 1024); } while (0)
#define PG8_MMA(ai, bj, At, Bt) do { __builtin_amdgcn_s_setprio(1); _Pragma("unroll") for (int m = 0; m < 4; ++m) _Pragma("unroll") for (int n = 0; n < 2; ++n) _Pragma("unroll") for (int k = 0; k < 2; ++k) \
        acc[ai][bj][m][n] = __builtin_amdgcn_mfma_f32_16x16x32_bf16(Bt[n][k], At[m][k], acc[ai][bj][m][n], 0, 0, 0); __builtin_amdgcn_s_setprio(0); } while (0)
#define PG8_WAIT_V(n) asm volatile("s_waitcnt vmcnt(" #n ")" ::: "memory")
#define PG8_WAIT_L(n) asm volatile("s_waitcnt lgkmcnt(" #n ")" ::: "memory")
#define PG8_BAR __builtin_amdgcn_s_barrier()
#define PG8_SCHED __builtin_amdgcn_sched_barrier(0)
    Unit cur, nxt; int ui = 0;
    if (!S.next(0, cur)) return;
    f32x4 acc[2][2][4][2];
#pragma unroll
    for (int a = 0; a < 2; ++a)
#pragma unroll
        for (int b = 0; b < 2; ++b)
#pragma unroll
            for (int m = 0; m < 4; ++m)
#pragma unroll
                for (int n = 0; n < 2; ++n) acc[a][b][m][n] = (f32x4){0.f, 0.f, 0.f, 0.f};
    bf16x8 At[4][2], B0[2][2], B1[2][2];
    const char* cA = (const char*)g.A + (size_t)cur.pm * tstep; const char* cB = (const char*)g.Bt + (size_t)cur.pn * tstep;
    S.a_ready(cur);
    if constexpr (SP2) {
        PG8_STAGE(PG8_SB(0, 0), cB, voffB); PG8_STAGE(PG8_SB(0, 1), cB + hstep, voffB); PG8_STAGE(PG8_SA(0, 0), cA, voffA); PG8_STAGE(PG8_SA(0, 1), cA + hstep, voffA);
        if (wr == 1) PG8_BAR;
        PG8_WAIT_V(2); PG8_BAR;
        PG8_STAGE(PG8_SB(1, 0), cB + kstep, voffB); PG8_STAGE(PG8_SA(1, 0), cA + kstep, voffA); PG8_STAGE(PG8_SB(1, 1), cB + hstep + kstep, voffB);
        PG8_WAIT_V(6); PG8_BAR;
    } else {
        PG8_STAGE(PG8_SB(0, 0), cB, voffB); PG8_STAGE(PG8_SA(0, 0), cA, voffA); PG8_STAGE(PG8_SB(0, 1), cB + hstep, voffB); PG8_STAGE(PG8_SA(0, 1), cA + hstep, voffA);
        if (wr == 1) PG8_BAR;
        PG8_WAIT_V(4); PG8_BAR;
        PG8_STAGE(PG8_SB(1, 0), cB + kstep, voffB); PG8_STAGE(PG8_SA(1, 0), cA + kstep, voffA); PG8_STAGE(PG8_SB(1, 1), cB + hstep + kstep, voffB);
        PG8_WAIT_V(6); PG8_BAR;
    }
    for (;;) {
        const bool has_next = S.next(ui + 1, nxt);
        const char* nA = has_next ? (const char*)g.A + (size_t)nxt.pm * tstep : cA; const char* nB = has_next ? (const char*)g.Bt + (size_t)nxt.pn * tstep : cB;
        for (int t = 0; t < nt; t += 2) {
            const bool last = (t == nt - 2);
            const char* a1 = cA + (size_t)(t + 1) * kstep;
            const char* a2 = last ? nA : cA + (size_t)(t + 2) * kstep; const char* b2 = last ? nB : cB + (size_t)(t + 2) * kstep;
            const char* a3 = a2 + kstep; const char* b3 = b2 + kstep;
            if (last && has_next) S.a_ready(nxt);
            if constexpr (SP2) {
            PG8_LDB(B0, 0, 0); PG8_LDB(B1, 0, 1); PG8_SCHED; PG8_LDA(At, 0, 0); PG8_STAGE(PG8_SA(1, 1), a1 + hstep, voffA);
            PG8_WAIT_V(8); PG8_WAIT_L(0); PG8_BAR; PG8_MMA(0, 0, At, B0); PG8_MMA(0, 1, At, B1); PG8_BAR; PG8_SCHED;
            PG8_LDA(At, 0, 1); PG8_STAGE(PG8_SB(0, 0), b2, voffB); PG8_STAGE(PG8_SB(0, 1), b2 + hstep, voffB); PG8_STAGE(PG8_SA(0, 0), a2, voffA);
            PG8_WAIT_V(8); PG8_WAIT_L(0); PG8_BAR; PG8_MMA(1, 0, At, B0); PG8_MMA(1, 1, At, B1); PG8_BAR; PG8_SCHED;
            PG8_LDB(B0, 1, 0); PG8_LDB(B1, 1, 1); PG8_SCHED; PG8_LDA(At, 1, 0); PG8_STAGE(PG8_SA(0, 1), a2 + hstep, voffA);
            PG8_WAIT_V(8); PG8_WAIT_L(0); PG8_BAR; PG8_MMA(0, 0, At, B0); PG8_MMA(0, 1, At, B1); PG8_BAR; PG8_SCHED;
            PG8_LDA(At, 1, 1); PG8_STAGE(PG8_SB(1, 0), b3, voffB); PG8_STAGE(PG8_SB(1, 1), b3 + hstep, voffB); PG8_STAGE(PG8_SA(1, 0), a3, voffA);
            PG8_WAIT_V(8); PG8_WAIT_L(0); PG8_BAR; PG8_MMA(1, 0, At, B0); PG8_MMA(1, 1, At, B1); PG8_BAR; PG8_SCHED;
            } else {
            PG8_LDB(B0, 0, 0); PG8_SCHED; PG8_LDA(At, 0, 0); PG8_STAGE(PG8_SA(1, 1), a1 + hstep, voffA);
            PG8_WAIT_L(8); PG8_BAR; PG8_WAIT_L(0); PG8_MMA(0, 0, At, B0); PG8_BAR; PG8_SCHED;
            PG8_LDB(B1, 0, 1); PG8_STAGE(PG8_SB(0, 0), b2, voffB);
            PG8_BAR; PG8_WAIT_L(0); PG8_MMA(0, 1, At, B1); PG8_BAR;
            PG8_LDA(At, 0, 1); PG8_STAGE(PG8_SA(0, 0), a2, voffA);
            PG8_BAR; PG8_WAIT_L(0); PG8_MMA(1, 0, At, B0); PG8_BAR; PG8_SCHED;
            PG8_STAGE(PG8_SB(0, 1), b2 + hstep, voffB);
            PG8_WAIT_V(6); PG8_BAR; PG8_MMA(1, 1, At, B1); PG8_BAR;
            PG8_LDB(B0, 1, 0); PG8_SCHED; PG8_LDA(At, 1, 0); PG8_STAGE(PG8_SA(0, 1), a2 + hstep, voffA);
            PG8_WAIT_L(8); PG8_BAR; PG8_WAIT_L(0); PG8_MMA(0, 0, At, B0); PG8_BAR; PG8_SCHED;
            PG8_LDB(B1, 1, 1); PG8_STAGE(PG8_SB(1, 0), b3, voffB);
            PG8_BAR; PG8_WAIT_L(0); PG8_MMA(0, 1, At, B1); PG8_BAR;
            PG8_LDA(At, 1, 1); PG8_STAGE(PG8_SA(1, 0), a3, voffA);
            PG8_BAR; PG8_WAIT_L(0); PG8_MMA(1, 0, At, B0); PG8_BAR; PG8_SCHED;
            PG8_STAGE(PG8_SB(1, 1), b3 + hstep, voffB);
            PG8_WAIT_V(6); PG8_BAR; PG8_MMA(1, 1, At, B1); PG8_BAR;
            }
        }
        if constexpr (ALIGN_EPI) { if (wr == 0) PG8_BAR; }
        if constexpr (!Epi::AFTER_DRAIN) { E(acc, cur, wr, wc, fr, fq); S.done(cur); }
        if (!has_next) break;
#pragma unroll
        for (int a = 0; a < 2; ++a)
#pragma unroll
            for (int b = 0; b < 2; ++b)
#pragma unroll
                for (int m = 0; m < 4; ++m)
#pragma unroll
                    for (int n = 0; n < 2; ++n) acc[a][b][m][n] = (f32x4){0.f, 0.f, 0.f, 0.f};
        cur = nxt; cA = nA; cB = nB; ++ui;
        if constexpr (ALIGN_EPI) { if (wr == 1) PG8_BAR; }
    }
    PG8_WAIT_V(0);
    if constexpr (!ALIGN_EPI) { if (wr == 0) PG8_BAR; }
    PG8_BAR;
    if constexpr (Epi::AFTER_DRAIN) { E.fused(acc, cur, wr, wc, fr, fq, lds, wid, lane); S.done(cur); }
#undef PG8_SA
#undef PG8_SB
#undef PG8_STAGE
#undef PG8_LDA
#undef PG8_LDB
#undef PG8_MMA
#undef PG8_WAIT_V
#undef PG8_WAIT_L
#undef PG8_BAR
#undef PG8_SCHED
}
}
#define XB_TMO      128
#define XB_XCNT(j)  (256  + 64 * (j))
#define XB_XSUB(j)  (1280 + 64 * (j))
#define XB_XGEN(j)  (2304 + 64 * (j))
#define XB_TOP      3328
#define XB_TOPGEN   3392
#define XCD_BAR_WORDS 3456
#define XB_SPIN_CAP (1u << 18)

__device__ __forceinline__ unsigned xb_ld(unsigned* p)              { return __hip_atomic_load(p, __ATOMIC_RELAXED, __HIP_MEMORY_SCOPE_AGENT); }
__device__ __forceinline__ unsigned xb_add(unsigned* p, unsigned v) { return __hip_atomic_fetch_add(p, v, __ATOMIC_RELAXED, __HIP_MEMORY_SCOPE_AGENT); }
__device__ __forceinline__ unsigned xb_xcc_id() { return (unsigned)__builtin_amdgcn_s_getreg((3 << 11) | 20) & 0xFu; }
#define XB_SPIN(cond, bar) do { unsigned _sp = 0; while (cond) { __builtin_amdgcn_s_sleep(1); \
    if ((++_sp & 255u) == 0u) { if (xb_ld(&(bar)[XB_TMO])) break; if (_sp > XB_SPIN_CAP) { atomicAdd(&(bar)[XB_TMO], 1u); break; } } } } while (0)

struct XcdBarrier {
    unsigned* bar; unsigned x;
    volatile LAS unsigned* st;
};

__device__ __forceinline__ XcdBarrier xcd_barrier_post(unsigned* bar, volatile LAS unsigned* st) {
    XcdBarrier b; b.bar = bar; b.x = xb_xcc_id(); b.st = st;
    if (threadIdx.x == 0) (void)xb_add(&bar[XB_XCNT(b.x)], 1u);
    return b;
}
__device__ __forceinline__ void xcd_barrier_complete(unsigned* bar, unsigned x, unsigned& nloc, unsigned& nx) {
    const unsigned G = gridDim.x * gridDim.y * gridDim.z;
    unsigned sum, cnt, mine, sp = 0u;
    for (;;) {
        sum = 0u; cnt = 0u; mine = 0u;
#pragma unroll
        for (unsigned j = 0; j < 16; ++j) { const unsigned c = xb_ld(&bar[XB_XCNT(j)]); sum += c; cnt += (c > 0u) ? 1u : 0u; mine = (j == x) ? c : mine; }
        if (sum == G) break;
        __builtin_amdgcn_s_sleep(1);
        if ((++sp & 255u) == 0u) { if (xb_ld(&bar[XB_TMO])) break; if (sp > XB_SPIN_CAP) { atomicAdd(&bar[XB_TMO], 1u); break; } }
    }
    nloc = mine > 0u ? mine : 1u; nx = cnt > 0u ? cnt : 1u;
}

__device__ __forceinline__ void xcd_barrier(const XcdBarrier& b) {
    asm volatile("s_waitcnt vmcnt(0)" ::: "memory");
    __syncthreads();
    if (threadIdx.x == 0) {
        unsigned* bar = b.bar;
        __builtin_amdgcn_s_waitcnt(0);
        unsigned nloc = b.st[0], nx = b.st[1];
        if (nloc == 0u) { xcd_barrier_complete(bar, b.x, nloc, nx); b.st[0] = nloc; b.st[1] = nx; }
        const unsigned old = xb_add(&bar[XB_XSUB(b.x)], 1u);
        const unsigned gen = old / nloc;
        if (old + 1u == (gen + 1u) * nloc) {
            __builtin_amdgcn_fence(__ATOMIC_RELEASE, "agent");
            asm volatile("s_waitcnt vmcnt(0)" ::: "memory");
            const unsigned og = xb_add(&bar[XB_TOP], 1u);
            const unsigned tg = og / nx;
            if (og + 1u == (tg + 1u) * nx) xb_add(&bar[XB_TOPGEN], 1u);
            else XB_SPIN(xb_ld(&bar[XB_TOPGEN]) == tg, bar);
            __builtin_amdgcn_fence(__ATOMIC_ACQUIRE, "agent");
            xb_add(&bar[XB_XGEN(b.x)], 1u);
            asm volatile("s_waitcnt vmcnt(0)" ::: "memory");
        } else {
            XB_SPIN(xb_ld(&bar[XB_XGEN(b.x)]) == gen, bar);
            __builtin_amdgcn_fence(__ATOMIC_ACQUIRE, "agent");
            asm volatile("s_waitcnt vmcnt(0)" ::: "memory");
        }
    }
    __syncthreads();
}
typedef unsigned short bf16;
typedef unsigned v4u __attribute__((ext_vector_type(4)));
typedef unsigned v2u __attribute__((ext_vector_type(2)));
typedef float f32x4 __attribute__((ext_vector_type(4)));
typedef short bf16x8 __attribute__((ext_vector_type(8)));
constexpr int NB = 2, S = 8192, T = NB * S, D = 1024, DEPTH = 2, DFF = 2816, DIN = 5080;
constexpr int NWAVES = 8, NTHR = 512;
constexpr float RMS_EPS = 1e-6f;
constexpr int WI_AQ = 0, WI_CKV = 512, WI_IQ = 640, WI_IK = 1152, WI_IW = 1216, WI_BQKV = 1224, WI_CQ = 3528, WI_CK = 3784, WI_CV = 4040, WI_CG = 4552, WI_CA = 5064;
constexpr int NBIG = 9216, RB0 = 0, NRB = 2304, RAC0 = 2304, NRAC = 3840, RG0 = 6144, NRG = 3072;
constexpr int LA2 = 2816, A2_QR = 0, A2_IQ = 128, A2_IK = 640, A2_IW = 704, A2_CKV = 768, A2_KR = 896, A2_CQ = 1024, A2_CK = 1280, A2_CV = 1536, A2_CG = 2048, A2_CAL = 2560;
constexpr int LPB = 2304;
constexpr float QSCALE = 0.18033688011112042f;

constexpr size_t MiB = 1u << 20;
constexpr size_t WS_CTL = 0, CTL_ZERO_BYTES = 1 * MiB;
constexpr size_t WS_W = 1 * MiB;
constexpr size_t WS_CS = 25 * MiB;
constexpr size_t WS_XN = 26 * MiB;
constexpr size_t WS_FB = 58 * MiB;
constexpr size_t WS_YB = 90 * MiB;
constexpr size_t WS_YA = 98 * MiB;
constexpr size_t WS_YC = 130 * MiB;
constexpr size_t WS_BIG = 146 * MiB;
constexpr size_t WS_DEC = 242 * MiB;
constexpr size_t WS_END = 243 * MiB;
constexpr size_t WO_W1 = 0, WO_W2 = (size_t)2 * DFF * D;
constexpr size_t WO_BIG = 0, WO_MA = (size_t)NBIG * D, WO_MB = WO_MA + (size_t)D * 1024, WO_MC = WO_MB + (size_t)D * 256, WO_WO = WO_MC + (size_t)D * 512;
static_assert((WO_WO + (size_t)D * D) * 2 <= 24 * MiB && (WO_W2 + (size_t)D * DFF) * 2 <= 24 * MiB, "weights region");
constexpr int CW_BAR = 4096;

constexpr int RING_BYTES = 131072, MISC_OFF = RING_BYTES + 320, LDS_BYTES = 147456;

#define RLX_AGENT __ATOMIC_RELAXED, __HIP_MEMORY_SCOPE_AGENT
#define LDS_WAIT() asm volatile("s_waitcnt lgkmcnt(0)" ::: "memory")
#define VM_WAIT() asm volatile("s_waitcnt vmcnt(0)" ::: "memory")
__device__ __forceinline__ unsigned char* opaque_ptr(unsigned char* p) { GAS unsigned char* g = (GAS unsigned char*)p; asm volatile("" : "+s"(g)); return (unsigned char*)g; }
__device__ __forceinline__ int otid() { int t = threadIdx.x; asm volatile("" : "+v"(t)); return t; }
__device__ __forceinline__ int obid() { int b = blockIdx.x; asm volatile("" : "+s"(b)); return b; }
__device__ __forceinline__ unsigned f2bf(float f) { unsigned u = __builtin_bit_cast(unsigned, f); return (u + 0x7fffu + ((u >> 16) & 1u)) >> 16; }
__device__ __forceinline__ unsigned pk2(float lo, float hi) { return f2bf(lo) | (f2bf(hi) << 16); }
__device__ __forceinline__ float bf2f(bf16 v) { return __uint_as_float((unsigned)v << 16); }
__device__ __forceinline__ float blo(unsigned w) { return __uint_as_float(w << 16); }
__device__ __forceinline__ float bhi(unsigned w) { return __uint_as_float(w & 0xffff0000u); }
__device__ __forceinline__ float wave_sum(float v) {
#pragma unroll
    for (int o = 1; o < 64; o <<= 1) v += __shfl_xor(v, o);
    return v;
}
__device__ __forceinline__ float wave_max(float v) {
#pragma unroll
    for (int o = 1; o < 64; o <<= 1) v = fmaxf(v, __shfl_xor(v, o));
    return v;
}

struct Args {
    const float* in[24]; float* out; unsigned char* ws; int l, pad;
};
enum { I_X = 0, I_POS, I_F1PRE, I_F1WIN, I_F1WOUT, I_F1POST, I_MIXPRE, I_WIN, I_AKVG, I_AWKV, I_CWAL, I_CBAL, I_CNORM, I_WBA, I_WBB, I_WBC, I_WGATE, I_BGATE, I_WOUT, I_MIXPOST, I_F2PRE, I_F2WIN, I_F2WOUT, I_F2POST };

__device__ __forceinline__ void cvt_tile(const float* src, int ld, int col0, int ncols, int k0, bf16* dst, int K, int drow0, float scale, bool zfill, LAS float* scr, int tid) {
    __syncthreads();
#pragma unroll
    for (int i = 0; i < 8; ++i) { const int kk = (tid >> 6) + 8 * i, n = tid & 63; scr[kk * 65 + n] = (n < ncols) ? src[(size_t)(k0 + kk) * ld + col0 + n] * scale : 0.f; }
    __syncthreads();
    const int n = tid >> 3, c = tid & 7;
    if (n < ncols || zfill) { const LAS float* s = scr + (8 * c) * 65 + n;
        v4u o; o.x = pk2(s[0], s[65]); o.y = pk2(s[2 * 65], s[3 * 65]); o.z = pk2(s[4 * 65], s[5 * 65]); o.w = pk2(s[6 * 65], s[7 * 65]);
        *(v4u*)(dst + (size_t)(drow0 + n) * K + k0 + 8 * c) = o; }
}
__device__ __forceinline__ void cvt_block(const float* src, int ld, int col0, int ncols, int K, bf16* dst, int drow0, float scale, bool zfill, LAS float* scr, int& rot) {
    const int G = gridDim.x, nct = (ncols + 63) / 64, nkt = K / 64, nt = nct * nkt;
    for (int t = (obid() - rot % G + G) % G; t < nt; t += G) { const int ct = t / nkt, kt = t % nkt; const int nc = ncols - 64 * ct < 64 ? ncols - 64 * ct : 64;
        cvt_tile(src, ld, col0 + 64 * ct, nc, 64 * kt, dst, K, drow0 + 64 * ct, scale, zfill, scr, otid()); }
    rot += nt;
}
__device__ __forceinline__ void cvt_ffn(const float* w_in, const float* w_out, bf16* W1t, bf16* W2t, LAS float* scr) {
    const int G = gridDim.x;
    constexpr int NRT = 2 * DFF / 64, NKT = D / 64;
    for (int t = obid(); t < NRT * NKT; t += G) { const int rt = t / NKT, kt = t % NKT; const int pn = rt >> 2, w = (rt & 3) * 64;
        const int col = (w < 128) ? 128 * pn + w : DFF + 128 * pn + (w - 128);
        cvt_tile(w_in, 2 * DFF, col, 64, 64 * kt, W1t, D, 64 * rt, 1.0f, false, scr, otid()); }
    int rot = NRT * NKT;
    cvt_block(w_out, D, 0, D, DFF, W2t, 0, 1.0f, false, scr, rot);
}
template <class C> __device__ __forceinline__ void cvt_mixer(const C& a, int l, bf16* W, LAS float* scr) {
    const float* w_in = a.in(I_WIN) + (size_t)l * D * DIN;
    const float* wkv = a.in(I_AWKV) + (size_t)l * 128 * 1024;
    bf16* Wbig = W + WO_BIG;
    int rot = 0;
    cvt_block(w_in, DIN, WI_BQKV, 768, D, Wbig, RB0, QSCALE, false, scr, rot);
    cvt_block(w_in, DIN, WI_BQKV + 768, 1536, D, Wbig, RB0 + 768, 1.0f, false, scr, rot);
    const int R2 = RAC0 + 1024;
#pragma unroll 1
    for (int h = 0; h < 8; ++h) cvt_block(w_in, DIN, WI_AQ + 64 * h, 16, D, Wbig, R2 + A2_QR + 16 * h, QSCALE, false, scr, rot);
    cvt_block(w_in, DIN, WI_IQ, 512, D, Wbig, R2 + A2_IQ, 1.0f, false, scr, rot);
    cvt_block(w_in, DIN, WI_IK, 64, D, Wbig, R2 + A2_IK, 1.0f, false, scr, rot);
    cvt_block(w_in, DIN, WI_IW, 8, D, Wbig, R2 + A2_IW, 1.0f, true, scr, rot);
    cvt_block(w_in, DIN, WI_CKV, 128, D, Wbig, R2 + A2_CKV, 1.0f, false, scr, rot);
    cvt_block(w_in, DIN, WI_CQ, 256, D, Wbig, R2 + A2_CQ, 0.125f, false, scr, rot);
    cvt_block(w_in, DIN, WI_CK, 256 + 512 + 512, D, Wbig, R2 + A2_CK, 1.0f, false, scr, rot);
    cvt_block(a.in(I_WGATE) + (size_t)l * D * 3072, 3072, 0, 3072, D, Wbig, RG0, 1.0f, false, scr, rot);
    cvt_block(a.in(I_WBB) + (size_t)l * 256 * D, D, 0, D, 256, W + WO_MB, 0, 1.0f, false, scr, rot);
    cvt_block(a.in(I_WBC) + (size_t)l * 512 * D, D, 0, D, 512, W + WO_MC, 0, 1.0f, false, scr, rot);
    cvt_block(a.in(I_WOUT) + (size_t)l * D * D, D, 0, D, D, W + WO_WO, 0, 1.0f, false, scr, rot);
    const int gt = obid() * NTHR + otid(), GT = gridDim.x * NTHR;
    for (int e = gt; e < 1024 * D; e += GT) { const int d = e & 1023, rc = e >> 10, h = rc >> 7, c = rc & 127;
        const float* wi = w_in + (size_t)d * DIN + WI_AQ + 64 * h; const float* wk = wkv + (size_t)c * 1024 + 128 * h; float s = 0.f;
#pragma unroll 8
        for (int j = 16; j < 64; ++j) s += wi[j] * wk[j];
        Wbig[(size_t)(RAC0 + rc) * D + d] = (bf16)f2bf(s * QSCALE); }
    const float* gkv = a.in(I_AKVG) + (size_t)l * 128;
    for (int e = gt; e < 128 * D; e += GT) { const int d = e & 1023, rc = e >> 10, h = rc >> 4, i = rc & 15;
        const float* wi = w_in + (size_t)d * DIN + WI_CKV; float s = 0.f;
#pragma unroll 8
        for (int c = 0; c < 128; ++c) s += wi[c] * gkv[c] * wkv[(size_t)c * 1024 + 128 * h + i];
        Wbig[(size_t)(R2 + A2_KR + rc) * D + d] = (bf16)f2bf(s); }
    const float* wal = a.in(I_CWAL) + (size_t)l * 16 * 256;
    for (int e = gt; e < 256 * D; e += GT) { const int d = e & 1023, n = e >> 10;
        const float* wi = w_in + (size_t)d * DIN + WI_CA; float s = 0.f;
#pragma unroll
        for (int r = 0; r < 16; ++r) s += wi[r] * wal[r * 256 + n];
        Wbig[(size_t)(R2 + A2_CAL + n) * D + d] = (bf16)f2bf(s); }
    const float* wba = a.in(I_WBA) + (size_t)l * 512 * D;
    for (int e = gt; e < 1024 * 1024; e += GT) { const int k = e & 1023, n = e >> 10, h = k >> 7, c = k & 127;
        const float* wk = wkv + (size_t)c * 1024 + 128 * h + 64; const float* wb = wba + (size_t)(64 * h) * D + n; float s = 0.f;
#pragma unroll 8
        for (int j = 0; j < 64; ++j) s += wk[j] * wb[(size_t)j * D];
        (W + WO_MA)[(size_t)n * 1024 + k] = (bf16)f2bf(s); }
}

__device__ __forceinline__ void cs_phase(const int* pos, float* cs) {
    const int gt = obid() * NTHR + otid(), GT = gridDim.x * NTHR;
    for (int e = gt; e < T * 8; e += GT) { const int t = e >> 3, i = e & 7;
        const double frev = (i == 0) ? 0.15915494309189535 : (i == 1) ? 0.03086376340470123 : (i == 2) ? 0.005985185712713705 : (i == 3) ? 0.001160663641240061 :
                            (i == 4) ? 0.00022507907903927653 : (i == 5) ? 4.364795279280289e-05 : (i == 6) ? 8.464330808241401e-06 : 1.6414262627950345e-06;
        const double rev = (double)pos[t] * frev; const float fr = (float)(rev - __builtin_floor(rev));
        cs[(size_t)t * 16 + i] = __builtin_amdgcn_cosf(fr); cs[(size_t)t * 16 + 8 + i] = __builtin_amdgcn_sinf(fr); }
}
__device__ __forceinline__ void resid_phase(const float* hin, float* hout, const bf16* f, float w, const float* gpost, const float* gpre, bf16* xn) {
    const int lane = otid() & 63, gw = obid() * NWAVES + (otid() >> 6), NGW = gridDim.x * NWAVES;
    for (int r = gw; r < T; r += NGW) {
        f32x4 v[4];
#pragma unroll
        for (int j = 0; j < 4; ++j) v[j] = *(const f32x4*)(hin + (size_t)r * D + 256 * j + 4 * lane);
        if (f) { f32x4 fv[4]; float s = 0.f;
#pragma unroll
            for (int j = 0; j < 4; ++j) { const v2u p = *(const v2u*)(f + (size_t)r * D + 256 * j + 4 * lane); fv[j] = (f32x4){blo(p.x), bhi(p.x), blo(p.y), bhi(p.y)};
                s += (fv[j][0] * fv[j][0] + fv[j][1] * fv[j][1]) + (fv[j][2] * fv[j][2] + fv[j][3] * fv[j][3]); }
            const float rstd = w * __builtin_amdgcn_rsqf(wave_sum(s) * (1.0f / D) + RMS_EPS);
#pragma unroll
            for (int j = 0; j < 4; ++j) { const f32x4 g = *(const f32x4*)(gpost + 256 * j + 4 * lane); v[j] = v[j] + fv[j] * rstd * g; }
        }
#pragma unroll
        for (int j = 0; j < 4; ++j) *(f32x4*)(hout + (size_t)r * D + 256 * j + 4 * lane) = v[j];
        if (xn) { float s = 0.f;
#pragma unroll
            for (int j = 0; j < 4; ++j) s += (v[j][0] * v[j][0] + v[j][1] * v[j][1]) + (v[j][2] * v[j][2] + v[j][3] * v[j][3]);
            const float rstd = __builtin_amdgcn_rsqf(wave_sum(s) * (1.0f / D) + RMS_EPS);
#pragma unroll
            for (int j = 0; j < 4; ++j) { const f32x4 g = *(const f32x4*)(gpre + 256 * j + 4 * lane); const f32x4 o = v[j] * rstd * g;
                v2u p; p.x = pk2(o[0], o[1]); p.y = pk2(o[2], o[3]); *(v2u*)(xn + (size_t)r * D + 256 * j + 4 * lane) = p; }
        }
    }
}
__device__ __forceinline__ void rec_phase(const bf16* pA2, const float* gkv, const float* cs, bf16* rec) {
    const int lane = otid() & 63, gw = obid() * NWAVES + (otid() >> 6), NGW = gridDim.x * NWAVES;
    for (int r = gw; r < T; r += NGW) {
        const unsigned pc = *(const unsigned*)(pA2 + (size_t)r * LA2 + A2_CKV + 2 * lane), pk = *(const unsigned*)(pA2 + (size_t)r * LA2 + A2_KR + 2 * lane);
        const float c0 = blo(pc), c1 = bhi(pc);
        const float rstd = __builtin_amdgcn_rsqf(wave_sum(c0 * c0 + c1 * c1) * (1.0f / 128.0f) + RMS_EPS);
        *(unsigned*)(rec + (size_t)r * 256 + 2 * lane) = pk2(c0 * rstd * gkv[2 * lane], c1 * rstd * gkv[2 * lane + 1]);
        const float k0 = blo(pk) * rstd, k1 = bhi(pk) * rstd;
        const float q0 = __shfl_xor(k0, 4), q1 = __shfl_xor(k1, 4);
        const int i0 = (2 * lane) & 7; const bool hi = ((2 * lane) & 8) != 0;
        const float cc0 = cs[(size_t)r * 16 + i0], cc1 = cs[(size_t)r * 16 + i0 + 1], ss0 = cs[(size_t)r * 16 + 8 + i0], ss1 = cs[(size_t)r * 16 + 8 + i0 + 1];
        const float o0 = hi ? k0 * cc0 + q0 * ss0 : k0 * cc0 - q0 * ss0, o1 = hi ? k1 * cc1 + q1 * ss1 : k1 * cc1 - q1 * ss1;
        *(unsigned*)(rec + (size_t)r * 256 + 128 + 2 * lane) = pk2(o0, o1);
    }
}
__device__ __forceinline__ unsigned pack_score(float sc, int idx) {
    const unsigned u = __float_as_uint(sc); const unsigned m = u ^ ((u >> 31) ? 0xffffffffu : 0x80000000u);
    return (m & 0xffffe000u) | (unsigned)idx;
}
__device__ __forceinline__ void nv_idx_phase(const bf16* pA2, unsigned short* sel, LAS unsigned char* lds) {
    LAS float* qs = (LAS float*)lds;
    LAS float* ws_ = qs + 512;
    LAS unsigned* ctr = (LAS unsigned*)(ws_ + 8);
    LAS unsigned* pk = (LAS unsigned*)(lds + 4096);
    const int tid = otid();
    for (int q0 = obid(); q0 < T; q0 += gridDim.x) {
        const int q = ((q0 & 1) ? (T - 1 - (q0 >> 1)) : (q0 >> 1));
        const int b = q / S, t = q % S, n = t + 1;
        __syncthreads();
        qs[tid] = bf2f(pA2[(size_t)q * LA2 + A2_IQ + tid]);
        if (tid < 8) ws_[tid] = bf2f(pA2[(size_t)q * LA2 + A2_IW + tid]);
        if (tid < 8) ctr[tid] = 0u;
        __syncthreads();
        for (int s = tid; s < n; s += NTHR) {
            const v4u* kp = (const v4u*)(pA2 + (size_t)(b * S + s) * LA2 + A2_IK);
            v4u kq[8];
#pragma unroll
            for (int c = 0; c < 8; ++c) kq[c] = kp[c];
            float sc = 0.f;
#pragma unroll 1
            for (int h = 0; h < 8; ++h) { float d = 0.f; const LAS float* qh = qs + h * 64;
#pragma unroll
                for (int c = 0; c < 8; ++c) d += qh[8 * c] * blo(kq[c].x) + qh[8 * c + 1] * bhi(kq[c].x) + qh[8 * c + 2] * blo(kq[c].y) + qh[8 * c + 3] * bhi(kq[c].y) + qh[8 * c + 4] * blo(kq[c].z) + qh[8 * c + 5] * bhi(kq[c].z) + qh[8 * c + 6] * blo(kq[c].w) + qh[8 * c + 7] * bhi(kq[c].w);
                sc += ws_[h] * fmaxf(d, 0.f); }
            pk[s] = pack_score(sc, s);
        }
        __syncthreads();
        unsigned thr = 0u;
        if (n > 256) {
            unsigned lo = 0u, hi = 0xffffffffu; int it = 0;
            for (;;) {
                const unsigned mid = lo + ((hi - lo) >> 1);
                unsigned c = 0;
                for (int s = tid; s < n; s += NTHR) c += (pk[s] >= mid) ? 1u : 0u;
#pragma unroll
                for (int o = 1; o < 64; o <<= 1) c += __shfl_xor(c, o);
                const int slot = 1 + (it & 3);
                if ((tid & 63) == 0) atomicAdd((unsigned*)&ctr[slot], c);
                __syncthreads();
                const unsigned tot = ctr[slot];
                if (tid == 0) ctr[1 + ((it + 2) & 3)] = 0u;
                ++it;
                if (tot == 256u || hi - lo <= 1u || it > 40) { thr = mid; break; }
                if (tot > 256u) lo = mid; else hi = mid;
            }
        }
        __syncthreads();
        unsigned base = 0u;
        for (int s0 = 0; s0 < n; s0 += NTHR) { const int s = s0 + tid; const bool keep = (s < n) && (pk[s] >= thr);
            const unsigned long long bm = __ballot(keep); const unsigned wc_ = (unsigned)__popcll(bm);
            __syncthreads();
            if ((tid & 63) == 0) ctr[tid >> 6] = wc_;
            __syncthreads();
            unsigned off = base, tot = 0u;
#pragma unroll
            for (int w = 0; w < 8; ++w) { const unsigned c = ctr[w]; if (w < (tid >> 6)) off += c; tot += c; }
            if (keep) { const unsigned p = off + (unsigned)__popcll(bm & ((1ull << (tid & 63)) - 1ull)); if (p < 256u) sel[(size_t)q * 256 + p] = (unsigned short)s; }
            base += tot; }
        const unsigned cnt = base < 256u ? base : 256u;
        if (tid < 256 && (unsigned)tid >= cnt) sel[(size_t)q * 256 + tid] = 0xffffu;
    }
}
__device__ __forceinline__ void nv_atta_phase(const bf16* pA2, bf16* ya, const bf16* rec, const unsigned short* sel, LAS unsigned char* lds) {
    LAS float* qa = (LAS float*)lds;
    LAS float* qr = qa + 1024;
    LAS float* P = qr + 128;
    LAS int* sl = (LAS int*)(P + 2048);
    const int tid = otid(), lane = tid & 63, wv = tid >> 6;
    for (int q = obid(); q < T; q += gridDim.x) {
        const int b = q / S;
        __syncthreads();
        qa[tid] = bf2f(ya[(size_t)q * 1024 + tid]); qa[tid + 512] = bf2f(ya[(size_t)q * 1024 + 512 + tid]);
        if (tid < 128) qr[tid] = bf2f(pA2[(size_t)q * LA2 + A2_QR + tid]);
        if (tid < 256) sl[tid] = sel[(size_t)q * 256 + tid];
        __syncthreads();
        { const int k = tid & 255, hh = tid >> 8; const int key = sl[k]; const bool valid = key != 0xffff;
          const bf16* rp = rec + (size_t)(b * S + (valid ? key : 0)) * 256;
          float s4[4] = {0.f, 0.f, 0.f, 0.f};
          for (int c8 = 0; c8 < 16; ++c8) { const v4u w = *(const v4u*)(rp + 8 * c8); const float x[8] = {blo(w.x), bhi(w.x), blo(w.y), bhi(w.y), blo(w.z), bhi(w.z), blo(w.w), bhi(w.w)};
#pragma unroll
              for (int h = 0; h < 4; ++h)
#pragma unroll
                  for (int e = 0; e < 8; ++e) s4[h] += qa[(hh * 4 + h) * 128 + 8 * c8 + e] * x[e]; }
#pragma unroll
          for (int h = 0; h < 4; ++h) { const int hd = hh * 4 + h; const v4u w0 = *(const v4u*)(rp + 128 + 16 * hd), w1 = *(const v4u*)(rp + 128 + 16 * hd + 8);
              const float x[16] = {blo(w0.x), bhi(w0.x), blo(w0.y), bhi(w0.y), blo(w0.z), bhi(w0.z), blo(w0.w), bhi(w0.w), blo(w1.x), bhi(w1.x), blo(w1.y), bhi(w1.y), blo(w1.z), bhi(w1.z), blo(w1.w), bhi(w1.w)};
#pragma unroll
              for (int e = 0; e < 16; ++e) s4[h] += qr[hd * 16 + e] * x[e];
              P[hd * 256 + k] = valid ? s4[h] : -INFINITY; } }
        __syncthreads();
        { float v[4]; float m = -INFINITY;
#pragma unroll
          for (int j = 0; j < 4; ++j) { v[j] = P[wv * 256 + lane + 64 * j]; m = fmaxf(m, v[j]); }
          m = wave_max(m); float sum = 0.f;
#pragma unroll
          for (int j = 0; j < 4; ++j) { v[j] = exp2f(v[j] - m); sum += v[j]; }
          sum = wave_sum(sum); const float inv = 1.0f / sum;
#pragma unroll
          for (int j = 0; j < 4; ++j) P[wv * 256 + lane + 64 * j] = v[j] * inv; }
        __syncthreads();
        { const int c = tid & 127, hq = tid >> 7; float o0 = 0.f, o1 = 0.f;
          for (int k = 0; k < 256; ++k) { const int key = sl[k]; if (key == 0xffff) continue; const float x = bf2f(rec[(size_t)(b * S + key) * 256 + c]); o0 += P[(2 * hq) * 256 + k] * x; o1 += P[(2 * hq + 1) * 256 + k] * x; }
          ya[(size_t)q * 1024 + (2 * hq) * 128 + c] = (bf16)f2bf(o0); ya[(size_t)q * 1024 + (2 * hq + 1) * 128 + c] = (bf16)f2bf(o1); }
    }
}
__device__ __forceinline__ void nv_attb_phase(const bf16* pB, bf16* yb, LAS unsigned char* lds) {
    const int tid = otid(), lane = tid & 63, wv = tid >> 6;
    LAS float* qv = (LAS float*)lds + wv * 64;
    const int gw = obid() * NWAVES + wv, NGW = gridDim.x * NWAVES;
    for (int item = gw; item < T * 4; item += NGW) {
        const int tg = item >> 2, hs = item & 3, b = tg / S, t = tg % S;
        float m = -INFINITY, l = 0.f, o = 0.f;
#pragma unroll 1
        for (int g = 0; g < 3; ++g) {
            const int dil = (g == 0) ? 1 : (g == 1) ? 4 : 16, head = g * 4 + hs;
            LDS_WAIT();
            qv[lane] = bf2f(pB[(size_t)tg * LPB + head * 64 + lane]);
            LDS_WAIT();
#pragma unroll 1
            for (int pass = 0; pass < 3; ++pass) {
                const int j = pass * 64 + lane, pos = t - dil * j; const bool valid = (j <= 128) && (pos >= 0);
                float s = -INFINITY;
                if (valid) { const v4u* kp = (const v4u*)(pB + (size_t)(b * S + pos) * LPB + 768 + head * 64); float d = 0.f;
#pragma unroll
                    for (int c = 0; c < 8; ++c) { const v4u w = kp[c]; d += qv[8 * c] * blo(w.x) + qv[8 * c + 1] * bhi(w.x) + qv[8 * c + 2] * blo(w.y) + qv[8 * c + 3] * bhi(w.y) + qv[8 * c + 4] * blo(w.z) + qv[8 * c + 5] * bhi(w.z) + qv[8 * c + 6] * blo(w.w) + qv[8 * c + 7] * bhi(w.w); }
                    s = d; }
                const float mx = wave_max(s);
                if (mx == -INFINITY) continue;
                const float mn = fmaxf(m, mx), p = valid ? exp2f(s - mn) : 0.f, scl = exp2f(m - mn);
                l = l * scl + wave_sum(p); o *= scl; m = mn;
                const int nj = (pass == 2) ? 1 : 64;
                for (int jj = 0; jj < nj; ++jj) { const float pj = __shfl(p, jj); const int pj_pos = t - dil * (pass * 64 + jj);
                    if (pj_pos >= 0) o += pj * bf2f(pB[(size_t)(b * S + pj_pos) * LPB + 1536 + head * 64 + lane]); }
            }
        }
        yb[(size_t)tg * 256 + hs * 64 + lane] = (bf16)f2bf(o / l);
    }
}
__device__ __forceinline__ float logsigmoid_f(float x) { return fminf(x, 0.f) - log1pf(__expf(-fabsf(x))); }
__device__ __forceinline__ void nv_gla_phase(const bf16* pA2, const float* cbal, bf16* yc) {
    const int lane = otid() & 63, gw = obid() * NWAVES + (otid() >> 6), NGW = gridDim.x * NWAVES;
    for (int item = gw; item < NB * 4 * 128; item += NGW) {
        const int b = item >> 9, h = (item >> 7) & 3, dv = item & 127;
        const float bias = cbal[h * 64 + lane];
        float St = 0.f;
        for (int t = 0; t < S; ++t) { const bf16* rp = pA2 + (size_t)(b * S + t) * LA2;
            const float a = __expf(logsigmoid_f(bf2f(rp[A2_CAL + h * 64 + lane]) + bias) * (1.0f / 16.0f));
            const float k = bf2f(rp[A2_CK + h * 64 + lane]), qv = bf2f(rp[A2_CQ + h * 64 + lane]), v = bf2f(rp[A2_CV + h * 128 + dv]);
            St = a * St + k * v;
            const float o = wave_sum(qv * St);
            if (lane == 0) yc[(size_t)(b * S + t) * 512 + h * 128 + dv] = (bf16)f2bf(o); }
    }
}
__device__ __forceinline__ void nv_gla_out_phase(const bf16* pA2, const float* cng, bf16* yc) {
    const int lane = otid() & 63, gw = obid() * NWAVES + (otid() >> 6), NGW = gridDim.x * NWAVES;
    for (int item = gw; item < T * 4; item += NGW) { const int r = item >> 2, h = item & 3;
        const unsigned po = *(const unsigned*)(yc + (size_t)r * 512 + h * 128 + 2 * lane), pg = *(const unsigned*)(pA2 + (size_t)r * LA2 + A2_CG + h * 128 + 2 * lane);
        const float o0 = blo(po), o1 = bhi(po), g0 = blo(pg), g1 = bhi(pg);
        const float rstd = __builtin_amdgcn_rsqf(wave_sum(o0 * o0 + o1 * o1) * (1.0f / 128.0f) + RMS_EPS);
        const float y0 = o0 * rstd * cng[2 * lane] * (g0 / (1.0f + __expf(-g0))), y1 = o1 * rstd * cng[2 * lane + 1] * (g1 / (1.0f + __expf(-g1)));
        *(unsigned*)(yc + (size_t)r * 512 + h * 128 + 2 * lane) = pk2(y0, y1); }
}
constexpr int NPH = 19;
constexpr int ARGS_OFF = MISC_OFF + 128;
struct CtxK {
    const Args& a;
    __device__ __forceinline__ const float* in(int i) const { return a.in[i]; }
    __device__ __forceinline__ float* out() const { return a.out; }
    __device__ __forceinline__ unsigned char* ws() const { return opaque_ptr(a.ws); }
};
__device__ __forceinline__ unsigned char* lds_ptr64(const LAS unsigned* p) {
    const unsigned lo = __builtin_amdgcn_readfirstlane(p[0]), hi = __builtin_amdgcn_readfirstlane(p[1]);
    return (unsigned char*)(GAS unsigned char*)(((unsigned long long)hi << 32) | lo);
}
struct CtxL {
    LAS unsigned char* lds;
    __device__ __forceinline__ const float* in(int i) const { return (const float*)lds_ptr64((const LAS unsigned*)(lds + ARGS_OFF) + 2 * i); }
    __device__ __forceinline__ float* out() const { return (float*)lds_ptr64((const LAS unsigned*)(lds + ARGS_OFF) + 48); }
    __device__ __forceinline__ unsigned char* ws() const { return lds_ptr64((const LAS unsigned*)(lds + ARGS_OFF) + 50); }
};
template <int K, class C> __device__ __forceinline__ void phase_body(const C& cx, int l, LAS unsigned char* lds) {
    unsigned char* wq_ = cx.ws(); bf16* W = (bf16*)(wq_ + WS_W); float* cs = (float*)(wq_ + WS_CS); bf16* XN = (bf16*)(wq_ + WS_XN); bf16* FB = (bf16*)(wq_ + WS_FB);
    unsigned short* SEL = (unsigned short*)(wq_ + WS_FB); bf16* REC = (bf16*)(wq_ + WS_FB + 8 * MiB); bf16* YB = (bf16*)(wq_ + WS_YB); bf16* YA = (bf16*)(wq_ + WS_YA); bf16* YC = (bf16*)(wq_ + WS_YC); bf16* BIG = (bf16*)(wq_ + WS_BIG);
    (void)W; (void)cs; (void)XN; (void)FB; (void)SEL; (void)REC; (void)YB; (void)YA; (void)YC; (void)BIG;
    LAS float* scr = (LAS float*)lds; (void)scr;
    if constexpr (K == 0) { if (l == 0) { cs_phase((const int*)cx.in(I_POS), cs); resid_phase(cx.in(I_X), cx.out(), nullptr, 0.f, nullptr, cx.in(I_F1PRE) + l * D, XN);
                cvt_ffn(cx.in(I_F1WIN), cx.in(I_F1WOUT), W + WO_W1, W + WO_W2, scr); } }
    if constexpr (K == 1) { pg8::Gemm g{XN, W + WO_W1, T, 2 * DFF, D}; pg8::StaticOrder So; So.init(T, 2 * DFF, gridDim.x, obid()); pg8::EpiSwiglu E{BIG, DFF};
            pg8::gemm_phase<pg8::EpiSwiglu, pg8::StaticOrder, true, true>(lds, g, So, E); }
    if constexpr (K == 2) { pg8::Gemm g{BIG, W + WO_W2, T, D, DFF}; pg8::StaticOrder So; So.init(T, D, gridDim.x, obid()); pg8::EpiStore E{FB, D};
            pg8::gemm_phase<pg8::EpiStore, pg8::StaticOrder, true, true>(lds, g, So, E); }
    if constexpr (K == 3) { resid_phase(cx.out(), cx.out(), FB, 0.5f, cx.in(I_F1POST) + l * D, cx.in(I_MIXPRE) + l * D, XN); cvt_mixer(cx, l, W, scr); }
    if constexpr (K == 4) { pg8::Gemm g{XN, W + WO_BIG + (size_t)RB0 * D, T, NRB, D}; pg8::StaticOrder So; So.init(T, NRB, gridDim.x, obid());
            pg8::EpiProj<0> E{BIG, LPB, 1000, BIG, LPB, cs, nullptr};
            pg8::gemm_phase<pg8::EpiProj<0>, pg8::StaticOrder, true, true>(lds, g, So, E); }
    if constexpr (K == 5) { nv_attb_phase(BIG, YB, lds); }
    if constexpr (K == 6) { pg8::Gemm g{XN, W + WO_BIG + (size_t)RAC0 * D, T, NRAC, D}; pg8::StaticOrder So; So.init(T, NRAC, gridDim.x, obid());
            pg8::EpiProj<1> E{YA, 1024, 4, BIG, LA2, cs, nullptr};
            pg8::gemm_phase<pg8::EpiProj<1>, pg8::StaticOrder, true, true>(lds, g, So, E); }
    if constexpr (K == 7) { rec_phase(BIG, cx.in(I_AKVG) + l * 128, cs, REC); nv_gla_phase(BIG, cx.in(I_CBAL) + l * 256, YC); }
    if constexpr (K == 8) { nv_gla_out_phase(BIG, cx.in(I_CNORM) + l * 128, YC); }
    if constexpr (K == 10) { nv_idx_phase(BIG, SEL, lds); }
    if constexpr (K == 11) { nv_atta_phase(BIG, YA, REC, SEL, lds); }
    if constexpr (K == 12) { pg8::Gemm g{XN, W + WO_BIG + (size_t)RG0 * D, T, NRG, D}; pg8::StaticOrder So; So.init(T, NRG, gridDim.x, obid());
            pg8::EpiProj<2> E{BIG, 3072, 1000, BIG, 3072, cs, cx.in(I_BGATE) + l * 3072};
            pg8::gemm_phase<pg8::EpiProj<2>, pg8::StaticOrder, true, true>(lds, g, So, E); }
    if constexpr (K == 13) { pg8::StaticOrder So; So.init(T, D, gridDim.x, obid());
            { pg8::Gemm g{YA, W + WO_MA, T, D, 1024}; pg8::EpiMerge<true> E{XN, D, BIG, 3072, 0}; pg8::gemm_phase<pg8::EpiMerge<true>, pg8::StaticOrder, true, true>(lds, g, So, E); }
            VM_WAIT(); __syncthreads();
            { pg8::Gemm g{YB, W + WO_MB, T, D, 256}; pg8::EpiMerge<false> E{XN, D, BIG, 3072, 1024}; pg8::gemm_phase<pg8::EpiMerge<false>, pg8::StaticOrder, true, true>(lds, g, So, E); }
            VM_WAIT(); __syncthreads();
            { pg8::Gemm g{YC, W + WO_MC, T, D, 512}; pg8::EpiMerge<false> E{XN, D, BIG, 3072, 2048}; pg8::gemm_phase<pg8::EpiMerge<false>, pg8::StaticOrder, true, true>(lds, g, So, E); } }
    if constexpr (K == 14) { pg8::Gemm g{XN, W + WO_WO, T, D, D}; pg8::StaticOrder So; So.init(T, D, gridDim.x, obid()); pg8::EpiStore E{FB, D};
            pg8::gemm_phase<pg8::EpiStore, pg8::StaticOrder, true, true>(lds, g, So, E); }
    if constexpr (K == 15) { resid_phase(cx.out(), cx.out(), FB, 1.0f, cx.in(I_MIXPOST) + l * D, cx.in(I_F2PRE) + l * D, XN);
            cvt_ffn(cx.in(I_F2WIN) + (size_t)l * D * 2 * DFF, cx.in(I_F2WOUT) + (size_t)l * DFF * D, W + WO_W1, W + WO_W2, scr); }
    if constexpr (K == 16) { pg8::Gemm g{XN, W + WO_W1, T, 2 * DFF, D}; pg8::StaticOrder So; So.init(T, 2 * DFF, gridDim.x, obid()); pg8::EpiSwiglu E{BIG, DFF};
            pg8::gemm_phase<pg8::EpiSwiglu, pg8::StaticOrder, true, true>(lds, g, So, E); }
    if constexpr (K == 17) { pg8::Gemm g{BIG, W + WO_W2, T, D, DFF}; pg8::StaticOrder So; So.init(T, D, gridDim.x, obid()); pg8::EpiStore E{FB, D};
            pg8::gemm_phase<pg8::EpiStore, pg8::StaticOrder, true, true>(lds, g, So, E); }
    if constexpr (K == 18) { if (l + 1 < DEPTH) { resid_phase(cx.out(), cx.out(), FB, 0.5f, cx.in(I_F2POST) + l * D, cx.in(I_F1PRE) + (l + 1) * D, XN);
                cvt_ffn(cx.in(I_F1WIN) + (size_t)(l + 1) * D * 2 * DFF, cx.in(I_F1WOUT) + (size_t)(l + 1) * DFF * D, W + WO_W1, W + WO_W2, scr); }
            else resid_phase(cx.out(), cx.out(), FB, 0.5f, cx.in(I_F2POST) + l * D, nullptr, nullptr); }
}

__device__ __forceinline__ void zero_lds_ctl(LAS unsigned char* lds) {
    for (int u = threadIdx.x; u < (LDS_BYTES - RING_BYTES) / 4; u += NTHR) ((LAS unsigned*)(lds + RING_BYTES))[u] = 0u;
    __syncthreads();
}
template <int K> __global__ void __launch_bounds__(NTHR, 2) mk_fwd(Args args) {
    extern __shared__ __attribute__((aligned(16))) unsigned char lds_raw[];
    LAS unsigned char* lds = (LAS unsigned char*)lds_raw;
    zero_lds_ctl(lds);
    CtxK cx{args};
    phase_body<K, CtxK>(cx, args.l, lds);
}
#if MK_ONE_LAUNCH
#if MK_ONE_LAUNCH == 2
#define phase_call_inl(K, l) do { extern __shared__ __attribute__((aligned(16))) unsigned char lds_raw2[]; CtxK cxk{args}; phase_body<K, CtxK>(cxk, l, (LAS unsigned char*)lds_raw2); } while (0)
template <int K> __device__ __forceinline__ void phase_call(int l) {
#else
template <int K> __device__ __attribute__((noinline)) void phase_call(int l) {
#endif
    extern __shared__ __attribute__((aligned(16))) unsigned char lds_raw[];
    LAS unsigned char* lds = (LAS unsigned char*)lds_raw;
    l = __builtin_amdgcn_readfirstlane(l);
    CtxL cx{lds};
    phase_body<K, CtxL>(cx, l, lds);
}
__global__ void __launch_bounds__(NTHR, 2) mk_one(Args args) {
    extern __shared__ __attribute__((aligned(16))) unsigned char lds_raw[];
    LAS unsigned char* lds = (LAS unsigned char*)lds_raw;
    zero_lds_ctl(lds);
#if MK_ONE_LAUNCH == 1
    if (threadIdx.x == 0) { LAS unsigned long long* la = (LAS unsigned long long*)(lds + ARGS_OFF);
#pragma unroll
        for (int i = 0; i < 24; ++i) la[i] = (unsigned long long)args.in[i];
        la[24] = (unsigned long long)args.out; la[25] = (unsigned long long)args.ws; }
    __syncthreads();
#endif
    volatile LAS unsigned* MISC = (volatile LAS unsigned*)(lds + MISC_OFF);
    unsigned* ctl = (unsigned*)((unsigned char*)(GAS unsigned char*)args.ws + WS_CTL);
    XcdBarrier bar = xcd_barrier_post(ctl + CW_BAR, MISC + 8);
#ifndef MK_PHMASK
#define MK_PHMASK 0x7ffff
#endif
#if MK_ONE_LAUNCH == 2
#define PH(K) do { if ((MK_PHMASK >> K) & 1) { phase_call_inl(K, l); xcd_barrier(bar); } } while (0)
#else
#define PH(K) do { if ((MK_PHMASK >> K) & 1) { phase_call<K>(l); xcd_barrier(bar); } } while (0)
#endif
    { const int l = 0; PH(0); }
#pragma unroll 1
    for (int l = 0; l < DEPTH; ++l) {
        PH(1); PH(2); PH(3); PH(4); PH(5); PH(6); PH(7); PH(8); PH(10); PH(11); PH(12); PH(13); PH(14); PH(15); PH(16); PH(17);
#if MK_ONE_LAUNCH == 2
        phase_call_inl(18, l);
#else
        phase_call<18>(l);
#endif
        if (l + 1 < DEPTH) xcd_barrier(bar);
    }
#undef PH
}
#endif

#define MK_PHASES(X) X(0) X(1) X(2) X(3) X(4) X(5) X(6) X(7) X(8) X(10) X(11) X(12) X(13) X(14) X(15) X(16) X(17) X(18)
#if !MK_ONE_LAUNCH
static void launch_phase(int k, int grid, hipStream_t stream, const Args& a) {
    switch (k) {
#define X(K) case K: hipLaunchKernelGGL(mk_fwd<K>, dim3(grid), dim3(NTHR), LDS_BYTES, stream, a); break;
        MK_PHASES(X)
#undef X
        default: break;
    }
}
#endif
static bool set_lds_attr() {
    bool ok = true;
#if MK_ONE_LAUNCH
    ok = ok && (hipFuncSetAttribute((const void*)mk_one, hipFuncAttributeMaxDynamicSharedMemorySize, LDS_BYTES) == hipSuccess);
#else
#define X(K) ok = ok && (hipFuncSetAttribute((const void*)mk_fwd<K>, hipFuncAttributeMaxDynamicSharedMemorySize, LDS_BYTES) == hipSuccess);
    MK_PHASES(X)
#undef X
#endif
    return ok;
}
extern "C" void kernel_launch(void* const* d_in, const int* in_sizes, int n_in, void* d_out, int out_size, void* d_ws, size_t ws_size, hipStream_t stream) {
    static int grid = 0;
    if (grid == 0) {
        if (n_in != 24 || out_size != T * D || ws_size < WS_END) { fprintf(stderr, "kernel_launch: unexpected shapes (n_in %d out %d ws %zu)\n", n_in, out_size, ws_size); grid = -1; return; }
        int dev = 0, cus = 0;
        if (hipGetDevice(&dev) != hipSuccess || hipDeviceGetAttribute(&cus, hipDeviceAttributeMultiprocessorCount, dev) != hipSuccess) { grid = -1; return; }
        if (!set_lds_attr()) { fprintf(stderr, "kernel_launch: hipFuncSetAttribute failed\n"); grid = -1; return; }
        int per_cu = 0;
#if MK_ONE_LAUNCH
        if (hipOccupancyMaxActiveBlocksPerMultiprocessor(&per_cu, (const void*)mk_one, NTHR, LDS_BYTES) != hipSuccess || per_cu < 1) { fprintf(stderr, "kernel_launch: occupancy query reports %d\n", per_cu); grid = -1; return; }
#endif
        (void)hipGetLastError();
        grid = cus;
    }
    if (grid < 0) return;
    (void)hipMemsetAsync((char*)d_ws + WS_CTL, 0, CTL_ZERO_BYTES, stream);
    Args a{};
    for (int i = 0; i < 24; ++i) a.in[i] = (const float*)d_in[i];
    a.out = (float*)d_out; a.ws = (unsigned char*)d_ws;
#if MK_ONE_LAUNCH
    hipLaunchKernelGGL(mk_one, dim3(grid), dim3(NTHR), LDS_BYTES, stream, a);
#else
    for (int p = 0; p < DEPTH * NPH; ++p) {
        const int k = p % NPH, l = p / NPH;
        if ((k == 0 && l > 0) || k == 9) continue;
        a.l = l;
        launch_phase(k, grid, stream, a);
    }
#endif
}
```

```cpp
#define MK_ONE_LAUNCH 2
#include <hip/hip_runtime.h>
#include <cstdio>
#include <cstdint>
#define GAS __attribute__((address_space(1)))
#define LAS __attribute__((address_space(3)))
#ifndef MK_ONE_LAUNCH
#define MK_ONE_LAUNCH 0
#endif
namespace pg8 {
#define PG8_LAS __attribute__((address_space(3)))
typedef unsigned short bf16_t;
typedef short bf16x8 __attribute__((ext_vector_type(8)));
typedef float f32x4 __attribute__((ext_vector_type(4)));
typedef unsigned u32x4 __attribute__((ext_vector_type(4)));
constexpr int BM = 256, BK = 64, HALF = 128, HTB = HALF * BK * 2  , STAGE_BYTES = 8 * HTB, NXCD = 8, WGM = 8;

__host__ __device__ __forceinline__ int lds_byte(int r, int c) { const int st = (r >> 4) * 2 + (c >> 5), rr = r & 15, cc = c & 31, ob = rr * 64 + cc * 2; return st * 1024 + (ob ^ (((ob >> 9) & 1) << 5)); }
__host__ __device__ __forceinline__ void stage_rc(int b, int& R, int& C) { const int st = b / 1024, sb = b % 1024, swz = sb ^ (((sb >> 9) & 1) << 5); R = (st >> 1) * 16 + swz / 64; C = (st & 1) * 32 + (swz % 64) / 2; }
__host__ __device__ __forceinline__ int perm32(int rho) { const int n = rho >> 4, i = rho & 15; return 8 * (i >> 2) + 4 * n + (i & 3); }

struct Unit { int pm, pn; };
struct Gemm { const bf16_t* A; const bf16_t* Bt; int M, N, K; };

struct StaticOrder {
    int nM, nN, nwg, G, c;
    __host__ __device__ void init(int M, int N, int G_, int c_) { nM = M / BM; nN = N / BM; nwg = nM * nN; G = G_; c = c_; }
    __host__ __device__ bool next(int i, Unit& u) const {
        const long L = (long)i * G + c; if (L >= nwg) return false;
        int wgid = (int)L; { const int q = nwg / NXCD, r = nwg % NXCD, xcd = wgid % NXCD, off = wgid / NXCD; wgid = (xcd < r ? xcd * (q + 1) : r * (q + 1) + (xcd - r) * q) + off; }
        const int nig = WGM * nN, gid = wgid / nig, fm = gid * WGM, gsz = (nM - fm) < WGM ? (nM - fm) : WGM;
        u.pm = fm + ((wgid % nig) % gsz); u.pn = (wgid % nig) / gsz; return true;
    }
    __device__ __forceinline__ void a_ready(const Unit&) const {}
    __device__ __forceinline__ void done(const Unit&) const {}
};

typedef float f32x2_t_ __attribute__((ext_vector_type(2))); typedef __bf16 bf16x2_t_ __attribute__((ext_vector_type(2)));
__device__ __forceinline__ unsigned cvt_pk_bf16(float lo, float hi) { const f32x2_t_ v = {lo, hi}; const bf16x2_t_ b = __builtin_convertvector(v, bf16x2_t_); return __builtin_bit_cast(unsigned, b); }
typedef float f32x2 __attribute__((ext_vector_type(2)));
__device__ __forceinline__ float bflo(unsigned w) { return __uint_as_float(w << 16); }
__device__ __forceinline__ float bfhi(unsigned w) { return __uint_as_float(w & 0xffff0000u); }
__device__ __forceinline__ u32x4 pack8(const f32x4 a, const f32x4 b) { u32x4 w; w.x = cvt_pk_bf16(a[0], a[1]); w.y = cvt_pk_bf16(a[2], a[3]); w.z = cvt_pk_bf16(b[0], b[1]); w.w = cvt_pk_bf16(b[2], b[3]); return w; }
__device__ __forceinline__ float fast_sigmoid(float x) { return __builtin_amdgcn_rcpf(1.0f + __expf(-x)); }

struct EpiSwiglu {
    static constexpr bool PERM = true, AFTER_DRAIN = false;
    bf16_t* O; int ldc;
    __device__ __forceinline__ void operator()(const f32x4 (&acc)[2][2][4][2], const Unit& u, int wr, int wc, int fr, int fq) const {
        const int row0 = u.pm * BM + wr * 64 + fr, col0 = u.pn * HALF + wc * 32 + 8 * fq;
#pragma unroll
        for (int ai = 0; ai < 2; ++ai)
#pragma unroll
            for (int m = 0; m < 4; ++m) { bf16_t* rowp = O + (size_t)(row0 + ai * HALF + m * 16) * ldc + col0;
                f32x4 o0, o1;
#pragma unroll
                for (int j = 0; j < 4; ++j) { const float g0 = acc[ai][0][m][0][j], g1 = acc[ai][0][m][1][j];
                    o0[j] = g0 * fast_sigmoid(g0) * acc[ai][1][m][0][j]; o1[j] = g1 * fast_sigmoid(g1) * acc[ai][1][m][1][j]; }
                *(u32x4*)rowp = pack8(o0, o1); asm volatile("" ::: "memory"); }
    }
};
struct EpiStore {
    static constexpr bool PERM = true, AFTER_DRAIN = false;
    bf16_t* O; int ldc;
    __device__ __forceinline__ void operator()(const f32x4 (&acc)[2][2][4][2], const Unit& u, int wr, int wc, int fr, int fq) const {
        const int row0 = u.pm * BM + wr * 64 + fr, col0 = u.pn * BM + wc * 32 + 8 * fq;
#pragma unroll
        for (int ai = 0; ai < 2; ++ai)
#pragma unroll
            for (int m = 0; m < 4; ++m) { bf16_t* rowp = O + (size_t)(row0 + ai * HALF + m * 16) * ldc + col0;
#pragma unroll
                for (int bj = 0; bj < 2; ++bj) *(u32x4*)(rowp + bj * HALF) = pack8(acc[ai][bj][m][0], acc[ai][bj][m][1]); }
    }
};
enum { PM_PLAIN = 0, PM_ROPE64 = 1, PM_ROPE16 = 2, PM_SIGMOID = 3 };
template <int RANGE> __device__ __forceinline__ int proj_mode(int gcol) {
    if (RANGE == 0) return gcol < 1536 ? PM_ROPE64 : PM_PLAIN;
    if (RANGE == 1) { if (gcol < 1024) return PM_PLAIN; const int g2 = gcol - 1024;
        return g2 < 128 ? PM_ROPE16 : (g2 < 704 ? PM_ROPE64 : PM_PLAIN); }
    return PM_SIGMOID;
}
template <int RANGE> struct EpiProj {
    static constexpr bool PERM = true, AFTER_DRAIN = false;
    bf16_t* d0; int ld0; int nt0; bf16_t* d1; int ld1; const float* cs; const float* bias;
    __device__ __forceinline__ void operator()(const f32x4 (&acc)[2][2][4][2], const Unit& u, int wr, int wc, int fr, int fq) const {
        const int row0 = u.pm * BM + wr * 64 + fr;
        bf16_t* dbase; int ld;
        if (u.pn < nt0) { dbase = d0 + u.pn * BM; ld = ld0; } else { dbase = d1 + (u.pn - nt0) * BM; ld = ld1; }
#pragma unroll
        for (int bj = 0; bj < 2; ++bj) {
            const int gcol = u.pn * BM + bj * HALF + wc * 32;
            const int mode = proj_mode<RANGE>(gcol);
            const bool rope = (mode == PM_ROPE16) || (mode == PM_ROPE64 && (wc & 1) == 0);
            const bool lane_rope = (mode == PM_ROPE16) || (fq < 2);
            f32x4 b0 = (f32x4){0.f, 0.f, 0.f, 0.f}, b1 = b0;
#ifndef MK_NOBIAS
            if (mode == PM_SIGMOID) { b0 = *(const f32x4*)(bias + gcol + 8 * fq); b1 = *(const f32x4*)(bias + gcol + 8 * fq + 4); }
#endif
#pragma unroll
            for (int ai = 0; ai < 2; ++ai)
#pragma unroll
                for (int m = 0; m < 4; ++m) {
                    const int r = row0 + ai * HALF + m * 16;
                    f32x4 v0 = acc[ai][bj][m][0], v1 = acc[ai][bj][m][1];
                    if (rope) {
                        const float sg = (fq & 1) ? 1.0f : -1.0f;
                        { const f32x4 c0 = *(const f32x4*)(cs + (size_t)r * 16), s0 = *(const f32x4*)(cs + (size_t)r * 16 + 8); f32x4 p0;
#pragma unroll
                          for (int j = 0; j < 4; ++j) p0[j] = __shfl_xor(v0[j], 16);
                          if (lane_rope) v0 = v0 * c0 + sg * (p0 * s0); }
                        asm volatile("" ::: "memory");
                        { const f32x4 c1 = *(const f32x4*)(cs + (size_t)r * 16 + 4), s1 = *(const f32x4*)(cs + (size_t)r * 16 + 12); f32x4 p1;
#pragma unroll
                          for (int j = 0; j < 4; ++j) p1[j] = __shfl_xor(v1[j], 16);
                          if (lane_rope) v1 = v1 * c1 + sg * (p1 * s1); }
                    }
                    if (mode == PM_SIGMOID) {
#pragma unroll
                        for (int j = 0; j < 4; ++j) { v0[j] = fast_sigmoid(v0[j] + b0[j]); v1[j] = fast_sigmoid(v1[j] + b1[j]); }
                    }
                    *(u32x4*)(dbase + (size_t)r * ld + bj * HALF + wc * 32 + 8 * fq) = pack8(v0, v1);
                    asm volatile("" ::: "memory");
                }
        }
    }
};
template <bool FIRST> struct EpiMerge {
    static constexpr bool PERM = true, AFTER_DRAIN = false;
    bf16_t* O; int ldc; const bf16_t* G; int ldg; int gcol;
    __device__ __forceinline__ void operator()(const f32x4 (&acc)[2][2][4][2], const Unit& u, int wr, int wc, int fr, int fq) const {
        const int row0 = u.pm * BM + wr * 64 + fr, col0 = u.pn * BM + wc * 32 + 8 * fq;
#pragma unroll
        for (int ai = 0; ai < 2; ++ai)
#pragma unroll
            for (int m = 0; m < 4; ++m) { const int r = row0 + ai * HALF + m * 16;
#pragma unroll
                for (int bj = 0; bj < 2; ++bj) {
                    const u32x4 g = *(const u32x4*)(G + (size_t)r * ldg + gcol + col0 + bj * HALF);
                    f32x4 o0, o1;
                    o0[0] = bflo(g.x) * acc[ai][bj][m][0][0]; o0[1] = bfhi(g.x) * acc[ai][bj][m][0][1]; o0[2] = bflo(g.y) * acc[ai][bj][m][0][2]; o0[3] = bfhi(g.y) * acc[ai][bj][m][0][3];
                    o1[0] = bflo(g.z) * acc[ai][bj][m][1][0]; o1[1] = bfhi(g.z) * acc[ai][bj][m][1][1]; o1[2] = bflo(g.w) * acc[ai][bj][m][1][2]; o1[3] = bfhi(g.w) * acc[ai][bj][m][1][3];
                    bf16_t* op = O + (size_t)r * ldc + col0 + bj * HALF;
                    if (!FIRST) { const u32x4 p = *(const u32x4*)op;
                        o0[0] += bflo(p.x); o0[1] += bfhi(p.x); o0[2] += bflo(p.y); o0[3] += bfhi(p.y); o1[0] += bflo(p.z); o1[1] += bfhi(p.z); o1[2] += bflo(p.w); o1[3] += bfhi(p.w); }
                    *(u32x4*)op = pack8(o0, o1); asm volatile("" ::: "memory"); } }
    }
};

template <class Epi, class Sched, bool ALIGN_EPI = false, bool SP2 = false>
__device__ __forceinline__ void gemm_phase(PG8_LAS unsigned char* lds, const Gemm g, const Sched& S, const Epi& E) {
    int tid_o = threadIdx.x; asm volatile("" : "+v"(tid_o));
    const int tid = tid_o, wid = __builtin_amdgcn_readfirstlane(tid >> 6), lane = tid & 63, wr = wid >> 2, wc = wid & 3, fr = lane & 15, fq = lane >> 4;
    const int K = g.K, nt = K / BK;
    unsigned voffA[2], voffB[2];
#pragma unroll
    for (int i = 0; i < 2; ++i) { int R, C; stage_rc(tid * 16 + i * 8192, R, C); const int Rb = Epi::PERM ? ((R & ~31) + perm32(R & 31)) : R;
        voffA[i] = (unsigned)(R * K + C) * 2u; voffB[i] = (unsigned)(Rb * K + C) * 2u; }
    const size_t kstep = (size_t)(BK * 2);
    const size_t hstep = (size_t)HALF * K * 2;
    const size_t tstep = 2 * hstep;
    const unsigned ldsw = (unsigned)wid * 1024u;
    const int aoff = lds_byte(wr * 64 + fr, fq * 8), boff = lds_byte(wc * 32 + fr, fq * 8);
#define PG8_SA(b, h) (((b) * 2 + (h)) * HTB)
#define PG8_SB(b, h) ((4 + (b) * 2 + (h)) * HTB)
#define PG8_STAGE(bufoff, gbase, voff) do { _Pragma("unroll") for (int _i = 0; _i < 2; ++_i) \
        __builtin_amdgcn_global_load_lds((const unsigned*)((const char*)(gbase) + (voff)[_i]), (PG8_LAS unsigned*)(lds + (bufoff) + ldsw + _i * 8192), 16, 0, 0); } while (0)
#define PG8_LDA(dst, b, h) do { _Pragma("unroll") for (int m = 0; m < 4; ++m) _Pragma("unroll") for (int k = 0; k < 2; ++k) dst[m][k] = *(const PG8_LAS bf16x8*)(lds + PG8_SA(b, h) + aoff + m * 2048 + k * 1024); } while (0)
#define PG8_LDB(dst, b, h) do { _Pragma("unroll") for (int n = 0; n < 2; ++n) _Pragma("unroll") for (int k = 0; k < 2; ++k) dst[n][k] = *(const PG8_LAS bf16x8*)(lds + PG8_SB(b, h) + boff + n * 2048 + k * 1024); } while (0)
#define PG8_MMA(ai, bj, At, Bt) do { __builtin_amdgcn_s_setprio(1); _Pragma("unroll") for (int m = 0; m < 4; ++m) _Pragma("unroll") for (int n = 0; n < 2; ++n) _Pragma("unroll") for (int k = 0; k < 2; ++k) \
        acc[ai][bj][m][n] = __builtin_amdgcn_mfma_f32_16x16x32_bf16(Bt[n][k], At[m][k], acc[ai][bj][m][n], 0, 0, 0); __builtin_amdgcn_s_setprio(0); } while (0)
#define PG8_WAIT_V(n) asm volatile("s_waitcnt vmcnt(" #n ")" ::: "memory")
#define PG8_WAIT_L(n) asm volatile("s_waitcnt lgkmcnt(" #n ")" ::: "memory")
#define PG8_BAR __builtin_amdgcn_s_barrier()
#define PG8_SCHED __builtin_amdgcn_sched_barrier(0)
    Unit cur, nxt; int ui = 0;
    if (!S.next(0, cur)) return;
    f32x4 acc[2][2][4][2];
#pragma unroll
    for (int a = 0; a < 2; ++a)
#pragma unroll
        for (int b = 0; b < 2; ++b)
#pragma unroll
            for (int m = 0; m < 4; ++m)
#pragma unroll
                for (int n = 0; n < 2; ++n) acc[a][b][m][n] = (f32x4){0.f, 0.f, 0.f, 0.f};
    bf16x8 At[4][2], B0[2][2], B1[2][2];
    const char* cA = (const char*)g.A + (size_t)cur.pm * tstep; const char* cB = (const char*)g.Bt + (size_t)cur.pn * tstep;
    S.a_ready(cur);
    if constexpr (SP2) {
        PG8_STAGE(PG8_SB(0, 0), cB, voffB); PG8_STAGE(PG8_SB(0, 1), cB + hstep, voffB); PG8_STAGE(PG8_SA(0, 0), cA, voffA); PG8_STAGE(PG8_SA(0, 1), cA + hstep, voffA);
        if (wr == 1) PG8_BAR;
        PG8_WAIT_V(2); PG8_BAR;
        PG8_STAGE(PG8_SB(1, 0), cB + kstep, voffB); PG8_STAGE(PG8_SA(1, 0), cA + kstep, voffA); PG8_STAGE(PG8_SB(1, 1), cB + hstep + kstep, voffB);
        PG8_WAIT_V(6); PG8_BAR;
    } else {
        PG8_STAGE(PG8_SB(0, 0), cB, voffB); PG8_STAGE(PG8_SA(0, 0), cA, voffA); PG8_STAGE(PG8_SB(0, 1), cB + hstep, voffB); PG8_STAGE(PG8_SA(0, 1), cA + hstep, voffA);
        if (wr == 1) PG8_BAR;
        PG8_WAIT_V(4); PG8_BAR;
        PG8_STAGE(PG8_SB(1, 0), cB + kstep, voffB); PG8_STAGE(PG8_SA(1, 0), cA + kstep, voffA); PG8_STAGE(PG8_SB(1, 1), cB + hstep + kstep, voffB);
        PG8_WAIT_V(6); PG8_BAR;
    }
    for (;;) {
        const bool has_next = S.next(ui + 1, nxt);
        const char* nA = has_next ? (const char*)g.A + (size_t)nxt.pm * tstep : cA; const char* nB = has_next ? (const char*)g.Bt + (size_t)nxt.pn * tstep : cB;
        for (int t = 0; t < nt; t += 2) {
            const bool last = (t == nt - 2);
            const char* a1 = cA + (size_t)(t + 1) * kstep;
            const char* a2 = last ? nA : cA + (size_t)(t + 2) * kstep; const char* b2 = last ? nB : cB + (size_t)(t + 2) * kstep;
            const char* a3 = a2 + kstep; const char* b3 = b2 + kstep;
            if (last && has_next) S.a_ready(nxt);
            if constexpr (SP2) {
            PG8_LDB(B0, 0, 0); PG8_LDB(B1, 0, 1); PG8_SCHED; PG8_LDA(At, 0, 0); PG8_STAGE(PG8_SA(1, 1), a1 + hstep, voffA);
            PG8_WAIT_V(8); PG8_WAIT_L(0); PG8_BAR; PG8_MMA(0, 0, At, B0); PG8_MMA(0, 1, At, B1); PG8_BAR; PG8_SCHED;
            PG8_LDA(At, 0, 1); PG8_STAGE(PG8_SB(0, 0), b2, voffB); PG8_STAGE(PG8_SB(0, 1), b2 + hstep, voffB); PG8_STAGE(PG8_SA(0, 0), a2, voffA);
            PG8_WAIT_V(8); PG8_WAIT_L(0); PG8_BAR; PG8_MMA(1, 0, At, B0); PG8_MMA(1, 1, At, B1); PG8_BAR; PG8_SCHED;
            PG8_LDB(B0, 1, 0); PG8_LDB(B1, 1, 1); PG8_SCHED; PG8_LDA(At, 1, 0); PG8_STAGE(PG8_SA(0, 1), a2 + hstep, voffA);
            PG8_WAIT_V(8); PG8_WAIT_L(0); PG8_BAR; PG8_MMA(0, 0, At, B0); PG8_MMA(0, 1, At, B1); PG8_BAR; PG8_SCHED;
            PG8_LDA(At, 1, 1); PG8_STAGE(PG8_SB(1, 0), b3, voffB); PG8_STAGE(PG8_SB(1, 1), b3 + hstep, voffB); PG8_STAGE(PG8_SA(1, 0), a3, voffA);
            PG8_WAIT_V(8); PG8_WAIT_L(0); PG8_BAR; PG8_MMA(1, 0, At, B0); PG8_MMA(1, 1, At, B1); PG8_BAR; PG8_SCHED;
            } else {
            PG8_LDB(B0, 0, 0); PG8_SCHED; PG8_LDA(At, 0, 0); PG8_STAGE(PG8_SA(1, 1), a1 + hstep, voffA);
            PG8_WAIT_L(8); PG8_BAR; PG8_WAIT_L(0); PG8_MMA(0, 0, At, B0); PG8_BAR; PG8_SCHED;
            PG8_LDB(B1, 0, 1); PG8_STAGE(PG8_SB(0, 0), b2, voffB);
            PG8_BAR; PG8_WAIT_L(0); PG8_MMA(0, 1, At, B1); PG8_BAR;
            PG8_LDA(At, 0, 1); PG8_STAGE(PG8_SA(0, 0), a2, voffA);
            PG8_BAR; PG8_WAIT_L(0); PG8_MMA(1, 0, At, B0); PG8_BAR; PG8_SCHED;
            PG8_STAGE(PG8_SB(0, 1), b2 + hstep, voffB);
            PG8_WAIT_V(6); PG8_BAR; PG8_MMA(1, 1, At, B1); PG8_BAR;
            PG8_LDB(B0, 1, 0); PG8_SCHED; PG8_LDA(At, 1, 0); PG8_STAGE(PG8_SA(0, 1), a2 + hstep, voffA);
            PG8_WAIT_L(8); PG8_BAR; PG8_WAIT_L(0); PG8_MMA(0, 0, At, B0); PG8_BAR; PG8_SCHED;
            PG8_LDB(B1, 1, 1); PG8_STAGE(PG8_SB(1, 0), b3, voffB);
            PG8_BAR; PG8_WAIT_L(0); PG8_MMA(0, 1, At, B1); PG8_BAR;
            PG8_LDA(At, 1, 1); PG8_STAGE(PG8_SA(1, 0), a3, voffA);
            PG8_BAR; PG8_WAIT_L(0); PG8_MMA(1, 0, At, B0); PG8_BAR; PG8_SCHED;
            PG8_STAGE(PG8_SB(1, 1), b3 + hstep, voffB);
            PG8_WAIT_V(6); PG8_BAR; PG8_MMA(1, 1, At, B1); PG8_BAR;
            }
        }
        if constexpr (ALIGN_EPI) { if (wr == 0) PG8_BAR; }
        if constexpr (!Epi::AFTER_DRAIN) { E(acc, cur, wr, wc, fr, fq); S.done(cur); }
        if (!has_next) break;
#pragma unroll
        for (int a = 0; a < 2; ++a)
#pragma unroll
            for (int b = 0; b < 2; ++b)
#pragma unroll
                for (int m = 0; m < 4; ++m)
#pragma unroll
                    for (int n = 0; n < 2; ++n) acc[a][b][m][n] = (f32x4){0.f, 0.f, 0.f, 0.f};
        cur = nxt; cA = nA; cB = nB; ++ui;
        if constexpr (ALIGN_EPI) { if (wr == 1) PG8_BAR; }
    }
    PG8_WAIT_V(0);
    if constexpr (!ALIGN_EPI) { if (wr == 0) PG8_BAR; }
    PG8_BAR;
    if constexpr (Epi::AFTER_DRAIN) { E.fused(acc, cur, wr, wc, fr, fq, lds, wid, lane); S.done(cur); }
#undef PG8_SA
#undef PG8_SB
#undef PG8_STAGE
#undef PG8_LDA
#undef PG8_LDB
#undef PG8_MMA
#undef PG8_WAIT_V
#undef PG8_WAIT_L
#undef PG8_BAR
#undef PG8_SCHED
}
}
#define XB_TMO      128
#define XB_XCNT(j)  (256  + 64 * (j))
#define XB_XSUB(j)  (1280 + 64 * (j))
#define XB_XGEN(j)  (2304 + 64 * (j))
#define XB_TOP      3328
#define XB_TOPGEN   3392
#define XCD_BAR_WORDS 3456
#define XB_SPIN_CAP (1u << 18)

__device__ __forceinline__ unsigned xb_ld(unsigned* p)              { return __hip_atomic_load(p, __ATOMIC_RELAXED, __HIP_MEMORY_SCOPE_AGENT); }
__device__ __forceinline__ unsigned xb_add(unsigned* p, unsigned v) { return __hip_atomic_fetch_add(p, v, __ATOMIC_RELAXED, __HIP_MEMORY_SCOPE_AGENT); }
__device__ __forceinline__ unsigned xb_xcc_id() { return (unsigned)__builtin_amdgcn_s_getreg((3 << 11) | 20) & 0xFu; }
#define XB_SPIN(cond, bar) do { unsigned _sp = 0; while (cond) { __builtin_amdgcn_s_sleep(1); \
    if ((++_sp & 255u) == 0u) { if (xb_ld(&(bar)[XB_TMO])) break; if (_sp > XB_SPIN_CAP) { atomicAdd(&(bar)[XB_TMO], 1u); break; } } } } while (0)

struct XcdBarrier {
    unsigned* bar; unsigned x;
    volatile LAS unsigned* st;
};

__device__ __forceinline__ XcdBarrier xcd_barrier_post(unsigned* bar, volatile LAS unsigned* st) {
    XcdBarrier b; b.bar = bar; b.x = xb_xcc_id(); b.st = st;
    if (threadIdx.x == 0) (void)xb_add(&bar[XB_XCNT(b.x)], 1u);
    return b;
}
__device__ __forceinline__ void xcd_barrier_complete(unsigned* bar, unsigned x, unsigned& nloc, unsigned& nx) {
    const unsigned G = gridDim.x * gridDim.y * gridDim.z;
    unsigned sum, cnt, mine, sp = 0u;
    for (;;) {
        sum = 0u; cnt = 0u; mine = 0u;
#pragma unroll
        for (unsigned j = 0; j < 16; ++j) { const unsigned c = xb_ld(&bar[XB_XCNT(j)]); sum += c; cnt += (c > 0u) ? 1u : 0u; mine = (j == x) ? c : mine; }
        if (sum == G) break;
        __builtin_amdgcn_s_sleep(1);
        if ((++sp & 255u) == 0u) { if (xb_ld(&bar[XB_TMO])) break; if (sp > XB_SPIN_CAP) { atomicAdd(&bar[XB_TMO], 1u); break; } }
    }
    nloc = mine > 0u ? mine : 1u; nx = cnt > 0u ? cnt : 1u;
}

__device__ __forceinline__ void xcd_barrier(const XcdBarrier& b) {
    asm volatile("s_waitcnt vmcnt(0)" ::: "memory");
    __syncthreads();
    if (threadIdx.x == 0) {
        unsigned* bar = b.bar;
        __builtin_amdgcn_s_waitcnt(0);
        unsigned nloc = b.st[0], nx = b.st[1];
        if (nloc == 0u) { xcd_barrier_complete(bar, b.x, nloc, nx); b.st[0] = nloc; b.st[1] = nx; }
        const unsigned old = xb_add(&bar[XB_XSUB(b.x)], 1u);
        const unsigned gen = old / nloc;
        if (old + 1u == (gen + 1u) * nloc) {
            __builtin_amdgcn_fence(__ATOMIC_RELEASE, "agent");
            asm volatile("s_waitcnt vmcnt(0)" ::: "memory");
            const unsigned og = xb_add(&bar[XB_TOP], 1u);
            const unsigned tg = og / nx;
            if (og + 1u == (tg + 1u) * nx) xb_add(&bar[XB_TOPGEN], 1u);
            else XB_SPIN(xb_ld(&bar[XB_TOPGEN]) == tg, bar);
            __builtin_amdgcn_fence(__ATOMIC_ACQUIRE, "agent");
            xb_add(&bar[XB_XGEN(b.x)], 1u);
            asm volatile("s_waitcnt vmcnt(0)" ::: "memory");
        } else {
            XB_SPIN(xb_ld(&bar[XB_XGEN(b.x)]) == gen, bar);
            __builtin_amdgcn_fence(__ATOMIC_ACQUIRE, "agent");
            asm volatile("s_waitcnt vmcnt(0)" ::: "memory");
        }
    }
    __syncthreads();
}
typedef unsigned short bf16;
typedef unsigned v4u __attribute__((ext_vector_type(4)));
typedef unsigned v2u __attribute__((ext_vector_type(2)));
typedef float f32x4 __attribute__((ext_vector_type(4)));
typedef short bf16x8 __attribute__((ext_vector_type(8)));
constexpr int NB = 2, S = 8192, T = NB * S, D = 1024, DEPTH = 2, DFF = 2816, DIN = 5080;
constexpr int NWAVES = 8, NTHR = 512;
constexpr float RMS_EPS = 1e-6f;
constexpr int WI_AQ = 0, WI_CKV = 512, WI_IQ = 640, WI_IK = 1152, WI_IW = 1216, WI_BQKV = 1224, WI_CQ = 3528, WI_CK = 3784, WI_CV = 4040, WI_CG = 4552, WI_CA = 5064;
constexpr int NBIG = 9216, RB0 = 0, NRB = 2304, RAC0 = 2304, NRAC = 3840, RG0 = 6144, NRG = 3072;
constexpr int LA2 = 2816, A2_QR = 0, A2_IQ = 128, A2_IK = 640, A2_IW = 704, A2_CKV = 768, A2_KR = 896, A2_CQ = 1024, A2_CK = 1280, A2_CV = 1536, A2_CG = 2048, A2_CAL = 2560;
constexpr int LPB = 2304;
constexpr float QSCALE = 0.18033688011112042f;

constexpr size_t MiB = 1u << 20;
constexpr size_t WS_CTL = 0, CTL_ZERO_BYTES = 1 * MiB;
constexpr size_t WS_W = 1 * MiB;
constexpr size_t WS_CS = 25 * MiB;
constexpr size_t WS_XN = 26 * MiB;
constexpr size_t WS_FB = 58 * MiB;
constexpr size_t WS_YB = 90 * MiB;
constexpr size_t WS_YA = 98 * MiB;
constexpr size_t WS_YC = 130 * MiB;
constexpr size_t WS_BIG = 146 * MiB;
constexpr size_t WS_DEC = 242 * MiB;
constexpr size_t WS_END = 243 * MiB;
constexpr size_t WO_W1 = 0, WO_W2 = (size_t)2 * DFF * D;
constexpr size_t WO_BIG = 0, WO_MA = (size_t)NBIG * D, WO_MB = WO_MA + (size_t)D * 1024, WO_MC = WO_MB + (size_t)D * 256, WO_WO = WO_MC + (size_t)D * 512;
static_assert((WO_WO + (size_t)D * D) * 2 <= 24 * MiB && (WO_W2 + (size_t)D * DFF) * 2 <= 24 * MiB, "weights region");
constexpr int CW_BAR = 4096;

constexpr int RING_BYTES = 131072, MISC_OFF = RING_BYTES + 320, LDS_BYTES = 147456;

#define RLX_AGENT __ATOMIC_RELAXED, __HIP_MEMORY_SCOPE_AGENT
#define LDS_WAIT() asm volatile("s_waitcnt lgkmcnt(0)" ::: "memory")
#define VM_WAIT() asm volatile("s_waitcnt vmcnt(0)" ::: "memory")
__device__ __forceinline__ unsigned char* opaque_ptr(unsigned char* p) { GAS unsigned char* g = (GAS unsigned char*)p; asm volatile("" : "+s"(g)); return (unsigned char*)g; }
__device__ __forceinline__ int otid() { int t = threadIdx.x; asm volatile("" : "+v"(t)); return t; }
__device__ __forceinline__ int obid() { int b = blockIdx.x; asm volatile("" : "+s"(b)); return b; }
__device__ __forceinline__ unsigned f2bf(float f) { unsigned u = __builtin_bit_cast(unsigned, f); return (u + 0x7fffu + ((u >> 16) & 1u)) >> 16; }
__device__ __forceinline__ unsigned pk2(float lo, float hi) { return f2bf(lo) | (f2bf(hi) << 16); }
__device__ __forceinline__ float bf2f(bf16 v) { return __uint_as_float((unsigned)v << 16); }
__device__ __forceinline__ float blo(unsigned w) { return __uint_as_float(w << 16); }
__device__ __forceinline__ float bhi(unsigned w) { return __uint_as_float(w & 0xffff0000u); }
__device__ __forceinline__ float wave_sum(float v) {
#pragma unroll
    for (int o = 1; o < 64; o <<= 1) v += __shfl_xor(v, o);
    return v;
}
__device__ __forceinline__ float wave_max(float v) {
#pragma unroll
    for (int o = 1; o < 64; o <<= 1) v = fmaxf(v, __shfl_xor(v, o));
    return v;
}

struct Args {
    const float* in[24]; float* out; unsigned char* ws; int l, pad;
};
enum { I_X = 0, I_POS, I_F1PRE, I_F1WIN, I_F1WOUT, I_F1POST, I_MIXPRE, I_WIN, I_AKVG, I_AWKV, I_CWAL, I_CBAL, I_CNORM, I_WBA, I_WBB, I_WBC, I_WGATE, I_BGATE, I_WOUT, I_MIXPOST, I_F2PRE, I_F2WIN, I_F2WOUT, I_F2POST };

__device__ __forceinline__ void cvt_tile(const float* src, int ld, int col0, int ncols, int k0, bf16* dst, int K, int drow0, float scale, bool zfill, LAS float* scr, int tid) {
    __syncthreads();
#pragma unroll
    for (int i = 0; i < 8; ++i) { const int kk = (tid >> 6) + 8 * i, n = tid & 63; scr[kk * 65 + n] = (n < ncols) ? src[(size_t)(k0 + kk) * ld + col0 + n] * scale : 0.f; }
    __syncthreads();
    const int n = tid >> 3, c = tid & 7;
    if (n < ncols || zfill) { const LAS float* s = scr + (8 * c) * 65 + n;
        v4u o; o.x = pk2(s[0], s[65]); o.y = pk2(s[2 * 65], s[3 * 65]); o.z = pk2(s[4 * 65], s[5 * 65]); o.w = pk2(s[6 * 65], s[7 * 65]);
        *(v4u*)(dst + (size_t)(drow0 + n) * K + k0 + 8 * c) = o; }
}
__device__ __forceinline__ void cvt_block(const float* src, int ld, int col0, int ncols, int K, bf16* dst, int drow0, float scale, bool zfill, LAS float* scr, int& rot) {
    const int G = gridDim.x, nct = (ncols + 63) / 64, nkt = K / 64, nt = nct * nkt;
    for (int t = (obid() - rot % G + G) % G; t < nt; t += G) { const int ct = t / nkt, kt = t % nkt; const int nc = ncols - 64 * ct < 64 ? ncols - 64 * ct : 64;
        cvt_tile(src, ld, col0 + 64 * ct, nc, 64 * kt, dst, K, drow0 + 64 * ct, scale, zfill, scr, otid()); }
    rot += nt;
}
__device__ __forceinline__ void cvt_ffn(const float* w_in, const float* w_out, bf16* W1t, bf16* W2t, LAS float* scr) {
    const int G = gridDim.x;
    constexpr int NRT = 2 * DFF / 64, NKT = D / 64;
    for (int t = obid(); t < NRT * NKT; t += G) { const int rt = t / NKT, kt = t % NKT; const int pn = rt >> 2, w = (rt & 3) * 64;
        const int col = (w < 128) ? 128 * pn + w : DFF + 128 * pn + (w - 128);
        cvt_tile(w_in, 2 * DFF, col, 64, 64 * kt, W1t, D, 64 * rt, 1.0f, false, scr, otid()); }
    int rot = NRT * NKT;
    cvt_block(w_out, D, 0, D, DFF, W2t, 0, 1.0f, false, scr, rot);
}
template <class C> __device__ __forceinline__ void cvt_mixer(const C& a, int l, bf16* W, LAS float* scr) {
    const float* w_in = a.in(I_WIN) + (size_t)l * D * DIN;
    const float* wkv = a.in(I_AWKV) + (size_t)l * 128 * 1024;
    bf16* Wbig = W + WO_BIG;
    int rot = 0;
    cvt_block(w_in, DIN, WI_BQKV, 768, D, Wbig, RB0, QSCALE, false, scr, rot);
    cvt_block(w_in, DIN, WI_BQKV + 768, 1536, D, Wbig, RB0 + 768, 1.0f, false, scr, rot);
    const int R2 = RAC0 + 1024;
#pragma unroll 1
    for (int h = 0; h < 8; ++h) cvt_block(w_in, DIN, WI_AQ + 64 * h, 16, D, Wbig, R2 + A2_QR + 16 * h, QSCALE, false, scr, rot);
    cvt_block(w_in, DIN, WI_IQ, 512, D, Wbig, R2 + A2_IQ, 1.0f, false, scr, rot);
    cvt_block(w_in, DIN, WI_IK, 64, D, Wbig, R2 + A2_IK, 1.0f, false, scr, rot);
    cvt_block(w_in, DIN, WI_IW, 8, D, Wbig, R2 + A2_IW, 1.0f, true, scr, rot);
    cvt_block(w_in, DIN, WI_CKV, 128, D, Wbig, R2 + A2_CKV, 1.0f, false, scr, rot);
    cvt_block(w_in, DIN, WI_CQ, 256, D, Wbig, R2 + A2_CQ, 0.125f, false, scr, rot);
    cvt_block(w_in, DIN, WI_CK, 256 + 512 + 512, D, Wbig, R2 + A2_CK, 1.0f, false, scr, rot);
    cvt_block(a.in(I_WGATE) + (size_t)l * D * 3072, 3072, 0, 3072, D, Wbig, RG0, 1.0f, false, scr, rot);
    cvt_block(a.in(I_WBB) + (size_t)l * 256 * D, D, 0, D, 256, W + WO_MB, 0, 1.0f, false, scr, rot);
    cvt_block(a.in(I_WBC) + (size_t)l * 512 * D, D, 0, D, 512, W + WO_MC, 0, 1.0f, false, scr, rot);
    cvt_block(a.in(I_WOUT) + (size_t)l * D * D, D, 0, D, D, W + WO_WO, 0, 1.0f, false, scr, rot);
    const int gt = obid() * NTHR + otid(), GT = gridDim.x * NTHR;
    for (int e = gt; e < 1024 * D; e += GT) { const int d = e & 1023, rc = e >> 10, h = rc >> 7, c = rc & 127;
        const float* wi = w_in + (size_t)d * DIN + WI_AQ + 64 * h; const float* wk = wkv + (size_t)c * 1024 + 128 * h; float s = 0.f;
#pragma unroll 8
        for (int j = 16; j < 64; ++j) s += wi[j] * wk[j];
        Wbig[(size_t)(RAC0 + rc) * D + d] = (bf16)f2bf(s * QSCALE); }
    const float* gkv = a.in(I_AKVG) + (size_t)l * 128;
    for (int e = gt; e < 128 * D; e += GT) { const int d = e & 1023, rc = e >> 10, h = rc >> 4, i = rc & 15;
        const float* wi = w_in + (size_t)d * DIN + WI_CKV; float s = 0.f;
#pragma unroll 8
        for (int c = 0; c < 128; ++c) s += wi[c] * gkv[c] * wkv[(size_t)c * 1024 + 128 * h + i];
        Wbig[(size_t)(R2 + A2_KR + rc) * D + d] = (bf16)f2bf(s); }
    const float* wal = a.in(I_CWAL) + (size_t)l * 16 * 256;
    for (int e = gt; e < 256 * D; e += GT) { const int d = e & 1023, n = e >> 10;
        const float* wi = w_in + (size_t)d * DIN + WI_CA; float s = 0.f;
#pragma unroll
        for (int r = 0; r < 16; ++r) s += wi[r] * wal[r * 256 + n];
        Wbig[(size_t)(R2 + A2_CAL + n) * D + d] = (bf16)f2bf(s); }
    const float* wba = a.in(I_WBA) + (size_t)l * 512 * D;
    for (int e = gt; e < 1024 * 1024; e += GT) { const int k = e & 1023, n = e >> 10, h = k >> 7, c = k & 127;
        const float* wk = wkv + (size_t)c * 1024 + 128 * h + 64; const float* wb = wba + (size_t)(64 * h) * D + n; float s = 0.f;
#pragma unroll 8
        for (int j = 0; j < 64; ++j) s += wk[j] * wb[(size_t)j * D];
        (W + WO_MA)[(size_t)n * 1024 + k] = (bf16)f2bf(s); }
}

__device__ __forceinline__ void cs_phase(const int* pos, float* cs) {
    const int gt = obid() * NTHR + otid(), GT = gridDim.x * NTHR;
    for (int e = gt; e < T * 8; e += GT) { const int t = e >> 3, i = e & 7;
        const double frev = (i == 0) ? 0.15915494309189535 : (i == 1) ? 0.03086376340470123 : (i == 2) ? 0.005985185712713705 : (i == 3) ? 0.001160663641240061 :
                            (i == 4) ? 0.00022507907903927653 : (i == 5) ? 4.364795279280289e-05 : (i == 6) ? 8.464330808241401e-06 : 1.6414262627950345e-06;
        const double rev = (double)pos[t] * frev; const float fr = (float)(rev - __builtin_floor(rev));
        cs[(size_t)t * 16 + i] = __builtin_amdgcn_cosf(fr); cs[(size_t)t * 16 + 8 + i] = __builtin_amdgcn_sinf(fr); }
}
__device__ __forceinline__ void resid_phase(const float* hin, float* hout, const bf16* f, float w, const float* gpost, const float* gpre, bf16* xn) {
    const int lane = otid() & 63, gw = obid() * NWAVES + (otid() >> 6), NGW = gridDim.x * NWAVES;
    for (int r = gw; r < T; r += NGW) {
        f32x4 v[4];
#pragma unroll
        for (int j = 0; j < 4; ++j) v[j] = *(const f32x4*)(hin + (size_t)r * D + 256 * j + 4 * lane);
        if (f) { f32x4 fv[4]; float s = 0.f;
#pragma unroll
            for (int j = 0; j < 4; ++j) { const v2u p = *(const v2u*)(f + (size_t)r * D + 256 * j + 4 * lane); fv[j] = (f32x4){blo(p.x), bhi(p.x), blo(p.y), bhi(p.y)};
                s += (fv[j][0] * fv[j][0] + fv[j][1] * fv[j][1]) + (fv[j][2] * fv[j][2] + fv[j][3] * fv[j][3]); }
            const float rstd = w * __builtin_amdgcn_rsqf(wave_sum(s) * (1.0f / D) + RMS_EPS);
#pragma unroll
            for (int j = 0; j < 4; ++j) { const f32x4 g = *(const f32x4*)(gpost + 256 * j + 4 * lane); v[j] = v[j] + fv[j] * rstd * g; }
        }
#pragma unroll
        for (int j = 0; j < 4; ++j) *(f32x4*)(hout + (size_t)r * D + 256 * j + 4 * lane) = v[j];
        if (xn) { float s = 0.f;
#pragma unroll
            for (int j = 0; j < 4; ++j) s += (v[j][0] * v[j][0] + v[j][1] * v[j][1]) + (v[j][2] * v[j][2] + v[j][3] * v[j][3]);
            const float rstd = __builtin_amdgcn_rsqf(wave_sum(s) * (1.0f / D) + RMS_EPS);
#pragma unroll
            for (int j = 0; j < 4; ++j) { const f32x4 g = *(const f32x4*)(gpre + 256 * j + 4 * lane); const f32x4 o = v[j] * rstd * g;
                v2u p; p.x = pk2(o[0], o[1]); p.y = pk2(o[2], o[3]); *(v2u*)(xn + (size_t)r * D + 256 * j + 4 * lane) = p; }
        }
    }
}
__device__ __forceinline__ void rec_phase(const bf16* pA2, const float* gkv, const float* cs, bf16* rec) {
    const int lane = otid() & 63, gw = obid() * NWAVES + (otid() >> 6), NGW = gridDim.x * NWAVES;
    for (int r = gw; r < T; r += NGW) {
        const unsigned pc = *(const unsigned*)(pA2 + (size_t)r * LA2 + A2_CKV + 2 * lane), pk = *(const unsigned*)(pA2 + (size_t)r * LA2 + A2_KR + 2 * lane);
        const float c0 = blo(pc), c1 = bhi(pc);
        const float rstd = __builtin_amdgcn_rsqf(wave_sum(c0 * c0 + c1 * c1) * (1.0f / 128.0f) + RMS_EPS);
        *(unsigned*)(rec + (size_t)r * 256 + 2 * lane) = pk2(c0 * rstd * gkv[2 * lane], c1 * rstd * gkv[2 * lane + 1]);
        const float k0 = blo(pk) * rstd, k1 = bhi(pk) * rstd;
        const float q0 = __shfl_xor(k0, 4), q1 = __shfl_xor(k1, 4);
        const int i0 = (2 * lane) & 7; const bool hi = ((2 * lane) & 8) != 0;
        const float cc0 = cs[(size_t)r * 16 + i0], cc1 = cs[(size_t)r * 16 + i0 + 1], ss0 = cs[(size_t)r * 16 + 8 + i0], ss1 = cs[(size_t)r * 16 + 8 + i0 + 1];
        const float o0 = hi ? k0 * cc0 + q0 * ss0 : k0 * cc0 - q0 * ss0, o1 = hi ? k1 * cc1 + q1 * ss1 : k1 * cc1 - q1 * ss1;
        *(unsigned*)(rec + (size_t)r * 256 + 128 + 2 * lane) = pk2(o0, o1);
    }
}
__device__ __forceinline__ unsigned pack_score(float sc, int idx) {
    const unsigned u = __float_as_uint(sc); const unsigned m = u ^ ((u >> 31) ? 0xffffffffu : 0x80000000u);
    return (m & 0xffffe000u) | (unsigned)idx;
}
__device__ __forceinline__ void nv_idx_phase(const bf16* pA2, unsigned short* sel, LAS unsigned char* lds) {
    LAS float* qs = (LAS float*)lds;
    LAS float* ws_ = qs + 512;
    LAS unsigned* ctr = (LAS unsigned*)(ws_ + 8);
    LAS unsigned* pk = (LAS unsigned*)(lds + 4096);
    const int tid = otid();
    for (int q0 = obid(); q0 < T; q0 += gridDim.x) {
        const int q = ((q0 & 1) ? (T - 1 - (q0 >> 1)) : (q0 >> 1));
        const int b = q / S, t = q % S, n = t + 1;
        __syncthreads();
        qs[tid] = bf2f(pA2[(size_t)q * LA2 + A2_IQ + tid]);
        if (tid < 8) ws_[tid] = bf2f(pA2[(size_t)q * LA2 + A2_IW + tid]);
        if (tid < 8) ctr[tid] = 0u;
        __syncthreads();
        for (int s = tid; s < n; s += NTHR) {
            const v4u* kp = (const v4u*)(pA2 + (size_t)(b * S + s) * LA2 + A2_IK);
            v4u kq[8];
#pragma unroll
            for (int c = 0; c < 8; ++c) kq[c] = kp[c];
            float sc = 0.f;
#pragma unroll 1
            for (int h = 0; h < 8; ++h) { float d = 0.f; const LAS float* qh = qs + h * 64;
#pragma unroll
                for (int c = 0; c < 8; ++c) d += qh[8 * c] * blo(kq[c].x) + qh[8 * c + 1] * bhi(kq[c].x) + qh[8 * c + 2] * blo(kq[c].y) + qh[8 * c + 3] * bhi(kq[c].y) + qh[8 * c + 4] * blo(kq[c].z) + qh[8 * c + 5] * bhi(kq[c].z) + qh[8 * c + 6] * blo(kq[c].w) + qh[8 * c + 7] * bhi(kq[c].w);
                sc += ws_[h] * fmaxf(d, 0.f); }
            pk[s] = pack_score(sc, s);
        }
        __syncthreads();
        unsigned thr = 0u;
        if (n > 256) {
            unsigned lo = 0u, hi = 0xffffffffu; int it = 0;
            for (;;) {
                const unsigned mid = lo + ((hi - lo) >> 1);
                unsigned c = 0;
                for (int s = tid; s < n; s += NTHR) c += (pk[s] >= mid) ? 1u : 0u;
#pragma unroll
                for (int o = 1; o < 64; o <<= 1) c += __shfl_xor(c, o);
                const int slot = 1 + (it & 3);
                if ((tid & 63) == 0) atomicAdd((unsigned*)&ctr[slot], c);
                __syncthreads();
                const unsigned tot = ctr[slot];
                if (tid == 0) ctr[1 + ((it + 2) & 3)] = 0u;
                ++it;
                if (tot == 256u || hi - lo <= 1u || it > 40) { thr = mid; break; }
                if (tot > 256u) lo = mid; else hi = mid;
            }
        }
        __syncthreads();
        unsigned base = 0u;
        for (int s0 = 0; s0 < n; s0 += NTHR) { const int s = s0 + tid; const bool keep = (s < n) && (pk[s] >= thr);
            const unsigned long long bm = __ballot(keep); const unsigned wc_ = (unsigned)__popcll(bm);
            __syncthreads();
            if ((tid & 63) == 0) ctr[tid >> 6] = wc_;
            __syncthreads();
            unsigned off = base, tot = 0u;
#pragma unroll
            for (int w = 0; w < 8; ++w) { const unsigned c = ctr[w]; if (w < (tid >> 6)) off += c; tot += c; }
            if (keep) { const unsigned p = off + (unsigned)__popcll(bm & ((1ull << (tid & 63)) - 1ull)); if (p < 256u) sel[(size_t)q * 256 + p] = (unsigned short)s; }
            base += tot; }
        const unsigned cnt = base < 256u ? base : 256u;
        if (tid < 256 && (unsigned)tid >= cnt) sel[(size_t)q * 256 + tid] = 0xffffu;
    }
}
__device__ __forceinline__ void nv_atta_phase(const bf16* pA2, bf16* ya, const bf16* rec, const unsigned short* sel, LAS unsigned char* lds) {
    LAS float* qa = (LAS float*)lds;
    LAS float* qr = qa + 1024;
    LAS float* P = qr + 128;
    LAS int* sl = (LAS int*)(P + 2048);
    const int tid = otid(), lane = tid & 63, wv = tid >> 6;
    for (int q = obid(); q < T; q += gridDim.x) {
        const int b = q / S;
        __syncthreads();
        qa[tid] = bf2f(ya[(size_t)q * 1024 + tid]); qa[tid + 512] = bf2f(ya[(size_t)q * 1024 + 512 + tid]);
        if (tid < 128) qr[tid] = bf2f(pA2[(size_t)q * LA2 + A2_QR + tid]);
        if (tid < 256) sl[tid] = sel[(size_t)q * 256 + tid];
        __syncthreads();
        { const int k = tid & 255, hh = tid >> 8; const int key = sl[k]; const bool valid = key != 0xffff;
          const bf16* rp = rec + (size_t)(b * S + (valid ? key : 0)) * 256;
          float s4[4] = {0.f, 0.f, 0.f, 0.f};
          for (int c8 = 0; c8 < 16; ++c8) { const v4u w = *(const v4u*)(rp + 8 * c8); const float x[8] = {blo(w.x), bhi(w.x), blo(w.y), bhi(w.y), blo(w.z), bhi(w.z), blo(w.w), bhi(w.w)};
#pragma unroll
              for (int h = 0; h < 4; ++h)
#pragma unroll
                  for (int e = 0; e < 8; ++e) s4[h] += qa[(hh * 4 + h) * 128 + 8 * c8 + e] * x[e]; }
#pragma unroll
          for (int h = 0; h < 4; ++h) { const int hd = hh * 4 + h; const v4u w0 = *(const v4u*)(rp + 128 + 16 * hd), w1 = *(const v4u*)(rp + 128 + 16 * hd + 8);
              const float x[16] = {blo(w0.x), bhi(w0.x), blo(w0.y), bhi(w0.y), blo(w0.z), bhi(w0.z), blo(w0.w), bhi(w0.w), blo(w1.x), bhi(w1.x), blo(w1.y), bhi(w1.y), blo(w1.z), bhi(w1.z), blo(w1.w), bhi(w1.w)};
#pragma unroll
              for (int e = 0; e < 16; ++e) s4[h] += qr[hd * 16 + e] * x[e];
              P[hd * 256 + k] = valid ? s4[h] : -INFINITY; } }
        __syncthreads();
        { float v[4]; float m = -INFINITY;
#pragma unroll
          for (int j = 0; j < 4; ++j) { v[j] = P[wv * 256 + lane + 64 * j]; m = fmaxf(m, v[j]); }
          m = wave_max(m); float sum = 0.f;
#pragma unroll
          for (int j = 0; j < 4; ++j) { v[j] = exp2f(v[j] - m); sum += v[j]; }
          sum = wave_sum(sum); const float inv = 1.0f / sum;
#pragma unroll
          for (int j = 0; j < 4; ++j) P[wv * 256 + lane + 64 * j] = v[j] * inv; }
        __syncthreads();
        { const int c = tid & 127, hq = tid >> 7; float o0 = 0.f, o1 = 0.f;
          for (int k = 0; k < 256; ++k) { const int key = sl[k]; if (key == 0xffff) continue; const float x = bf2f(rec[(size_t)(b * S + key) * 256 + c]); o0 += P[(2 * hq) * 256 + k] * x; o1 += P[(2 * hq + 1) * 256 + k] * x; }
          ya[(size_t)q * 1024 + (2 * hq) * 128 + c] = (bf16)f2bf(o0); ya[(size_t)q * 1024 + (2 * hq + 1) * 128 + c] = (bf16)f2bf(o1); }
    }
}
__device__ __forceinline__ void nv_attb_phase(const bf16* pB, bf16* yb, LAS unsigned char* lds) {
    const int tid = otid(), lane = tid & 63, wv = tid >> 6;
    LAS float* qv = (LAS float*)lds + wv * 64;
    const int gw = obid() * NWAVES + wv, NGW = gridDim.x * NWAVES;
    for (int item = gw; item < T * 4; item += NGW) {
        const int tg = item >> 2, hs = item & 3, b = tg / S, t = tg % S;
        float m = -INFINITY, l = 0.f, o = 0.f;
#pragma unroll 1
        for (int g = 0; g < 3; ++g) {
            const int dil = (g == 0) ? 1 : (g == 1) ? 4 : 16, head = g * 4 + hs;
            LDS_WAIT();
            qv[lane] = bf2f(pB[(size_t)tg * LPB + head * 64 + lane]);
            LDS_WAIT();
#pragma unroll 1
            for (int pass = 0; pass < 3; ++pass) {
                const int j = pass * 64 + lane, pos = t - dil * j; const bool valid = (j <= 128) && (pos >= 0);
                float s = -INFINITY;
                if (valid) { const v4u* kp = (const v4u*)(pB + (size_t)(b * S + pos) * LPB + 768 + head * 64); float d = 0.f;
#pragma unroll
                    for (int c = 0; c < 8; ++c) { const v4u w = kp[c]; d += qv[8 * c] * blo(w.x) + qv[8 * c + 1] * bhi(w.x) + qv[8 * c + 2] * blo(w.y) + qv[8 * c + 3] * bhi(w.y) + qv[8 * c + 4] * blo(w.z) + qv[8 * c + 5] * bhi(w.z) + qv[8 * c + 6] * blo(w.w) + qv[8 * c + 7] * bhi(w.w); }
                    s = d; }
                const float mx = wave_max(s);
                if (mx == -INFINITY) continue;
                const float mn = fmaxf(m, mx), p = valid ? exp2f(s - mn) : 0.f, scl = exp2f(m - mn);
                l = l * scl + wave_sum(p); o *= scl; m = mn;
                const int nj = (pass == 2) ? 1 : 64;
                for (int jj = 0; jj < nj; ++jj) { const float pj = __shfl(p, jj); const int pj_pos = t - dil * (pass * 64 + jj);
                    if (pj_pos >= 0) o += pj * bf2f(pB[(size_t)(b * S + pj_pos) * LPB + 1536 + head * 64 + lane]); }
            }
        }
        yb[(size_t)tg * 256 + hs * 64 + lane] = (bf16)f2bf(o / l);
    }
}
__device__ __forceinline__ float logsigmoid_f(float x) { return fminf(x, 0.f) - log1pf(__expf(-fabsf(x))); }
__device__ __forceinline__ void nv_gla_phase(const bf16* pA2, const float* cbal, bf16* yc) {
    const int lane = otid() & 63, gw = obid() * NWAVES + (otid() >> 6), NGW = gridDim.x * NWAVES;
    for (int item = gw; item < NB * 4 * 128; item += NGW) {
        const int b = item >> 9, h = (item >> 7) & 3, dv = item & 127;
        const float bias = cbal[h * 64 + lane];
        float St = 0.f;
        for (int t = 0; t < S; ++t) { const bf16* rp = pA2 + (size_t)(b * S + t) * LA2;
            const float a = __expf(logsigmoid_f(bf2f(rp[A2_CAL + h * 64 + lane]) + bias) * (1.0f / 16.0f));
            const float k = bf2f(rp[A2_CK + h * 64 + lane]), qv = bf2f(rp[A2_CQ + h * 64 + lane]), v = bf2f(rp[A2_CV + h * 128 + dv]);
            St = a * St + k * v;
            const float o = wave_sum(qv * St);
            if (lane == 0) yc[(size_t)(b * S + t) * 512 + h * 128 + dv] = (bf16)f2bf(o); }
    }
}
__device__ __forceinline__ void nv_gla_out_phase(const bf16* pA2, const float* cng, bf16* yc) {
    const int lane = otid() & 63, gw = obid() * NWAVES + (otid() >> 6), NGW = gridDim.x * NWAVES;
    for (int item = gw; item < T * 4; item += NGW) { const int r = item >> 2, h = item & 3;
        const unsigned po = *(const unsigned*)(yc + (size_t)r * 512 + h * 128 + 2 * lane), pg = *(const unsigned*)(pA2 + (size_t)r * LA2 + A2_CG + h * 128 + 2 * lane);
        const float o0 = blo(po), o1 = bhi(po), g0 = blo(pg), g1 = bhi(pg);
        const float rstd = __builtin_amdgcn_rsqf(wave_sum(o0 * o0 + o1 * o1) * (1.0f / 128.0f) + RMS_EPS);
        const float y0 = o0 * rstd * cng[2 * lane] * (g0 / (1.0f + __expf(-g0))), y1 = o1 * rstd * cng[2 * lane + 1] * (g1 / (1.0f + __expf(-g1)));
        *(unsigned*)(yc + (size_t)r * 512 + h * 128 + 2 * lane) = pk2(y0, y1); }
}
typedef short v4i16_t __attribute__((ext_vector_type(4)));
typedef float f32x4_t __attribute__((ext_vector_type(4)));
__device__ __forceinline__ v4i16_t lds_tr(LAS unsigned char* p) { return __builtin_amdgcn_ds_read_tr16_b64_v4i16((LAS v4i16_t*)p); }
__device__ __forceinline__ bf16x8 cat8(v4i16_t a, v4i16_t b) { return __builtin_shufflevector(a, b, 0, 1, 2, 3, 4, 5, 6, 7); }
__device__ __forceinline__ unsigned cvtpk(float lo, float hi) { return pg8::cvt_pk_bf16(lo, hi); }
__device__ __forceinline__ float fast_sig(float x) { return __builtin_amdgcn_rcpf(1.0f + __expf(-x)); }
__device__ __forceinline__ f32x4_t mfma16(bf16x8 a, bf16x8 b, f32x4_t c) { return __builtin_amdgcn_mfma_f32_16x16x32_bf16(a, b, c, 0, 0, 0); }

constexpr int GLA_HEAD_LDS = 39936;
template <int MODE> __device__ __forceinline__ void gla_chunk_phase(const bf16* pA2, const float* cbal, const float* cng, bf16* KVT, float* DEC, bf16* yc, LAS unsigned char* lds) {
    const int tid = otid(), lane = tid & 63, wv = __builtin_amdgcn_readfirstlane(tid >> 6), hh = wv >> 2, sub = wv & 3, ht = tid & 255;
    const int d = ht & 63, fr = lane & 15, g = lane >> 4, q4 = fr >> 2, p4 = fr & 3;
    LAS unsigned char* L = lds + hh * GLA_HEAD_LDS;
    LAS float* tot = (LAS float*)L;
    LAS unsigned char* KI = L + 1024;
    LAS unsigned char* QD = L + 1024 + 10240;
    LAS unsigned char* VI = L + 1024 + 10240 + 9216;
    for (int u = obid(); u < NB * 128 * 2; u += gridDim.x) {
        const int b = u >> 8, n = (u >> 1) & 127, h = (u & 1) * 2 + hh, bh = b * 4 + h;
        const size_t row0 = (size_t)b * S + (size_t)n * 64;
        __syncthreads();
        float bl_[16]; float run = 0.f; const float bias = cbal[h * 64 + d];
#pragma unroll
        for (int i = 0; i < 16; ++i) { const float x = bf2f(pA2[(row0 + sub * 16 + i) * LA2 + A2_CAL + h * 64 + d]) + bias;
            run += (fminf(x, 0.f) - __logf(1.0f + __expf(-fabsf(x)))) * (1.0f / 16.0f); bl_[i] = run; }
        tot[sub * 64 + d] = run;
        __syncthreads();
        float pre = 0.f, all = 0.f;
#pragma unroll
        for (int p = 0; p < 4; ++p) { const float v = tot[p * 64 + d]; pre += (p < sub) ? v : 0.f; all += v; }
#pragma unroll
        for (int i = 0; i < 16; ++i) { const int t = sub * 16 + i; const float bt = bl_[i] + pre; const float kk = bf2f(pA2[(row0 + t) * LA2 + A2_CK + h * 64 + d]);
            if (MODE == 1) { *(LAS unsigned short*)(KI + t * 160 + d * 2) = (unsigned short)f2bf(kk * __expf(all - bt)); }
            else { const float qq = bf2f(pA2[(row0 + t) * LA2 + A2_CQ + h * 64 + d]);
                *(LAS unsigned short*)(KI + t * 144 + d * 2) = (unsigned short)f2bf(kk * __expf(-bt)); *(LAS unsigned short*)(QD + t * 144 + d * 2) = (unsigned short)f2bf(qq * __expf(bt)); } }
        if (MODE == 1 && sub == 0) DEC[((size_t)bh * 128 + n) * 64 + d] = __expf(all);
#pragma unroll
        for (int c = 0; c < 4; ++c) { const int idx = ht + 256 * c, t = idx >> 4, ch = idx & 15;
            *(LAS v4u*)(VI + t * 288 + ch * 16) = *(const v4u*)(pA2 + (row0 + t) * LA2 + A2_CV + h * 128 + ch * 8); }
        __syncthreads();
        if (MODE == 1) {
            f32x4_t acc[2][4];
#pragma unroll
            for (int j = 0; j < 2; ++j)
#pragma unroll
                for (int mb = 0; mb < 4; ++mb) acc[j][mb] = (f32x4_t){0.f, 0.f, 0.f, 0.f};
#pragma unroll
            for (int ks = 0; ks < 2; ++ks) { const int r0 = 32 * ks + 4 * g + q4, r1 = r0 + 16;
                bf16x8 bfr[2];
#pragma unroll
                for (int j = 0; j < 2; ++j) { const int cb = (16 * (2 * sub + j) + 4 * p4) * 2; bfr[j] = cat8(lds_tr(VI + r0 * 288 + cb), lds_tr(VI + r1 * 288 + cb)); }
#pragma unroll
                for (int mb = 0; mb < 4; ++mb) { const int ca = (16 * mb + 4 * p4) * 2; const bf16x8 af = cat8(lds_tr(KI + r0 * 160 + ca), lds_tr(KI + r1 * 160 + ca));
#pragma unroll
                    for (int j = 0; j < 2; ++j) acc[j][mb] = mfma16(af, bfr[j], acc[j][mb]); } }
#pragma unroll
            for (int j = 0; j < 2; ++j)
#pragma unroll
                for (int mb = 0; mb < 4; ++mb) { v2u o; o.x = cvtpk(acc[j][mb][0], acc[j][mb][1]); o.y = cvtpk(acc[j][mb][2], acc[j][mb][3]);
                    *(v2u*)(KVT + (((size_t)bh * 128 + n) * 128 + 16 * (2 * sub + j) + fr) * 64 + 16 * mb + 4 * g) = o; }
        } else {
            const int tq = 16 * sub + fr;
            bf16x8 bq[2];
#pragma unroll
            for (int ks = 0; ks < 2; ++ks) bq[ks] = *(const LAS bf16x8*)(QD + tq * 144 + (32 * ks + 8 * g) * 2);
            unsigned pw[2][4];
#pragma unroll
            for (int ms = 0; ms < 4; ++ms) { f32x4_t sacc = (f32x4_t){0.f, 0.f, 0.f, 0.f};
#pragma unroll
                for (int ks = 0; ks < 2; ++ks) { const bf16x8 ak = *(const LAS bf16x8*)(KI + (16 * ms + fr) * 144 + (32 * ks + 8 * g) * 2); sacc = mfma16(ak, bq[ks], sacc); }
#pragma unroll
                for (int i = 0; i < 4; ++i) if (16 * ms + 4 * g + i > tq) sacc[i] = 0.f;
                pw[ms >> 1][(ms & 1) * 2 + 0] = cvtpk(sacc[0], sacc[1]); pw[ms >> 1][(ms & 1) * 2 + 1] = cvtpk(sacc[2], sacc[3]); }
            f32x4_t oacc[8];
#pragma unroll
            for (int mb = 0; mb < 8; ++mb) oacc[mb] = (f32x4_t){0.f, 0.f, 0.f, 0.f};
#pragma unroll
            for (int ks2 = 0; ks2 < 2; ++ks2) { const int r0 = 32 * ks2 + 4 * g + q4, r1 = r0 + 16;
                const v4u pwv = {pw[ks2][0], pw[ks2][1], pw[ks2][2], pw[ks2][3]}; const bf16x8 pf = __builtin_bit_cast(bf16x8, pwv);
#pragma unroll
                for (int mb = 0; mb < 8; ++mb) { const int ca = (16 * mb + 4 * p4) * 2; const bf16x8 av = cat8(lds_tr(VI + r0 * 288 + ca), lds_tr(VI + r1 * 288 + ca)); oacc[mb] = mfma16(av, pf, oacc[mb]); } }
            const bf16* sp = KVT + ((size_t)bh * 128 + n) * 8192;
#pragma unroll
            for (int ks = 0; ks < 2; ++ks)
#pragma unroll
                for (int mb = 0; mb < 8; ++mb) { const bf16x8 as = *(const bf16x8*)(sp + (16 * mb + fr) * 64 + 32 * ks + 8 * g); oacc[mb] = mfma16(as, bq[ks], oacc[mb]); }
            float ss = 0.f;
#pragma unroll
            for (int mb = 0; mb < 8; ++mb) ss += (oacc[mb][0] * oacc[mb][0] + oacc[mb][1] * oacc[mb][1]) + (oacc[mb][2] * oacc[mb][2] + oacc[mb][3] * oacc[mb][3]);
            ss += __shfl_xor(ss, 16); ss += __shfl_xor(ss, 32);
            const float rstd = __builtin_amdgcn_rsqf(ss * (1.0f / 128.0f) + RMS_EPS);
#pragma unroll
            for (int mb = 0; mb < 8; ++mb) { const int v0 = 16 * mb + 4 * g; const v2u gp = *(const v2u*)(pA2 + (row0 + tq) * LA2 + A2_CG + h * 128 + v0); const f32x4_t cn = *(const f32x4_t*)(cng + v0);
                const float g0 = blo(gp.x), g1 = bhi(gp.x), g2 = blo(gp.y), g3 = bhi(gp.y);
                const float y0 = oacc[mb][0] * rstd * cn[0] * g0 * fast_sig(g0), y1 = oacc[mb][1] * rstd * cn[1] * g1 * fast_sig(g1), y2 = oacc[mb][2] * rstd * cn[2] * g2 * fast_sig(g2), y3 = oacc[mb][3] * rstd * cn[3] * g3 * fast_sig(g3);
                v2u o; o.x = pk2(y0, y1); o.y = pk2(y2, y3); *(v2u*)(yc + (row0 + tq) * 512 + h * 128 + v0) = o; }
        }
    }
}
__device__ __forceinline__ void gla_scan_phase(bf16* KVT, const float* DEC) {
    const int tid = otid();
    if (tid < 256) for (int e = obid() * 256 + tid; e < 8 * 8192; e += gridDim.x * 256) { const int bh = e >> 13, vd = e & 8191, d = vd & 63;
        float St = 0.f; bf16* kp = KVT + (size_t)bh * 128 * 8192 + vd; const float* dp = DEC + (size_t)bh * 128 * 64 + d;
#pragma unroll 8
        for (int n = 0; n < 128; ++n) { const float kv = bf2f(kp[(size_t)n * 8192]), dc = dp[n * 64]; kp[(size_t)n * 8192] = (bf16)f2bf(St); St = dc * St + kv; } }
}
constexpr int NPH = 19;
constexpr int ARGS_OFF = MISC_OFF + 128;
struct CtxK {
    const Args& a;
    __device__ __forceinline__ const float* in(int i) const { return a.in[i]; }
    __device__ __forceinline__ float* out() const { return a.out; }
    __device__ __forceinline__ unsigned char* ws() const { return opaque_ptr(a.ws); }
};
__device__ __forceinline__ unsigned char* lds_ptr64(const LAS unsigned* p) {
    const unsigned lo = __builtin_amdgcn_readfirstlane(p[0]), hi = __builtin_amdgcn_readfirstlane(p[1]);
    return (unsigned char*)(GAS unsigned char*)(((unsigned long long)hi << 32) | lo);
}
struct CtxL {
    LAS unsigned char* lds;
    __device__ __forceinline__ const float* in(int i) const { return (const float*)lds_ptr64((const LAS unsigned*)(lds + ARGS_OFF) + 2 * i); }
    __device__ __forceinline__ float* out() const { return (float*)lds_ptr64((const LAS unsigned*)(lds + ARGS_OFF) + 48); }
    __device__ __forceinline__ unsigned char* ws() const { return lds_ptr64((const LAS unsigned*)(lds + ARGS_OFF) + 50); }
};
template <int K, class C> __device__ __forceinline__ void phase_body(const C& cx, int l, LAS unsigned char* lds) {
    unsigned char* wq_ = cx.ws(); bf16* W = (bf16*)(wq_ + WS_W); float* cs = (float*)(wq_ + WS_CS); bf16* XN = (bf16*)(wq_ + WS_XN); bf16* FB = (bf16*)(wq_ + WS_FB);
    unsigned short* SEL = (unsigned short*)(wq_ + WS_FB); bf16* REC = (bf16*)(wq_ + WS_FB + 8 * MiB); bf16* YB = (bf16*)(wq_ + WS_YB); bf16* YA = (bf16*)(wq_ + WS_YA); bf16* YC = (bf16*)(wq_ + WS_YC); bf16* BIG = (bf16*)(wq_ + WS_BIG);
    bf16* KVT = (bf16*)(wq_ + WS_FB + 16 * MiB); float* DEC = (float*)(wq_ + WS_DEC); (void)KVT; (void)DEC;
    (void)W; (void)cs; (void)XN; (void)FB; (void)SEL; (void)REC; (void)YB; (void)YA; (void)YC; (void)BIG;
    LAS float* scr = (LAS float*)lds; (void)scr;
    if constexpr (K == 0) { if (l == 0) { cs_phase((const int*)cx.in(I_POS), cs); resid_phase(cx.in(I_X), cx.out(), nullptr, 0.f, nullptr, cx.in(I_F1PRE) + l * D, XN);
                cvt_ffn(cx.in(I_F1WIN), cx.in(I_F1WOUT), W + WO_W1, W + WO_W2, scr); } }
    if constexpr (K == 1) { pg8::Gemm g{XN, W + WO_W1, T, 2 * DFF, D}; pg8::StaticOrder So; So.init(T, 2 * DFF, gridDim.x, obid()); pg8::EpiSwiglu E{BIG, DFF};
            pg8::gemm_phase<pg8::EpiSwiglu, pg8::StaticOrder, true, true>(lds, g, So, E); }
    if constexpr (K == 2) { pg8::Gemm g{BIG, W + WO_W2, T, D, DFF}; pg8::StaticOrder So; So.init(T, D, gridDim.x, obid()); pg8::EpiStore E{FB, D};
            pg8::gemm_phase<pg8::EpiStore, pg8::StaticOrder, true, true>(lds, g, So, E); }
    if constexpr (K == 3) { resid_phase(cx.out(), cx.out(), FB, 0.5f, cx.in(I_F1POST) + l * D, cx.in(I_MIXPRE) + l * D, XN); cvt_mixer(cx, l, W, scr); }
    if constexpr (K == 4) { pg8::Gemm g{XN, W + WO_BIG + (size_t)RB0 * D, T, NRB, D}; pg8::StaticOrder So; So.init(T, NRB, gridDim.x, obid());
            pg8::EpiProj<0> E{BIG, LPB, 1000, BIG, LPB, cs, nullptr};
            pg8::gemm_phase<pg8::EpiProj<0>, pg8::StaticOrder, true, true>(lds, g, So, E); }
    if constexpr (K == 5) { nv_attb_phase(BIG, YB, lds); }
    if constexpr (K == 6) { pg8::Gemm g{XN, W + WO_BIG + (size_t)RAC0 * D, T, NRAC, D}; pg8::StaticOrder So; So.init(T, NRAC, gridDim.x, obid());
            pg8::EpiProj<1> E{YA, 1024, 4, BIG, LA2, cs, nullptr};
            pg8::gemm_phase<pg8::EpiProj<1>, pg8::StaticOrder, true, true>(lds, g, So, E); }
    if constexpr (K == 7) { rec_phase(BIG, cx.in(I_AKVG) + l * 128, cs, REC); gla_chunk_phase<1>(BIG, cx.in(I_CBAL) + l * 256, nullptr, KVT, DEC, YC, lds); }
    if constexpr (K == 8) { gla_scan_phase(KVT, DEC); }
    if constexpr (K == 9) { gla_chunk_phase<3>(BIG, cx.in(I_CBAL) + l * 256, cx.in(I_CNORM) + l * 128, KVT, DEC, YC, lds); }
    if constexpr (K == 10) { nv_idx_phase(BIG, SEL, lds); }
    if constexpr (K == 11) { nv_atta_phase(BIG, YA, REC, SEL, lds); }
    if constexpr (K == 12) { pg8::Gemm g{XN, W + WO_BIG + (size_t)RG0 * D, T, NRG, D}; pg8::StaticOrder So; So.init(T, NRG, gridDim.x, obid());
            pg8::EpiProj<2> E{BIG, 3072, 1000, BIG, 3072, cs, cx.in(I_BGATE) + l * 3072};
            pg8::gemm_phase<pg8::EpiProj<2>, pg8::StaticOrder, true, true>(lds, g, So, E); }
    if constexpr (K == 13) { pg8::StaticOrder So; So.init(T, D, gridDim.x, obid());
            { pg8::Gemm g{YA, W + WO_MA, T, D, 1024}; pg8::EpiMerge<true> E{XN, D, BIG, 3072, 0}; pg8::gemm_phase<pg8::EpiMerge<true>, pg8::StaticOrder, true, true>(lds, g, So, E); }
            VM_WAIT(); __syncthreads();
            { pg8::Gemm g{YB, W + WO_MB, T, D, 256}; pg8::EpiMerge<false> E{XN, D, BIG, 3072, 1024}; pg8::gemm_phase<pg8::EpiMerge<false>, pg8::StaticOrder, true, true>(lds, g, So, E); }
            VM_WAIT(); __syncthreads();
            { pg8::Gemm g{YC, W + WO_MC, T, D, 512}; pg8::EpiMerge<false> E{XN, D, BIG, 3072, 2048}; pg8::gemm_phase<pg8::EpiMerge<false>, pg8::StaticOrder, true, true>(lds, g, So, E); } }
    if constexpr (K == 14) { pg8::Gemm g{XN, W + WO_WO, T, D, D}; pg8::StaticOrder So; So.init(T, D, gridDim.x, obid()); pg8::EpiStore E{FB, D};
            pg8::gemm_phase<pg8::EpiStore, pg8::StaticOrder, true, true>(lds, g, So, E); }
    if constexpr (K == 15) { resid_phase(cx.out(), cx.out(), FB, 1.0f, cx.in(I_MIXPOST) + l * D, cx.in(I_F2PRE) + l * D, XN);
            cvt_ffn(cx.in(I_F2WIN) + (size_t)l * D * 2 * DFF, cx.in(I_F2WOUT) + (size_t)l * DFF * D, W + WO_W1, W + WO_W2, scr); }
    if constexpr (K == 16) { pg8::Gemm g{XN, W + WO_W1, T, 2 * DFF, D}; pg8::StaticOrder So; So.init(T, 2 * DFF, gridDim.x, obid()); pg8::EpiSwiglu E{BIG, DFF};
            pg8::gemm_phase<pg8::EpiSwiglu, pg8::StaticOrder, true, true>(lds, g, So, E); }
    if constexpr (K == 17) { pg8::Gemm g{BIG, W + WO_W2, T, D, DFF}; pg8::StaticOrder So; So.init(T, D, gridDim.x, obid()); pg8::EpiStore E{FB, D};
            pg8::gemm_phase<pg8::EpiStore, pg8::StaticOrder, true, true>(lds, g, So, E); }
    if constexpr (K == 18) { if (l + 1 < DEPTH) { resid_phase(cx.out(), cx.out(), FB, 0.5f, cx.in(I_F2POST) + l * D, cx.in(I_F1PRE) + (l + 1) * D, XN);
                cvt_ffn(cx.in(I_F1WIN) + (size_t)(l + 1) * D * 2 * DFF, cx.in(I_F1WOUT) + (size_t)(l + 1) * DFF * D, W + WO_W1, W + WO_W2, scr); }
            else resid_phase(cx.out(), cx.out(), FB, 0.5f, cx.in(I_F2POST) + l * D, nullptr, nullptr); }
}

__device__ __forceinline__ void zero_lds_ctl(LAS unsigned char* lds) {
    for (int u = threadIdx.x; u < (LDS_BYTES - RING_BYTES) / 4; u += NTHR) ((LAS unsigned*)(lds + RING_BYTES))[u] = 0u;
    __syncthreads();
}
template <int K> __global__ void __launch_bounds__(NTHR, 2) mk_fwd(Args args) {
    extern __shared__ __attribute__((aligned(16))) unsigned char lds_raw[];
    LAS unsigned char* lds = (LAS unsigned char*)lds_raw;
    zero_lds_ctl(lds);
    CtxK cx{args};
    phase_body<K, CtxK>(cx, args.l, lds);
}
#if MK_ONE_LAUNCH
#if MK_ONE_LAUNCH == 2
#define phase_call_inl(K, l) do { extern __shared__ __attribute__((aligned(16))) unsigned char lds_raw2[]; CtxK cxk{args}; phase_body<K, CtxK>(cxk, l, (LAS unsigned char*)lds_raw2); } while (0)
template <int K> __device__ __forceinline__ void phase_call(int l) {
#else
template <int K> __device__ __attribute__((noinline)) void phase_call(int l) {
#endif
    extern __shared__ __attribute__((aligned(16))) unsigned char lds_raw[];
    LAS unsigned char* lds = (LAS unsigned char*)lds_raw;
    l = __builtin_amdgcn_readfirstlane(l);
    CtxL cx{lds};
    phase_body<K, CtxL>(cx, l, lds);
}
__global__ void __launch_bounds__(NTHR, 2) mk_one(Args args) {
    extern __shared__ __attribute__((aligned(16))) unsigned char lds_raw[];
    LAS unsigned char* lds = (LAS unsigned char*)lds_raw;
    zero_lds_ctl(lds);
#if MK_ONE_LAUNCH == 1
    if (threadIdx.x == 0) { LAS unsigned long long* la = (LAS unsigned long long*)(lds + ARGS_OFF);
#pragma unroll
        for (int i = 0; i < 24; ++i) la[i] = (unsigned long long)args.in[i];
        la[24] = (unsigned long long)args.out; la[25] = (unsigned long long)args.ws; }
    __syncthreads();
#endif
    volatile LAS unsigned* MISC = (volatile LAS unsigned*)(lds + MISC_OFF);
    unsigned* ctl = (unsigned*)((unsigned char*)(GAS unsigned char*)args.ws + WS_CTL);
    XcdBarrier bar = xcd_barrier_post(ctl + CW_BAR, MISC + 8);
#ifndef MK_PHMASK
#define MK_PHMASK 0x7ffff
#endif
#if MK_ONE_LAUNCH == 2
#define PH(K) do { if ((MK_PHMASK >> K) & 1) { phase_call_inl(K, l); xcd_barrier(bar); } } while (0)
#else
#define PH(K) do { if ((MK_PHMASK >> K) & 1) { phase_call<K>(l); xcd_barrier(bar); } } while (0)
#endif
    { const int l = 0; PH(0); }
#pragma unroll 1
    for (int l = 0; l < DEPTH; ++l) {
        PH(1); PH(2); PH(3); PH(4); PH(5); PH(6); PH(7); PH(8); PH(9); PH(10); PH(11); PH(12); PH(13); PH(14); PH(15); PH(16); PH(17);
#if MK_ONE_LAUNCH == 2
        phase_call_inl(18, l);
#else
        phase_call<18>(l);
#endif
        if (l + 1 < DEPTH) xcd_barrier(bar);
    }
#undef PH
}
#endif

#define MK_PHASES(X) X(0) X(1) X(2) X(3) X(4) X(5) X(6) X(7) X(8) X(9) X(10) X(11) X(12) X(13) X(14) X(15) X(16) X(17) X(18)
#if !MK_ONE_LAUNCH
static void launch_phase(int k, int grid, hipStream_t stream, const Args& a) {
    switch (k) {
#define X(K) case K: hipLaunchKernelGGL(mk_fwd<K>, dim3(grid), dim3(NTHR), LDS_BYTES, stream, a); break;
        MK_PHASES(X)
#undef X
        default: break;
    }
}
#endif
static bool set_lds_attr() {
    bool ok = true;
#if MK_ONE_LAUNCH
    ok = ok && (hipFuncSetAttribute((const void*)mk_one, hipFuncAttributeMaxDynamicSharedMemorySize, LDS_BYTES) == hipSuccess);
#else
#define X(K) ok = ok && (hipFuncSetAttribute((const void*)mk_fwd<K>, hipFuncAttributeMaxDynamicSharedMemorySize, LDS_BYTES) == hipSuccess);
    MK_PHASES(X)
#undef X
#endif
    return ok;
}
extern "C" void kernel_launch(void* const* d_in, const int* in_sizes, int n_in, void* d_out, int out_size, void* d_ws, size_t ws_size, hipStream_t stream) {
    static int grid = 0;
    if (grid == 0) {
        if (n_in != 24 || out_size != T * D || ws_size < WS_END) { fprintf(stderr, "kernel_launch: unexpected shapes (n_in %d out %d ws %zu)\n", n_in, out_size, ws_size); grid = -1; return; }
        int dev = 0, cus = 0;
        if (hipGetDevice(&dev) != hipSuccess || hipDeviceGetAttribute(&cus, hipDeviceAttributeMultiprocessorCount, dev) != hipSuccess) { grid = -1; return; }
        if (!set_lds_attr()) { fprintf(stderr, "kernel_launch: hipFuncSetAttribute failed\n"); grid = -1; return; }
        int per_cu = 0;
#if MK_ONE_LAUNCH
        if (hipOccupancyMaxActiveBlocksPerMultiprocessor(&per_cu, (const void*)mk_one, NTHR, LDS_BYTES) != hipSuccess || per_cu < 1) { fprintf(stderr, "kernel_launch: occupancy query reports %d\n", per_cu); grid = -1; return; }
#endif
        (void)hipGetLastError();
        grid = cus;
    }
    if (grid < 0) return;
    (void)hipMemsetAsync((char*)d_ws + WS_CTL, 0, CTL_ZERO_BYTES, stream);
    Args a{};
    for (int i = 0; i < 24; ++i) a.in[i] = (const float*)d_in[i];
    a.out = (float*)d_out; a.ws = (unsigned char*)d_ws;
#if MK_ONE_LAUNCH
    hipLaunchKernelGGL(mk_one, dim3(grid), dim3(NTHR), LDS_BYTES, stream, a);
#else
    for (int p = 0; p < DEPTH * NPH; ++p) {
        const int k = p % NPH, l = p / NPH;
        if (k == 0 && l > 0) continue;
        a.l = l;
        launch_phase(k, grid, stream, a);
    }
#endif
}
```

```cpp
#define MK_ONE_LAUNCH 2
#include <hip/hip_runtime.h>
#include <cstdio>
#include <cstdint>
#define GAS __attribute__((address_space(1)))
#define LAS __attribute__((address_space(3)))
#ifndef MK_ONE_LAUNCH
#define MK_ONE_LAUNCH 0
#endif
namespace pg8 {
#define PG8_LAS __attribute__((address_space(3)))
typedef unsigned short bf16_t;
typedef short bf16x8 __attribute__((ext_vector_type(8)));
typedef float f32x4 __attribute__((ext_vector_type(4)));
typedef unsigned u32x4 __attribute__((ext_vector_type(4)));
constexpr int BM = 256, BK = 64, HALF = 128, HTB = HALF * BK * 2  , STAGE_BYTES = 8 * HTB, NXCD = 8, WGM = 8;

__host__ __device__ __forceinline__ int lds_byte(int r, int c) { const int st = (r >> 4) * 2 + (c >> 5), rr = r & 15, cc = c & 31, ob = rr * 64 + cc * 2; return st * 1024 + (ob ^ (((ob >> 9) & 1) << 5)); }
__host__ __device__ __forceinline__ void stage_rc(int b, int& R, int& C) { const int st = b / 1024, sb = b % 1024, swz = sb ^ (((sb >> 9) & 1) << 5); R = (st >> 1) * 16 + swz / 64; C = (st & 1) * 32 + (swz % 64) / 2; }
__host__ __device__ __forceinline__ int perm32(int rho) { const int n = rho >> 4, i = rho & 15; return 8 * (i >> 2) + 4 * n + (i & 3); }

struct Unit { int pm, pn; };
struct Gemm { const bf16_t* A; const bf16_t* Bt; int M, N, K; };

struct StaticOrder {
    int nM, nN, nwg, G, c;
    __host__ __device__ void init(int M, int N, int G_, int c_) { nM = M / BM; nN = N / BM; nwg = nM * nN; G = G_; c = c_; }
    __host__ __device__ bool next(int i, Unit& u) const {
        const long L = (long)i * G + c; if (L >= nwg) return false;
        int wgid = (int)L; { const int q = nwg / NXCD, r = nwg % NXCD, xcd = wgid % NXCD, off = wgid / NXCD; wgid = (xcd < r ? xcd * (q + 1) : r * (q + 1) + (xcd - r) * q) + off; }
        const int nig = WGM * nN, gid = wgid / nig, fm = gid * WGM, gsz = (nM - fm) < WGM ? (nM - fm) : WGM;
        u.pm = fm + ((wgid % nig) % gsz); u.pn = (wgid % nig) / gsz; return true;
    }
    __device__ __forceinline__ void a_ready(const Unit&) const {}
    __device__ __forceinline__ void done(const Unit&) const {}
};

typedef float f32x2_t_ __attribute__((ext_vector_type(2))); typedef __bf16 bf16x2_t_ __attribute__((ext_vector_type(2)));
__device__ __forceinline__ unsigned cvt_pk_bf16(float lo, float hi) { const f32x2_t_ v = {lo, hi}; const bf16x2_t_ b = __builtin_convertvector(v, bf16x2_t_); return __builtin_bit_cast(unsigned, b); }
typedef float f32x2 __attribute__((ext_vector_type(2)));
__device__ __forceinline__ float bflo(unsigned w) { return __uint_as_float(w << 16); }
__device__ __forceinline__ float bfhi(unsigned w) { return __uint_as_float(w & 0xffff0000u); }
__device__ __forceinline__ u32x4 pack8(const f32x4 a, const f32x4 b) { u32x4 w; w.x = cvt_pk_bf16(a[0], a[1]); w.y = cvt_pk_bf16(a[2], a[3]); w.z = cvt_pk_bf16(b[0], b[1]); w.w = cvt_pk_bf16(b[2], b[3]); return w; }
__device__ __forceinline__ float fast_sigmoid(float x) { return __builtin_amdgcn_rcpf(1.0f + __expf(-x)); }

struct EpiSwiglu {
    static constexpr bool PERM = true, AFTER_DRAIN = false;
    bf16_t* O; int ldc;
    __device__ __forceinline__ void operator()(const f32x4 (&acc)[2][2][4][2], const Unit& u, int wr, int wc, int fr, int fq) const {
        const int row0 = u.pm * BM + wr * 64 + fr, col0 = u.pn * HALF + wc * 32 + 8 * fq;
#pragma unroll
        for (int ai = 0; ai < 2; ++ai)
#pragma unroll
            for (int m = 0; m < 4; ++m) { bf16_t* rowp = O + (size_t)(row0 + ai * HALF + m * 16) * ldc + col0;
                f32x4 o0, o1;
#pragma unroll
                for (int j = 0; j < 4; ++j) { const float g0 = acc[ai][0][m][0][j], g1 = acc[ai][0][m][1][j];
                    o0[j] = g0 * fast_sigmoid(g0) * acc[ai][1][m][0][j]; o1[j] = g1 * fast_sigmoid(g1) * acc[ai][1][m][1][j]; }
                *(u32x4*)rowp = pack8(o0, o1); asm volatile("" ::: "memory"); }
    }
};
struct EpiStore {
    static constexpr bool PERM = true, AFTER_DRAIN = false;
    bf16_t* O; int ldc;
    __device__ __forceinline__ void operator()(const f32x4 (&acc)[2][2][4][2], const Unit& u, int wr, int wc, int fr, int fq) const {
        const int row0 = u.pm * BM + wr * 64 + fr, col0 = u.pn * BM + wc * 32 + 8 * fq;
#pragma unroll
        for (int ai = 0; ai < 2; ++ai)
#pragma unroll
            for (int m = 0; m < 4; ++m) { bf16_t* rowp = O + (size_t)(row0 + ai * HALF + m * 16) * ldc + col0;
#pragma unroll
                for (int bj = 0; bj < 2; ++bj) *(u32x4*)(rowp + bj * HALF) = pack8(acc[ai][bj][m][0], acc[ai][bj][m][1]); }
    }
};
enum { PM_PLAIN = 0, PM_ROPE64 = 1, PM_ROPE16 = 2, PM_SIGMOID = 3 };
template <int RANGE> __device__ __forceinline__ int proj_mode(int gcol) {
    if (RANGE == 0) return gcol < 1536 ? PM_ROPE64 : PM_PLAIN;
    if (RANGE == 1) { if (gcol < 1024) return PM_PLAIN; const int g2 = gcol - 1024;
        return g2 < 128 ? PM_ROPE16 : (g2 < 704 ? PM_ROPE64 : PM_PLAIN); }
    return PM_SIGMOID;
}
template <int RANGE> struct EpiProj {
    static constexpr bool PERM = true, AFTER_DRAIN = false;
    bf16_t* d0; int ld0; int nt0; bf16_t* d1; int ld1; const float* cs; const float* bias;
    __device__ __forceinline__ void operator()(const f32x4 (&acc)[2][2][4][2], const Unit& u, int wr, int wc, int fr, int fq) const {
        const int row0 = u.pm * BM + wr * 64 + fr;
        bf16_t* dbase; int ld;
        if (u.pn < nt0) { dbase = d0 + u.pn * BM; ld = ld0; } else { dbase = d1 + (u.pn - nt0) * BM; ld = ld1; }
#pragma unroll
        for (int bj = 0; bj < 2; ++bj) {
            const int gcol = u.pn * BM + bj * HALF + wc * 32;
            const int mode = proj_mode<RANGE>(gcol);
            const bool rope = (mode == PM_ROPE16) || (mode == PM_ROPE64 && (wc & 1) == 0);
            const bool lane_rope = (mode == PM_ROPE16) || (fq < 2);
            f32x4 b0 = (f32x4){0.f, 0.f, 0.f, 0.f}, b1 = b0;
#ifndef MK_NOBIAS
            if (mode == PM_SIGMOID) { b0 = *(const f32x4*)(bias + gcol + 8 * fq); b1 = *(const f32x4*)(bias + gcol + 8 * fq + 4); }
#endif
#pragma unroll
            for (int ai = 0; ai < 2; ++ai)
#pragma unroll
                for (int m = 0; m < 4; ++m) {
                    const int r = row0 + ai * HALF + m * 16;
                    f32x4 v0 = acc[ai][bj][m][0], v1 = acc[ai][bj][m][1];
                    if (rope) {
                        const float sg = (fq & 1) ? 1.0f : -1.0f;
                        { const f32x4 c0 = *(const f32x4*)(cs + (size_t)r * 16), s0 = *(const f32x4*)(cs + (size_t)r * 16 + 8); f32x4 p0;
#pragma unroll
                          for (int j = 0; j < 4; ++j) p0[j] = __shfl_xor(v0[j], 16);
                          if (lane_rope) v0 = v0 * c0 + sg * (p0 * s0); }
                        asm volatile("" ::: "memory");
                        { const f32x4 c1 = *(const f32x4*)(cs + (size_t)r * 16 + 4), s1 = *(const f32x4*)(cs + (size_t)r * 16 + 12); f32x4 p1;
#pragma unroll
                          for (int j = 0; j < 4; ++j) p1[j] = __shfl_xor(v1[j], 16);
                          if (lane_rope) v1 = v1 * c1 + sg * (p1 * s1); }
                    }
                    if (mode == PM_SIGMOID) {
#pragma unroll
                        for (int j = 0; j < 4; ++j) { v0[j] = fast_sigmoid(v0[j] + b0[j]); v1[j] = fast_sigmoid(v1[j] + b1[j]); }
                    }
                    *(u32x4*)(dbase + (size_t)r * ld + bj * HALF + wc * 32 + 8 * fq) = pack8(v0, v1);
                    asm volatile("" ::: "memory");
                }
        }
    }
};
template <bool FIRST> struct EpiMerge {
    static constexpr bool PERM = true, AFTER_DRAIN = false;
    bf16_t* O; int ldc; const bf16_t* G; int ldg; int gcol;
    __device__ __forceinline__ void operator()(const f32x4 (&acc)[2][2][4][2], const Unit& u, int wr, int wc, int fr, int fq) const {
        const int row0 = u.pm * BM + wr * 64 + fr, col0 = u.pn * BM + wc * 32 + 8 * fq;
#pragma unroll
        for (int ai = 0; ai < 2; ++ai)
#pragma unroll
            for (int m = 0; m < 4; ++m) { const int r = row0 + ai * HALF + m * 16;
#pragma unroll
                for (int bj = 0; bj < 2; ++bj) {
                    const u32x4 g = *(const u32x4*)(G + (size_t)r * ldg + gcol + col0 + bj * HALF);
                    f32x4 o0, o1;
                    o0[0] = bflo(g.x) * acc[ai][bj][m][0][0]; o0[1] = bfhi(g.x) * acc[ai][bj][m][0][1]; o0[2] = bflo(g.y) * acc[ai][bj][m][0][2]; o0[3] = bfhi(g.y) * acc[ai][bj][m][0][3];
                    o1[0] = bflo(g.z) * acc[ai][bj][m][1][0]; o1[1] = bfhi(g.z) * acc[ai][bj][m][1][1]; o1[2] = bflo(g.w) * acc[ai][bj][m][1][2]; o1[3] = bfhi(g.w) * acc[ai][bj][m][1][3];
                    bf16_t* op = O + (size_t)r * ldc + col0 + bj * HALF;
                    if (!FIRST) { const u32x4 p = *(const u32x4*)op;
                        o0[0] += bflo(p.x); o0[1] += bfhi(p.x); o0[2] += bflo(p.y); o0[3] += bfhi(p.y); o1[0] += bflo(p.z); o1[1] += bfhi(p.z); o1[2] += bflo(p.w); o1[3] += bfhi(p.w); }
                    *(u32x4*)op = pack8(o0, o1); asm volatile("" ::: "memory"); } }
    }
};

template <class Epi, class Sched, bool ALIGN_EPI = false, bool SP2 = false>
__device__ __forceinline__ void gemm_phase(PG8_LAS unsigned char* lds, const Gemm g, const Sched& S, const Epi& E) {
    int tid_o = threadIdx.x; asm volatile("" : "+v"(tid_o));
    const int tid = tid_o, wid = __builtin_amdgcn_readfirstlane(tid >> 6), lane = tid & 63, wr = wid >> 2, wc = wid & 3, fr = lane & 15, fq = lane >> 4;
    const int K = g.K, nt = K / BK;
    unsigned voffA[2], voffB[2];
#pragma unroll
    for (int i = 0; i < 2; ++i) { int R, C; stage_rc(tid * 16 + i * 8192, R, C); const int Rb = Epi::PERM ? ((R & ~31) + perm32(R & 31)) : R;
        voffA[i] = (unsigned)(R * K + C) * 2u; voffB[i] = (unsigned)(Rb * K + C) * 2u; }
    const size_t kstep = (size_t)(BK * 2);
    const size_t hstep = (size_t)HALF * K * 2;
    const size_t tstep = 2 * hstep;
    const unsigned ldsw = (unsigned)wid * 1024u;
    const int aoff = lds_byte(wr * 64 + fr, fq * 8), boff = lds_byte(wc * 32 + fr, fq * 8);
#define PG8_SA(b, h) (((b) * 2 + (h)) * HTB)
#define PG8_SB(b, h) ((4 + (b) * 2 + (h)) * HTB)
#define PG8_STAGE(bufoff, gbase, voff) do { _Pragma("unroll") for (int _i = 0; _i < 2; ++_i) \
        __builtin_amdgcn_global_load_lds((const unsigned*)((const char*)(gbase) + (voff)[_i]), (PG8_LAS unsigned*)(lds + (bufoff) + ldsw + _i * 8192), 16, 0, 0); } while (0)
#define PG8_LDA(dst, b, h) do { _Pragma("unroll") for (int m = 0; m < 4; ++m) _Pragma("unroll") for (int k = 0; k < 2; ++k) dst[m][k] = *(const PG8_LAS bf16x8*)(lds + PG8_SA(b, h) + aoff + m * 2048 + k * 1024); } while (0)
#define PG8_LDB(dst, b, h) do { _Pragma("unroll") for (int n = 0; n < 2; ++n) _Pragma("unroll") for (int k = 0; k < 2; ++k) dst[n][k] = *(const PG8_LAS bf16x8*)(lds + PG8_SB(b, h) + boff + n * 2048 + k * 1024); } while (0)
#define PG8_MMA(ai, bj, At, Bt) do { __builtin_amdgcn_s_setprio(1); _Pragma("unroll") for (int m = 0; m < 4; ++m) _Pragma("unroll") for (int n = 0; n < 2; ++n) _Pragma("unroll") for (int k = 0; k < 2; ++k) \
        acc[ai][bj][m][n] = __builtin_amdgcn_mfma_f32_16x16x32_bf16(Bt[n][k], At[m][k], acc[ai][bj][m][n], 0, 0, 0); __builtin_amdgcn_s_setprio(0); } while (0)
#define PG8_WAIT_V(n) asm volatile("s_waitcnt vmcnt(" #n ")" ::: "memory")
#define PG8_WAIT_L(n) asm volatile("s_waitcnt lgkmcnt(" #n ")" ::: "memory")
#define PG8_BAR __builtin_amdgcn_s_barrier()
#define PG8_SCHED __builtin_amdgcn_sched_barrier(0)
    Unit cur, nxt; int ui = 0;
    if (!S.next(0, cur)) return;
    f32x4 acc[2][2][4][2];
#pragma unroll
    for (int a = 0; a < 2; ++a)
#pragma unroll
        for (int b = 0; b < 2; ++b)
#pragma unroll
            for (int m = 0; m < 4; ++m)
#pragma unroll
                for (int n = 0; n < 2; ++n) acc[a][b][m][n] = (f32x4){0.f, 0.f, 0.f, 0.f};
    bf16x8 At[4][2], B0[2][2], B1[2][2];
    const char* cA = (const char*)g.A + (size_t)cur.pm * tstep; const char* cB = (const char*)g.Bt + (size_t)cur.pn * tstep;
    S.a_ready(cur);
    if constexpr (SP2) {
        PG8_STAGE(PG8_SB(0, 0), cB, voffB); PG8_STAGE(PG8_SB(0, 1), cB + hstep, voffB); PG8_STAGE(PG8_SA(0, 0), cA, voffA); PG8_STAGE(PG8_SA(0, 1), cA + hstep, voffA);
        if (wr == 1) PG8_BAR;
        PG8_WAIT_V(2); PG8_BAR;
        PG8_STAGE(PG8_SB(1, 0), cB + kstep, voffB); PG8_STAGE(PG8_SA(1, 0), cA + kstep, voffA); PG8_STAGE(PG8_SB(1, 1), cB + hstep + kstep, voffB);
        PG8_WAIT_V(6); PG8_BAR;
    } else {
        PG8_STAGE(PG8_SB(0, 0), cB, voffB); PG8_STAGE(PG8_SA(0, 0), cA, voffA); PG8_STAGE(PG8_SB(0, 1), cB + hstep, voffB); PG8_STAGE(PG8_SA(0, 1), cA + hstep, voffA);
        if (wr == 1) PG8_BAR;
        PG8_WAIT_V(4); PG8_BAR;
        PG8_STAGE(PG8_SB(1, 0), cB + kstep, voffB); PG8_STAGE(PG8_SA(1, 0), cA + kstep, voffA); PG8_STAGE(PG8_SB(1, 1), cB + hstep + kstep, voffB);
        PG8_WAIT_V(6); PG8_BAR;
    }
    for (;;) {
        const bool has_next = S.next(ui + 1, nxt);
        const char* nA = has_next ? (const char*)g.A + (size_t)nxt.pm * tstep : cA; const char* nB = has_next ? (const char*)g.Bt + (size_t)nxt.pn * tstep : cB;
        for (int t = 0; t < nt; t += 2) {
            const bool last = (t == nt - 2);
            const char* a1 = cA + (size_t)(t + 1) * kstep;
            const char* a2 = last ? nA : cA + (size_t)(t + 2) * kstep; const char* b2 = last ? nB : cB + (size_t)(t + 2) * kstep;
            const char* a3 = a2 + kstep; const char* b3 = b2 + kstep;
            if (last && has_next) S.a_ready(nxt);
            if constexpr (SP2) {
            PG8_LDB(B0, 0, 0); PG8_LDB(B1, 0, 1); PG8_SCHED; PG8_LDA(At, 0, 0); PG8_STAGE(PG8_SA(1, 1), a1 + hstep, voffA);
            PG8_WAIT_V(8); PG8_WAIT_L(0); PG8_BAR; PG8_MMA(0, 0, At, B0); PG8_MMA(0, 1, At, B1); PG8_BAR; PG8_SCHED;
            PG8_LDA(At, 0, 1); PG8_STAGE(PG8_SB(0, 0), b2, voffB); PG8_STAGE(PG8_SB(0, 1), b2 + hstep, voffB); PG8_STAGE(PG8_SA(0, 0), a2, voffA);
            PG8_WAIT_V(8); PG8_WAIT_L(0); PG8_BAR; PG8_MMA(1, 0, At, B0); PG8_MMA(1, 1, At, B1); PG8_BAR; PG8_SCHED;
            PG8_LDB(B0, 1, 0); PG8_LDB(B1, 1, 1); PG8_SCHED; PG8_LDA(At, 1, 0); PG8_STAGE(PG8_SA(0, 1), a2 + hstep, voffA);
            PG8_WAIT_V(8); PG8_WAIT_L(0); PG8_BAR; PG8_MMA(0, 0, At, B0); PG8_MMA(0, 1, At, B1); PG8_BAR; PG8_SCHED;
            PG8_LDA(At, 1, 1); PG8_STAGE(PG8_SB(1, 0), b3, voffB); PG8_STAGE(PG8_SB(1, 1), b3 + hstep, voffB); PG8_STAGE(PG8_SA(1, 0), a3, voffA);
            PG8_WAIT_V(8); PG8_WAIT_L(0); PG8_BAR; PG8_MMA(1, 0, At, B0); PG8_MMA(1, 1, At, B1); PG8_BAR; PG8_SCHED;
            } else {
            PG8_LDB(B0, 0, 0); PG8_SCHED; PG8_LDA(At, 0, 0); PG8_STAGE(PG8_SA(1, 1), a1 + hstep, voffA);
            PG8_WAIT_L(8); PG8_BAR; PG8_WAIT_L(0); PG8_MMA(0, 0, At, B0); PG8_BAR; PG8_SCHED;
            PG8_LDB(B1, 0, 1); PG8_STAGE(PG8_SB(0, 0), b2, voffB);
            PG8_BAR; PG8_WAIT_L(0); PG8_MMA(0, 1, At, B1); PG8_BAR;
            PG8_LDA(At, 0, 1); PG8_STAGE(PG8_SA(0, 0), a2, voffA);
            PG8_BAR; PG8_WAIT_L(0); PG8_MMA(1, 0, At, B0); PG8_BAR; PG8_SCHED;
            PG8_STAGE(PG8_SB(0, 1), b2 + hstep, voffB);
            PG8_WAIT_V(6); PG8_BAR; PG8_MMA(1, 1, At, B1); PG8_BAR;
            PG8_LDB(B0, 1, 0); PG8_SCHED; PG8_LDA(At, 1, 0); PG8_STAGE(PG8_SA(0, 1), a2 + hstep, voffA);
            PG8_WAIT_L(8); PG8_BAR; PG8_WAIT_L(0); PG8_MMA(0, 0, At, B0); PG8_BAR; PG8_SCHED;
            PG8_LDB(B1, 1, 1); PG8_STAGE(PG8_SB(1, 0), b3, voffB);
            PG8_BAR; PG8_WAIT_L(0); PG8_MMA(0, 1, At, B1); PG8_BAR;
            PG8_LDA(At, 1, 1); PG8_STAGE(PG8_SA(1, 0), a3, voffA);
            PG8_BAR; PG8_WAIT_L(0); PG8_MMA(1, 0, At, B0); PG8_BAR; PG8_SCHED;
            PG8_STAGE(PG8_SB(1, 1), b3 + hstep, voffB);
            PG8_WAIT_V(6); PG8_BAR; PG8_MMA(1, 1, At, B1); PG8_BAR;
            }
        }
        if constexpr (ALIGN_EPI) { if (wr == 0) PG8_BAR; }
        if constexpr (!Epi::AFTER_DRAIN) { E(acc, cur, wr, wc, fr, fq); S.done(cur); }
        if (!has_next) break;
#pragma unroll
        for (int a = 0; a < 2; ++a)
#pragma unroll
            for (int b = 0; b < 2; ++b)
#pragma unroll
                for (int m = 0; m < 4; ++m)
#pragma unroll
                    for (int n = 0; n < 2; ++n) acc[a][b][m][n] = (f32x4){0.f, 0.f, 0.f, 0.f};
        cur = nxt; cA = nA; cB = nB; ++ui;
        if constexpr (ALIGN_EPI) { if (wr == 1) PG8_BAR; }
    }
    PG8_WAIT_V(0);
    if constexpr (!ALIGN_EPI) { if (wr == 0) PG8_BAR; }
    PG8_BAR;
    if constexpr (Epi::AFTER_DRAIN) { E.fused(acc, cur, wr, wc, fr, fq, lds, wid, lane); S.done(cur); }
#undef PG8_SA
#undef PG8_SB
#undef PG8_STAGE
#undef PG8_LDA
#undef PG8_LDB
#undef PG8_MMA
#undef PG8_WAIT_V
#undef PG8_WAIT_L
#undef PG8_BAR
#undef PG8_SCHED
}
}
#define XB_TMO      128
#define XB_XCNT(j)  (256  + 64 * (j))
#define XB_XSUB(j)  (1280 + 64 * (j))
#define XB_XGEN(j)  (2304 + 64 * (j))
#define XB_TOP      3328
#define XB_TOPGEN   3392
#define XCD_BAR_WORDS 3456
#define XB_SPIN_CAP (1u << 18)

__device__ __forceinline__ unsigned xb_ld(unsigned* p)              { return __hip_atomic_load(p, __ATOMIC_RELAXED, __HIP_MEMORY_SCOPE_AGENT); }
__device__ __forceinline__ unsigned xb_add(unsigned* p, unsigned v) { return __hip_atomic_fetch_add(p, v, __ATOMIC_RELAXED, __HIP_MEMORY_SCOPE_AGENT); }
__device__ __forceinline__ unsigned xb_xcc_id() { return (unsigned)__builtin_amdgcn_s_getreg((3 << 11) | 20) & 0xFu; }
#define XB_SPIN(cond, bar) do { unsigned _sp = 0; while (cond) { __builtin_amdgcn_s_sleep(1); \
    if ((++_sp & 255u) == 0u) { if (xb_ld(&(bar)[XB_TMO])) break; if (_sp > XB_SPIN_CAP) { atomicAdd(&(bar)[XB_TMO], 1u); break; } } } } while (0)

struct XcdBarrier {
    unsigned* bar; unsigned x;
    volatile LAS unsigned* st;
};

__device__ __forceinline__ XcdBarrier xcd_barrier_post(unsigned* bar, volatile LAS unsigned* st) {
    XcdBarrier b; b.bar = bar; b.x = xb_xcc_id(); b.st = st;
    if (threadIdx.x == 0) (void)xb_add(&bar[XB_XCNT(b.x)], 1u);
    return b;
}
__device__ __forceinline__ void xcd_barrier_complete(unsigned* bar, unsigned x, unsigned& nloc, unsigned& nx) {
    const unsigned G = gridDim.x * gridDim.y * gridDim.z;
    unsigned sum, cnt, mine, sp = 0u;
    for (;;) {
        sum = 0u; cnt = 0u; mine = 0u;
#pragma unroll
        for (unsigned j = 0; j < 16; ++j) { const unsigned c = xb_ld(&bar[XB_XCNT(j)]); sum += c; cnt += (c > 0u) ? 1u : 0u; mine = (j == x) ? c : mine; }
        if (sum == G) break;
        __builtin_amdgcn_s_sleep(1);
        if ((++sp & 255u) == 0u) { if (xb_ld(&bar[XB_TMO])) break; if (sp > XB_SPIN_CAP) { atomicAdd(&bar[XB_TMO], 1u); break; } }
    }
    nloc = mine > 0u ? mine : 1u; nx = cnt > 0u ? cnt : 1u;
}

__device__ __forceinline__ void xcd_barrier(const XcdBarrier& b) {
    asm volatile("s_waitcnt vmcnt(0)" ::: "memory");
    __syncthreads();
    if (threadIdx.x == 0) {
        unsigned* bar = b.bar;
        __builtin_amdgcn_s_waitcnt(0);
        unsigned nloc = b.st[0], nx = b.st[1];
        if (nloc == 0u) { xcd_barrier_complete(bar, b.x, nloc, nx); b.st[0] = nloc; b.st[1] = nx; }
        const unsigned old = xb_add(&bar[XB_XSUB(b.x)], 1u);
        const unsigned gen = old / nloc;
        if (old + 1u == (gen + 1u) * nloc) {
            __builtin_amdgcn_fence(__ATOMIC_RELEASE, "agent");
            asm volatile("s_waitcnt vmcnt(0)" ::: "memory");
            const unsigned og = xb_add(&bar[XB_TOP], 1u);
            const unsigned tg = og / nx;
            if (og + 1u == (tg + 1u) * nx) xb_add(&bar[XB_TOPGEN], 1u);
            else XB_SPIN(xb_ld(&bar[XB_TOPGEN]) == tg, bar);
            __builtin_amdgcn_fence(__ATOMIC_ACQUIRE, "agent");
            xb_add(&bar[XB_XGEN(b.x)], 1u);
            asm volatile("s_waitcnt vmcnt(0)" ::: "memory");
        } else {
            XB_SPIN(xb_ld(&bar[XB_XGEN(b.x)]) == gen, bar);
            __builtin_amdgcn_fence(__ATOMIC_ACQUIRE, "agent");
            asm volatile("s_waitcnt vmcnt(0)" ::: "memory");
        }
    }
    __syncthreads();
}
typedef unsigned short bf16;
typedef unsigned v4u __attribute__((ext_vector_type(4)));
typedef unsigned v2u __attribute__((ext_vector_type(2)));
typedef float f32x4 __attribute__((ext_vector_type(4)));
typedef short bf16x8 __attribute__((ext_vector_type(8)));
constexpr int NB = 2, S = 8192, T = NB * S, D = 1024, DEPTH = 2, DFF = 2816, DIN = 5080;
constexpr int NWAVES = 8, NTHR = 512;
constexpr float RMS_EPS = 1e-6f;
constexpr int WI_AQ = 0, WI_CKV = 512, WI_IQ = 640, WI_IK = 1152, WI_IW = 1216, WI_BQKV = 1224, WI_CQ = 3528, WI_CK = 3784, WI_CV = 4040, WI_CG = 4552, WI_CA = 5064;
constexpr int NBIG = 9216, RB0 = 0, NRB = 2304, RAC0 = 2304, NRAC = 3840, RG0 = 6144, NRG = 3072;
constexpr int LA2 = 2816, A2_QR = 0, A2_IQ = 128, A2_IK = 640, A2_IW = 704, A2_CKV = 768, A2_KR = 896, A2_CQ = 1024, A2_CK = 1280, A2_CV = 1536, A2_CG = 2048, A2_CAL = 2560;
constexpr int LPB = 2304;
constexpr float QSCALE = 0.18033688011112042f;

constexpr size_t MiB = 1u << 20;
constexpr size_t WS_CTL = 0, CTL_ZERO_BYTES = 1 * MiB;
constexpr size_t WS_W = 1 * MiB;
constexpr size_t WS_CS = 25 * MiB;
constexpr size_t WS_XN = 26 * MiB;
constexpr size_t WS_FB = 58 * MiB;
constexpr size_t WS_YB = 90 * MiB;
constexpr size_t WS_YA = 98 * MiB;
constexpr size_t WS_YC = 130 * MiB;
constexpr size_t WS_BIG = 146 * MiB;
constexpr size_t WS_DEC = 242 * MiB;
constexpr size_t WS_END = 243 * MiB;
constexpr size_t WO_W1 = 0, WO_W2 = (size_t)2 * DFF * D;
constexpr size_t WO_BIG = 0, WO_MA = (size_t)NBIG * D, WO_MB = WO_MA + (size_t)D * 1024, WO_MC = WO_MB + (size_t)D * 256, WO_WO = WO_MC + (size_t)D * 512;
static_assert((WO_WO + (size_t)D * D) * 2 <= 24 * MiB && (WO_W2 + (size_t)D * DFF) * 2 <= 24 * MiB, "weights region");
constexpr int CW_BAR = 4096;

constexpr int RING_BYTES = 131072, LDS_BYTES = 163840, MISC_OFF = LDS_BYTES - 1024;

#define RLX_AGENT __ATOMIC_RELAXED, __HIP_MEMORY_SCOPE_AGENT
#define LDS_WAIT() asm volatile("s_waitcnt lgkmcnt(0)" ::: "memory")
#define VM_WAIT() asm volatile("s_waitcnt vmcnt(0)" ::: "memory")
__device__ __forceinline__ unsigned char* opaque_ptr(unsigned char* p) { GAS unsigned char* g = (GAS unsigned char*)p; asm volatile("" : "+s"(g)); return (unsigned char*)g; }
__device__ __forceinline__ int otid() { int t = threadIdx.x; asm volatile("" : "+v"(t)); return t; }
__device__ __forceinline__ int obid() { int b = blockIdx.x; asm volatile("" : "+s"(b)); return b; }
__device__ __forceinline__ unsigned f2bf(float f) { unsigned u = __builtin_bit_cast(unsigned, f); return (u + 0x7fffu + ((u >> 16) & 1u)) >> 16; }
__device__ __forceinline__ unsigned pk2(float lo, float hi) { return f2bf(lo) | (f2bf(hi) << 16); }
__device__ __forceinline__ float bf2f(bf16 v) { return __uint_as_float((unsigned)v << 16); }
__device__ __forceinline__ float blo(unsigned w) { return __uint_as_float(w << 16); }
__device__ __forceinline__ float bhi(unsigned w) { return __uint_as_float(w & 0xffff0000u); }
__device__ __forceinline__ float wave_sum(float v) {
#pragma unroll
    for (int o = 1; o < 64; o <<= 1) v += __shfl_xor(v, o);
    return v;
}
__device__ __forceinline__ float wave_max(float v) {
#pragma unroll
    for (int o = 1; o < 64; o <<= 1) v = fmaxf(v, __shfl_xor(v, o));
    return v;
}

struct Args {
    const float* in[24]; float* out; unsigned char* ws; int l, pad;
};
enum { I_X = 0, I_POS, I_F1PRE, I_F1WIN, I_F1WOUT, I_F1POST, I_MIXPRE, I_WIN, I_AKVG, I_AWKV, I_CWAL, I_CBAL, I_CNORM, I_WBA, I_WBB, I_WBC, I_WGATE, I_BGATE, I_WOUT, I_MIXPOST, I_F2PRE, I_F2WIN, I_F2WOUT, I_F2POST };

__device__ __forceinline__ void cvt_tile(const float* src, int ld, int col0, int ncols, int k0, bf16* dst, int K, int drow0, float scale, bool zfill, LAS float* scr, int tid) {
    __syncthreads();
#pragma unroll
    for (int i = 0; i < 8; ++i) { const int kk = (tid >> 6) + 8 * i, n = tid & 63; scr[kk * 65 + n] = (n < ncols) ? src[(size_t)(k0 + kk) * ld + col0 + n] * scale : 0.f; }
    __syncthreads();
    const int n = tid >> 3, c = tid & 7;
    if (n < ncols || zfill) { const LAS float* s = scr + (8 * c) * 65 + n;
        v4u o; o.x = pk2(s[0], s[65]); o.y = pk2(s[2 * 65], s[3 * 65]); o.z = pk2(s[4 * 65], s[5 * 65]); o.w = pk2(s[6 * 65], s[7 * 65]);
        *(v4u*)(dst + (size_t)(drow0 + n) * K + k0 + 8 * c) = o; }
}
__device__ __forceinline__ void cvt_block(const float* src, int ld, int col0, int ncols, int K, bf16* dst, int drow0, float scale, bool zfill, LAS float* scr, int& rot) {
    const int G = gridDim.x, nct = (ncols + 63) / 64, nkt = K / 64, nt = nct * nkt;
    for (int t = (obid() - rot % G + G) % G; t < nt; t += G) { const int ct = t / nkt, kt = t % nkt; const int nc = ncols - 64 * ct < 64 ? ncols - 64 * ct : 64;
        cvt_tile(src, ld, col0 + 64 * ct, nc, 64 * kt, dst, K, drow0 + 64 * ct, scale, zfill, scr, otid()); }
    rot += nt;
}
__device__ __forceinline__ void cvt_ffn(const float* w_in, const float* w_out, bf16* W1t, bf16* W2t, LAS float* scr) {
    const int G = gridDim.x;
    constexpr int NRT = 2 * DFF / 64, NKT = D / 64;
    for (int t = obid(); t < NRT * NKT; t += G) { const int rt = t / NKT, kt = t % NKT; const int pn = rt >> 2, w = (rt & 3) * 64;
        const int col = (w < 128) ? 128 * pn + w : DFF + 128 * pn + (w - 128);
        cvt_tile(w_in, 2 * DFF, col, 64, 64 * kt, W1t, D, 64 * rt, 1.0f, false, scr, otid()); }
    int rot = NRT * NKT;
    cvt_block(w_out, D, 0, D, DFF, W2t, 0, 1.0f, false, scr, rot);
}
template <class C> __device__ __forceinline__ void cvt_mixer(const C& a, int l, bf16* W, LAS float* scr) {
    const float* w_in = a.in(I_WIN) + (size_t)l * D * DIN;
    const float* wkv = a.in(I_AWKV) + (size_t)l * 128 * 1024;
    bf16* Wbig = W + WO_BIG;
    int rot = 0;
    cvt_block(w_in, DIN, WI_BQKV, 768, D, Wbig, RB0, QSCALE, false, scr, rot);
    cvt_block(w_in, DIN, WI_BQKV + 768, 1536, D, Wbig, RB0 + 768, 1.0f, false, scr, rot);
    const int R2 = RAC0 + 1024;
#pragma unroll 1
    for (int h = 0; h < 8; ++h) cvt_block(w_in, DIN, WI_AQ + 64 * h, 16, D, Wbig, R2 + A2_QR + 16 * h, QSCALE, false, scr, rot);
    cvt_block(w_in, DIN, WI_IQ, 512, D, Wbig, R2 + A2_IQ, 1.0f, false, scr, rot);
    cvt_block(w_in, DIN, WI_IK, 64, D, Wbig, R2 + A2_IK, 1.0f, false, scr, rot);
    cvt_block(w_in, DIN, WI_IW, 8, D, Wbig, R2 + A2_IW, 1.0f, true, scr, rot);
    cvt_block(w_in, DIN, WI_CKV, 128, D, Wbig, R2 + A2_CKV, 1.0f, false, scr, rot);
    cvt_block(w_in, DIN, WI_CQ, 256, D, Wbig, R2 + A2_CQ, 0.125f, false, scr, rot);
    cvt_block(w_in, DIN, WI_CK, 256 + 512 + 512, D, Wbig, R2 + A2_CK, 1.0f, false, scr, rot);
    cvt_block(a.in(I_WGATE) + (size_t)l * D * 3072, 3072, 0, 3072, D, Wbig, RG0, 1.0f, false, scr, rot);
    cvt_block(a.in(I_WBB) + (size_t)l * 256 * D, D, 0, D, 256, W + WO_MB, 0, 1.0f, false, scr, rot);
    cvt_block(a.in(I_WBC) + (size_t)l * 512 * D, D, 0, D, 512, W + WO_MC, 0, 1.0f, false, scr, rot);
    cvt_block(a.in(I_WOUT) + (size_t)l * D * D, D, 0, D, D, W + WO_WO, 0, 1.0f, false, scr, rot);
    const int gt = obid() * NTHR + otid(), GT = gridDim.x * NTHR;
    for (int e = gt; e < 1024 * D; e += GT) { const int d = e & 1023, rc = e >> 10, h = rc >> 7, c = rc & 127;
        const float* wi = w_in + (size_t)d * DIN + WI_AQ + 64 * h; const float* wk = wkv + (size_t)c * 1024 + 128 * h; float s = 0.f;
#pragma unroll 8
        for (int j = 16; j < 64; ++j) s += wi[j] * wk[j];
        Wbig[(size_t)(RAC0 + rc) * D + d] = (bf16)f2bf(s * QSCALE); }
    const float* gkv = a.in(I_AKVG) + (size_t)l * 128;
    for (int e = gt; e < 128 * D; e += GT) { const int d = e & 1023, rc = e >> 10, h = rc >> 4, i = rc & 15;
        const float* wi = w_in + (size_t)d * DIN + WI_CKV; float s = 0.f;
#pragma unroll 8
        for (int c = 0; c < 128; ++c) s += wi[c] * gkv[c] * wkv[(size_t)c * 1024 + 128 * h + i];
        Wbig[(size_t)(R2 + A2_KR + rc) * D + d] = (bf16)f2bf(s); }
    const float* wal = a.in(I_CWAL) + (size_t)l * 16 * 256;
    for (int e = gt; e < 256 * D; e += GT) { const int d = e & 1023, n = e >> 10;
        const float* wi = w_in + (size_t)d * DIN + WI_CA; float s = 0.f;
#pragma unroll
        for (int r = 0; r < 16; ++r) s += wi[r] * wal[r * 256 + n];
        Wbig[(size_t)(R2 + A2_CAL + n) * D + d] = (bf16)f2bf(s); }
    const float* wba = a.in(I_WBA) + (size_t)l * 512 * D;
    for (int e = gt; e < 1024 * 1024; e += GT) { const int k = e & 1023, n = e >> 10, h = k >> 7, c = k & 127;
        const float* wk = wkv + (size_t)c * 1024 + 128 * h + 64; const float* wb = wba + (size_t)(64 * h) * D + n; float s = 0.f;
#pragma unroll 8
        for (int j = 0; j < 64; ++j) s += wk[j] * wb[(size_t)j * D];
        (W + WO_MA)[(size_t)n * 1024 + k] = (bf16)f2bf(s); }
}

__device__ __forceinline__ void cs_phase(const int* pos, float* cs) {
    const int gt = obid() * NTHR + otid(), GT = gridDim.x * NTHR;
    for (int e = gt; e < T * 8; e += GT) { const int t = e >> 3, i = e & 7;
        const double frev = (i == 0) ? 0.15915494309189535 : (i == 1) ? 0.03086376340470123 : (i == 2) ? 0.005985185712713705 : (i == 3) ? 0.001160663641240061 :
                            (i == 4) ? 0.00022507907903927653 : (i == 5) ? 4.364795279280289e-05 : (i == 6) ? 8.464330808241401e-06 : 1.6414262627950345e-06;
        const double rev = (double)pos[t] * frev; const float fr = (float)(rev - __builtin_floor(rev));
        cs[(size_t)t * 16 + i] = __builtin_amdgcn_cosf(fr); cs[(size_t)t * 16 + 8 + i] = __builtin_amdgcn_sinf(fr); }
}
__device__ __forceinline__ void resid_phase(const float* hin, float* hout, const bf16* f, float w, const float* gpost, const float* gpre, bf16* xn) {
    const int lane = otid() & 63, gw = obid() * NWAVES + (otid() >> 6), NGW = gridDim.x * NWAVES;
    for (int r = gw; r < T; r += NGW) {
        f32x4 v[4];
#pragma unroll
        for (int j = 0; j < 4; ++j) v[j] = *(const f32x4*)(hin + (size_t)r * D + 256 * j + 4 * lane);
        if (f) { f32x4 fv[4]; float s = 0.f;
#pragma unroll
            for (int j = 0; j < 4; ++j) { const v2u p = *(const v2u*)(f + (size_t)r * D + 256 * j + 4 * lane); fv[j] = (f32x4){blo(p.x), bhi(p.x), blo(p.y), bhi(p.y)};
                s += (fv[j][0] * fv[j][0] + fv[j][1] * fv[j][1]) + (fv[j][2] * fv[j][2] + fv[j][3] * fv[j][3]); }
            const float rstd = w * __builtin_amdgcn_rsqf(wave_sum(s) * (1.0f / D) + RMS_EPS);
#pragma unroll
            for (int j = 0; j < 4; ++j) { const f32x4 g = *(const f32x4*)(gpost + 256 * j + 4 * lane); v[j] = v[j] + fv[j] * rstd * g; }
        }
#pragma unroll
        for (int j = 0; j < 4; ++j) *(f32x4*)(hout + (size_t)r * D + 256 * j + 4 * lane) = v[j];
        if (xn) { float s = 0.f;
#pragma unroll
            for (int j = 0; j < 4; ++j) s += (v[j][0] * v[j][0] + v[j][1] * v[j][1]) + (v[j][2] * v[j][2] + v[j][3] * v[j][3]);
            const float rstd = __builtin_amdgcn_rsqf(wave_sum(s) * (1.0f / D) + RMS_EPS);
#pragma unroll
            for (int j = 0; j < 4; ++j) { const f32x4 g = *(const f32x4*)(gpre + 256 * j + 4 * lane); const f32x4 o = v[j] * rstd * g;
                v2u p; p.x = pk2(o[0], o[1]); p.y = pk2(o[2], o[3]); *(v2u*)(xn + (size_t)r * D + 256 * j + 4 * lane) = p; }
        }
    }
}
__device__ __forceinline__ void rec_phase(const bf16* pA2, const float* gkv, const float* cs, bf16* rec) {
    const int lane = otid() & 63, gw = obid() * NWAVES + (otid() >> 6), NGW = gridDim.x * NWAVES;
    for (int r = gw; r < T; r += NGW) {
        const unsigned pc = *(const unsigned*)(pA2 + (size_t)r * LA2 + A2_CKV + 2 * lane), pk = *(const unsigned*)(pA2 + (size_t)r * LA2 + A2_KR + 2 * lane);
        const float c0 = blo(pc), c1 = bhi(pc);
        const float rstd = __builtin_amdgcn_rsqf(wave_sum(c0 * c0 + c1 * c1) * (1.0f / 128.0f) + RMS_EPS);
        *(unsigned*)(rec + (size_t)r * 256 + 2 * lane) = pk2(c0 * rstd * gkv[2 * lane], c1 * rstd * gkv[2 * lane + 1]);
        const float k0 = blo(pk) * rstd, k1 = bhi(pk) * rstd;
        const float q0 = __shfl_xor(k0, 4), q1 = __shfl_xor(k1, 4);
        const int i0 = (2 * lane) & 7; const bool hi = ((2 * lane) & 8) != 0;
        const float cc0 = cs[(size_t)r * 16 + i0], cc1 = cs[(size_t)r * 16 + i0 + 1], ss0 = cs[(size_t)r * 16 + 8 + i0], ss1 = cs[(size_t)r * 16 + 8 + i0 + 1];
        const float o0 = hi ? k0 * cc0 + q0 * ss0 : k0 * cc0 - q0 * ss0, o1 = hi ? k1 * cc1 + q1 * ss1 : k1 * cc1 - q1 * ss1;
        *(unsigned*)(rec + (size_t)r * 256 + 128 + 2 * lane) = pk2(o0, o1);
    }
}
__device__ __forceinline__ unsigned pack_score(float sc, int idx) {
    const unsigned u = __float_as_uint(sc); const unsigned m = u ^ ((u >> 31) ? 0xffffffffu : 0x80000000u);
    return (m & 0xffffe000u) | (unsigned)idx;
}
__device__ __forceinline__ void nv_idx_phase(const bf16* pA2, unsigned short* sel, LAS unsigned char* lds) {
    LAS float* qs = (LAS float*)lds;
    LAS float* ws_ = qs + 512;
    LAS unsigned* ctr = (LAS unsigned*)(ws_ + 8);
    LAS unsigned* pk = (LAS unsigned*)(lds + 4096);
    const int tid = otid();
    for (int q0 = obid(); q0 < T; q0 += gridDim.x) {
        const int q = ((q0 & 1) ? (T - 1 - (q0 >> 1)) : (q0 >> 1));
        const int b = q / S, t = q % S, n = t + 1;
        __syncthreads();
        qs[tid] = bf2f(pA2[(size_t)q * LA2 + A2_IQ + tid]);
        if (tid < 8) ws_[tid] = bf2f(pA2[(size_t)q * LA2 + A2_IW + tid]);
        if (tid < 8) ctr[tid] = 0u;
        __syncthreads();
        for (int s = tid; s < n; s += NTHR) {
            const v4u* kp = (const v4u*)(pA2 + (size_t)(b * S + s) * LA2 + A2_IK);
            v4u kq[8];
#pragma unroll
            for (int c = 0; c < 8; ++c) kq[c] = kp[c];
            float sc = 0.f;
#pragma unroll 1
            for (int h = 0; h < 8; ++h) { float d = 0.f; const LAS float* qh = qs + h * 64;
#pragma unroll
                for (int c = 0; c < 8; ++c) d += qh[8 * c] * blo(kq[c].x) + qh[8 * c + 1] * bhi(kq[c].x) + qh[8 * c + 2] * blo(kq[c].y) + qh[8 * c + 3] * bhi(kq[c].y) + qh[8 * c + 4] * blo(kq[c].z) + qh[8 * c + 5] * bhi(kq[c].z) + qh[8 * c + 6] * blo(kq[c].w) + qh[8 * c + 7] * bhi(kq[c].w);
                sc += ws_[h] * fmaxf(d, 0.f); }
            pk[s] = pack_score(sc, s);
        }
        __syncthreads();
        unsigned thr = 0u;
        if (n > 256) {
            unsigned lo = 0u, hi = 0xffffffffu; int it = 0;
            for (;;) {
                const unsigned mid = lo + ((hi - lo) >> 1);
                unsigned c = 0;
                for (int s = tid; s < n; s += NTHR) c += (pk[s] >= mid) ? 1u : 0u;
#pragma unroll
                for (int o = 1; o < 64; o <<= 1) c += __shfl_xor(c, o);
                const int slot = 1 + (it & 3);
                if ((tid & 63) == 0) atomicAdd((unsigned*)&ctr[slot], c);
                __syncthreads();
                const unsigned tot = ctr[slot];
                if (tid == 0) ctr[1 + ((it + 2) & 3)] = 0u;
                ++it;
                if (tot == 256u || hi - lo <= 1u || it > 40) { thr = mid; break; }
                if (tot > 256u) lo = mid; else hi = mid;
            }
        }
        __syncthreads();
        unsigned base = 0u;
        for (int s0 = 0; s0 < n; s0 += NTHR) { const int s = s0 + tid; const bool keep = (s < n) && (pk[s] >= thr);
            const unsigned long long bm = __ballot(keep); const unsigned wc_ = (unsigned)__popcll(bm);
            __syncthreads();
            if ((tid & 63) == 0) ctr[tid >> 6] = wc_;
            __syncthreads();
            unsigned off = base, tot = 0u;
#pragma unroll
            for (int w = 0; w < 8; ++w) { const unsigned c = ctr[w]; if (w < (tid >> 6)) off += c; tot += c; }
            if (keep) { const unsigned p = off + (unsigned)__popcll(bm & ((1ull << (tid & 63)) - 1ull)); if (p < 256u) sel[(size_t)q * 256 + p] = (unsigned short)s; }
            base += tot; }
        const unsigned cnt = base < 256u ? base : 256u;
        if (tid < 256 && (unsigned)tid >= cnt) sel[(size_t)q * 256 + tid] = 0xffffu;
    }
}
__device__ __forceinline__ void nv_atta_phase(const bf16* pA2, bf16* ya, const bf16* rec, const unsigned short* sel, LAS unsigned char* lds) {
    LAS float* qa = (LAS float*)lds;
    LAS float* qr = qa + 1024;
    LAS float* P = qr + 128;
    LAS int* sl = (LAS int*)(P + 2048);
    const int tid = otid(), lane = tid & 63, wv = tid >> 6;
    for (int q = obid(); q < T; q += gridDim.x) {
        const int b = q / S;
        __syncthreads();
        qa[tid] = bf2f(ya[(size_t)q * 1024 + tid]); qa[tid + 512] = bf2f(ya[(size_t)q * 1024 + 512 + tid]);
        if (tid < 128) qr[tid] = bf2f(pA2[(size_t)q * LA2 + A2_QR + tid]);
        if (tid < 256) sl[tid] = sel[(size_t)q * 256 + tid];
        __syncthreads();
        { const int k = tid & 255, hh = tid >> 8; const int key = sl[k]; const bool valid = key != 0xffff;
          const bf16* rp = rec + (size_t)(b * S + (valid ? key : 0)) * 256;
          float s4[4] = {0.f, 0.f, 0.f, 0.f};
          for (int c8 = 0; c8 < 16; ++c8) { const v4u w = *(const v4u*)(rp + 8 * c8); const float x[8] = {blo(w.x), bhi(w.x), blo(w.y), bhi(w.y), blo(w.z), bhi(w.z), blo(w.w), bhi(w.w)};
#pragma unroll
              for (int h = 0; h < 4; ++h)
#pragma unroll
                  for (int e = 0; e < 8; ++e) s4[h] += qa[(hh * 4 + h) * 128 + 8 * c8 + e] * x[e]; }
#pragma unroll
          for (int h = 0; h < 4; ++h) { const int hd = hh * 4 + h; const v4u w0 = *(const v4u*)(rp + 128 + 16 * hd), w1 = *(const v4u*)(rp + 128 + 16 * hd + 8);
              const float x[16] = {blo(w0.x), bhi(w0.x), blo(w0.y), bhi(w0.y), blo(w0.z), bhi(w0.z), blo(w0.w), bhi(w0.w), blo(w1.x), bhi(w1.x), blo(w1.y), bhi(w1.y), blo(w1.z), bhi(w1.z), blo(w1.w), bhi(w1.w)};
#pragma unroll
              for (int e = 0; e < 16; ++e) s4[h] += qr[hd * 16 + e] * x[e];
              P[hd * 256 + k] = valid ? s4[h] : -INFINITY; } }
        __syncthreads();
        { float v[4]; float m = -INFINITY;
#pragma unroll
          for (int j = 0; j < 4; ++j) { v[j] = P[wv * 256 + lane + 64 * j]; m = fmaxf(m, v[j]); }
          m = wave_max(m); float sum = 0.f;
#pragma unroll
          for (int j = 0; j < 4; ++j) { v[j] = exp2f(v[j] - m); sum += v[j]; }
          sum = wave_sum(sum); const float inv = 1.0f / sum;
#pragma unroll
          for (int j = 0; j < 4; ++j) P[wv * 256 + lane + 64 * j] = v[j] * inv; }
        __syncthreads();
        { const int c = tid & 127, hq = tid >> 7; float o0 = 0.f, o1 = 0.f;
          for (int k = 0; k < 256; ++k) { const int key = sl[k]; if (key == 0xffff) continue; const float x = bf2f(rec[(size_t)(b * S + key) * 256 + c]); o0 += P[(2 * hq) * 256 + k] * x; o1 += P[(2 * hq + 1) * 256 + k] * x; }
          ya[(size_t)q * 1024 + (2 * hq) * 128 + c] = (bf16)f2bf(o0); ya[(size_t)q * 1024 + (2 * hq + 1) * 128 + c] = (bf16)f2bf(o1); }
    }
}
__device__ __forceinline__ void nv_attb_phase(const bf16* pB, bf16* yb, LAS unsigned char* lds) {
    const int tid = otid(), lane = tid & 63, wv = tid >> 6;
    LAS float* qv = (LAS float*)lds + wv * 64;
    const int gw = obid() * NWAVES + wv, NGW = gridDim.x * NWAVES;
    for (int item = gw; item < T * 4; item += NGW) {
        const int tg = item >> 2, hs = item & 3, b = tg / S, t = tg % S;
        float m = -INFINITY, l = 0.f, o = 0.f;
#pragma unroll 1
        for (int g = 0; g < 3; ++g) {
            const int dil = (g == 0) ? 1 : (g == 1) ? 4 : 16, head = g * 4 + hs;
            LDS_WAIT();
            qv[lane] = bf2f(pB[(size_t)tg * LPB + head * 64 + lane]);
            LDS_WAIT();
#pragma unroll 1
            for (int pass = 0; pass < 3; ++pass) {
                const int j = pass * 64 + lane, pos = t - dil * j; const bool valid = (j <= 128) && (pos >= 0);
                float s = -INFINITY;
                if (valid) { const v4u* kp = (const v4u*)(pB + (size_t)(b * S + pos) * LPB + 768 + head * 64); float d = 0.f;
#pragma unroll
                    for (int c = 0; c < 8; ++c) { const v4u w = kp[c]; d += qv[8 * c] * blo(w.x) + qv[8 * c + 1] * bhi(w.x) + qv[8 * c + 2] * blo(w.y) + qv[8 * c + 3] * bhi(w.y) + qv[8 * c + 4] * blo(w.z) + qv[8 * c + 5] * bhi(w.z) + qv[8 * c + 6] * blo(w.w) + qv[8 * c + 7] * bhi(w.w); }
                    s = d; }
                const float mx = wave_max(s);
                if (mx == -INFINITY) continue;
                const float mn = fmaxf(m, mx), p = valid ? exp2f(s - mn) : 0.f, scl = exp2f(m - mn);
                l = l * scl + wave_sum(p); o *= scl; m = mn;
                const int nj = (pass == 2) ? 1 : 64;
                for (int jj = 0; jj < nj; ++jj) { const float pj = __shfl(p, jj); const int pj_pos = t - dil * (pass * 64 + jj);
                    if (pj_pos >= 0) o += pj * bf2f(pB[(size_t)(b * S + pj_pos) * LPB + 1536 + head * 64 + lane]); }
            }
        }
        yb[(size_t)tg * 256 + hs * 64 + lane] = (bf16)f2bf(o / l);
    }
}
__device__ __forceinline__ float logsigmoid_f(float x) { return fminf(x, 0.f) - log1pf(__expf(-fabsf(x))); }
__device__ __forceinline__ void nv_gla_phase(const bf16* pA2, const float* cbal, bf16* yc) {
    const int lane = otid() & 63, gw = obid() * NWAVES + (otid() >> 6), NGW = gridDim.x * NWAVES;
    for (int item = gw; item < NB * 4 * 128; item += NGW) {
        const int b = item >> 9, h = (item >> 7) & 3, dv = item & 127;
        const float bias = cbal[h * 64 + lane];
        float St = 0.f;
        for (int t = 0; t < S; ++t) { const bf16* rp = pA2 + (size_t)(b * S + t) * LA2;
            const float a = __expf(logsigmoid_f(bf2f(rp[A2_CAL + h * 64 + lane]) + bias) * (1.0f / 16.0f));
            const float k = bf2f(rp[A2_CK + h * 64 + lane]), qv = bf2f(rp[A2_CQ + h * 64 + lane]), v = bf2f(rp[A2_CV + h * 128 + dv]);
            St = a * St + k * v;
            const float o = wave_sum(qv * St);
            if (lane == 0) yc[(size_t)(b * S + t) * 512 + h * 128 + dv] = (bf16)f2bf(o); }
    }
}
__device__ __forceinline__ void nv_gla_out_phase(const bf16* pA2, const float* cng, bf16* yc) {
    const int lane = otid() & 63, gw = obid() * NWAVES + (otid() >> 6), NGW = gridDim.x * NWAVES;
    for (int item = gw; item < T * 4; item += NGW) { const int r = item >> 2, h = item & 3;
        const unsigned po = *(const unsigned*)(yc + (size_t)r * 512 + h * 128 + 2 * lane), pg = *(const unsigned*)(pA2 + (size_t)r * LA2 + A2_CG + h * 128 + 2 * lane);
        const float o0 = blo(po), o1 = bhi(po), g0 = blo(pg), g1 = bhi(pg);
        const float rstd = __builtin_amdgcn_rsqf(wave_sum(o0 * o0 + o1 * o1) * (1.0f / 128.0f) + RMS_EPS);
        const float y0 = o0 * rstd * cng[2 * lane] * (g0 / (1.0f + __expf(-g0))), y1 = o1 * rstd * cng[2 * lane + 1] * (g1 / (1.0f + __expf(-g1)));
        *(unsigned*)(yc + (size_t)r * 512 + h * 128 + 2 * lane) = pk2(y0, y1); }
}
typedef short v4i16_t __attribute__((ext_vector_type(4)));
typedef float f32x4_t __attribute__((ext_vector_type(4)));
__device__ __forceinline__ v4i16_t lds_tr(LAS unsigned char* p) { return __builtin_amdgcn_ds_read_tr16_b64_v4i16((LAS v4i16_t*)p); }
__device__ __forceinline__ bf16x8 cat8(v4i16_t a, v4i16_t b) { return __builtin_shufflevector(a, b, 0, 1, 2, 3, 4, 5, 6, 7); }
__device__ __forceinline__ unsigned cvtpk(float lo, float hi) { return pg8::cvt_pk_bf16(lo, hi); }
__device__ __forceinline__ float fast_sig(float x) { return __builtin_amdgcn_rcpf(1.0f + __expf(-x)); }
__device__ __forceinline__ f32x4_t mfma16(bf16x8 a, bf16x8 b, f32x4_t c) { return __builtin_amdgcn_mfma_f32_16x16x32_bf16(a, b, c, 0, 0, 0); }

constexpr int GLA_HEAD_LDS = 39936;
template <int MODE> __device__ __forceinline__ void gla_chunk_phase(const bf16* pA2, const float* cbal, const float* cng, bf16* KVT, float* DEC, bf16* yc, LAS unsigned char* lds) {
    const int tid = otid(), lane = tid & 63, wv = __builtin_amdgcn_readfirstlane(tid >> 6), hh = wv >> 2, sub = wv & 3, ht = tid & 255;
    const int d = ht & 63, fr = lane & 15, g = lane >> 4, q4 = fr >> 2, p4 = fr & 3;
    LAS unsigned char* L = lds + hh * GLA_HEAD_LDS;
    LAS float* tot = (LAS float*)L;
    LAS unsigned char* KI = L + 1024;
    LAS unsigned char* QD = L + 1024 + 10240;
    LAS unsigned char* VI = L + 1024 + 10240 + 9216;
    for (int u = obid(); u < NB * 128 * 2; u += gridDim.x) {
        const int b = u >> 8, n = (u >> 1) & 127, h = (u & 1) * 2 + hh, bh = b * 4 + h;
        const size_t row0 = (size_t)b * S + (size_t)n * 64;
        __syncthreads();
        float bl_[16]; float run = 0.f; const float bias = cbal[h * 64 + d];
#pragma unroll
        for (int i = 0; i < 16; ++i) { const float x = bf2f(pA2[(row0 + sub * 16 + i) * LA2 + A2_CAL + h * 64 + d]) + bias;
            run += (fminf(x, 0.f) - __logf(1.0f + __expf(-fabsf(x)))) * (1.0f / 16.0f); bl_[i] = run; }
        tot[sub * 64 + d] = run;
        __syncthreads();
        float pre = 0.f, all = 0.f;
#pragma unroll
        for (int p = 0; p < 4; ++p) { const float v = tot[p * 64 + d]; pre += (p < sub) ? v : 0.f; all += v; }
#pragma unroll
        for (int i = 0; i < 16; ++i) { const int t = sub * 16 + i; const float bt = bl_[i] + pre; const float kk = bf2f(pA2[(row0 + t) * LA2 + A2_CK + h * 64 + d]);
            if (MODE == 1) { *(LAS unsigned short*)(KI + t * 160 + d * 2) = (unsigned short)f2bf(kk * __expf(all - bt)); }
            else { const float qq = bf2f(pA2[(row0 + t) * LA2 + A2_CQ + h * 64 + d]);
                *(LAS unsigned short*)(KI + t * 144 + d * 2) = (unsigned short)f2bf(kk * __expf(-bt)); *(LAS unsigned short*)(QD + t * 144 + d * 2) = (unsigned short)f2bf(qq * __expf(bt)); } }
        if (MODE == 1 && sub == 0) DEC[((size_t)bh * 128 + n) * 64 + d] = __expf(all);
#pragma unroll
        for (int c = 0; c < 4; ++c) { const int idx = ht + 256 * c, t = idx >> 4, ch = idx & 15;
            *(LAS v4u*)(VI + t * 288 + ch * 16) = *(const v4u*)(pA2 + (row0 + t) * LA2 + A2_CV + h * 128 + ch * 8); }
        __syncthreads();
        if (MODE == 1) {
            f32x4_t acc[2][4];
#pragma unroll
            for (int j = 0; j < 2; ++j)
#pragma unroll
                for (int mb = 0; mb < 4; ++mb) acc[j][mb] = (f32x4_t){0.f, 0.f, 0.f, 0.f};
#pragma unroll
            for (int ks = 0; ks < 2; ++ks) { const int r0 = 32 * ks + 4 * g + q4, r1 = r0 + 16;
                bf16x8 bfr[2];
#pragma unroll
                for (int j = 0; j < 2; ++j) { const int cb = (16 * (2 * sub + j) + 4 * p4) * 2; bfr[j] = cat8(lds_tr(VI + r0 * 288 + cb), lds_tr(VI + r1 * 288 + cb)); }
#pragma unroll
                for (int mb = 0; mb < 4; ++mb) { const int ca = (16 * mb + 4 * p4) * 2; const bf16x8 af = cat8(lds_tr(KI + r0 * 160 + ca), lds_tr(KI + r1 * 160 + ca));
#pragma unroll
                    for (int j = 0; j < 2; ++j) acc[j][mb] = mfma16(af, bfr[j], acc[j][mb]); } }
#pragma unroll
            for (int j = 0; j < 2; ++j)
#pragma unroll
                for (int mb = 0; mb < 4; ++mb) { v2u o; o.x = cvtpk(acc[j][mb][0], acc[j][mb][1]); o.y = cvtpk(acc[j][mb][2], acc[j][mb][3]);
                    *(v2u*)(KVT + (((size_t)bh * 128 + n) * 128 + 16 * (2 * sub + j) + fr) * 64 + 16 * mb + 4 * g) = o; }
        } else {
            const int tq = 16 * sub + fr;
            bf16x8 bq[2];
#pragma unroll
            for (int ks = 0; ks < 2; ++ks) bq[ks] = *(const LAS bf16x8*)(QD + tq * 144 + (32 * ks + 8 * g) * 2);
            unsigned pw[2][4];
#pragma unroll
            for (int ms = 0; ms < 4; ++ms) { f32x4_t sacc = (f32x4_t){0.f, 0.f, 0.f, 0.f};
#pragma unroll
                for (int ks = 0; ks < 2; ++ks) { const bf16x8 ak = *(const LAS bf16x8*)(KI + (16 * ms + fr) * 144 + (32 * ks + 8 * g) * 2); sacc = mfma16(ak, bq[ks], sacc); }
#pragma unroll
                for (int i = 0; i < 4; ++i) if (16 * ms + 4 * g + i > tq) sacc[i] = 0.f;
                pw[ms >> 1][(ms & 1) * 2 + 0] = cvtpk(sacc[0], sacc[1]); pw[ms >> 1][(ms & 1) * 2 + 1] = cvtpk(sacc[2], sacc[3]); }
            f32x4_t oacc[8];
#pragma unroll
            for (int mb = 0; mb < 8; ++mb) oacc[mb] = (f32x4_t){0.f, 0.f, 0.f, 0.f};
#pragma unroll
            for (int ks2 = 0; ks2 < 2; ++ks2) { const int r0 = 32 * ks2 + 4 * g + q4, r1 = r0 + 16;
                const v4u pwv = {pw[ks2][0], pw[ks2][1], pw[ks2][2], pw[ks2][3]}; const bf16x8 pf = __builtin_bit_cast(bf16x8, pwv);
#pragma unroll
                for (int mb = 0; mb < 8; ++mb) { const int ca = (16 * mb + 4 * p4) * 2; const bf16x8 av = cat8(lds_tr(VI + r0 * 288 + ca), lds_tr(VI + r1 * 288 + ca)); oacc[mb] = mfma16(av, pf, oacc[mb]); } }
            const bf16* sp = KVT + ((size_t)bh * 128 + n) * 8192;
#pragma unroll
            for (int ks = 0; ks < 2; ++ks)
#pragma unroll
                for (int mb = 0; mb < 8; ++mb) { const bf16x8 as = *(const bf16x8*)(sp + (16 * mb + fr) * 64 + 32 * ks + 8 * g); oacc[mb] = mfma16(as, bq[ks], oacc[mb]); }
            float ss = 0.f;
#pragma unroll
            for (int mb = 0; mb < 8; ++mb) ss += (oacc[mb][0] * oacc[mb][0] + oacc[mb][1] * oacc[mb][1]) + (oacc[mb][2] * oacc[mb][2] + oacc[mb][3] * oacc[mb][3]);
            ss += __shfl_xor(ss, 16); ss += __shfl_xor(ss, 32);
            const float rstd = __builtin_amdgcn_rsqf(ss * (1.0f / 128.0f) + RMS_EPS);
#pragma unroll
            for (int mb = 0; mb < 8; ++mb) { const int v0 = 16 * mb + 4 * g; const v2u gp = *(const v2u*)(pA2 + (row0 + tq) * LA2 + A2_CG + h * 128 + v0); const f32x4_t cn = *(const f32x4_t*)(cng + v0);
                const float g0 = blo(gp.x), g1 = bhi(gp.x), g2 = blo(gp.y), g3 = bhi(gp.y);
                const float y0 = oacc[mb][0] * rstd * cn[0] * g0 * fast_sig(g0), y1 = oacc[mb][1] * rstd * cn[1] * g1 * fast_sig(g1), y2 = oacc[mb][2] * rstd * cn[2] * g2 * fast_sig(g2), y3 = oacc[mb][3] * rstd * cn[3] * g3 * fast_sig(g3);
                v2u o; o.x = pk2(y0, y1); o.y = pk2(y2, y3); *(v2u*)(yc + (row0 + tq) * 512 + h * 128 + v0) = o; }
        }
    }
}
__device__ __forceinline__ void gla_scan_phase(bf16* KVT, const float* DEC) {
    const int tid = otid();
    if (tid < 256) for (int e = obid() * 256 + tid; e < 8 * 8192; e += gridDim.x * 256) { const int bh = e >> 13, vd = e & 8191, d = vd & 63;
        float St = 0.f; bf16* kp = KVT + (size_t)bh * 128 * 8192 + vd; const float* dp = DEC + (size_t)bh * 128 * 64 + d;
#pragma unroll 8
        for (int n = 0; n < 128; ++n) { const float kv = bf2f(kp[(size_t)n * 8192]), dc = dp[n * 64]; kp[(size_t)n * 8192] = (bf16)f2bf(St); St = dc * St + kv; } }
}

typedef float f32x16_t __attribute__((ext_vector_type(16)));
constexpr int IDX_C = 1024, IDX_KT = 128, IDX_KROW = 144, IDX_KT_OFF = 131072;
__device__ __forceinline__ unsigned wave_select256(const unsigned (&v)[16], unsigned lo0) {
    unsigned lo = lo0, hi = 0xffffffffu;
#pragma unroll 1
    for (int it = 0; it < 40; ++it) { const unsigned mid = lo + ((hi - lo) >> 1); int c = 0;
#pragma unroll
        for (int i = 0; i < 16; ++i) c += __popcll(__ballot(v[i] >= mid));
        if (c == 256) return mid;
        if (c > 256) lo = mid; else hi = mid; }
    return lo;
}
__device__ __forceinline__ void wave_prune(LAS unsigned* list, int& cnt, unsigned& thr, int lane) {
    unsigned v[16];
#pragma unroll
    for (int i = 0; i < 16; ++i) { const int idx = lane + 64 * i; v[i] = idx < cnt ? list[idx] : 0u; }
    const unsigned T = wave_select256(v, thr + 1u);
    int base = 0;
#pragma unroll
    for (int i = 0; i < 16; ++i) { const bool keep = v[i] >= T; const unsigned long long m = __ballot(keep);
        if (keep) list[base + __popcll(m & ((1ull << lane) - 1ull))] = v[i];
        base += __popcll(m); }
    cnt = base; thr = T - 1u;
}
__device__ __forceinline__ void idx_phase(const bf16* pA2, unsigned short* sel, LAS unsigned char* lds) {
    const int tid = otid(), lane = tid & 63, wv = __builtin_amdgcn_readfirstlane(tid >> 6), c = lane & 31, hb = lane >> 5;
    LAS unsigned char* KT = lds + IDX_KT_OFF;
    LAS unsigned* lists = (LAS unsigned*)lds + wv * 4 * IDX_C;
    const int r = lane & 31, a_tk = 2 * ((r >> 2) & 1) + (r >> 4), a_hd = ((r >> 3) & 1) * 4 + (r & 3);
    for (int u = obid(); u < 512; u += gridDim.x) {
        const int b = u >> 8, qt = (u < 256) ? u : 511 - u, t0 = qt * 32 + wv * 4;
        const size_t rowq = (size_t)b * S + t0;
        bf16x8 A[4];
#pragma unroll
        for (int ks = 0; ks < 4; ++ks) A[ks] = *(const bf16x8*)(pA2 + (rowq + a_tk) * LA2 + A2_IQ + a_hd * 64 + 16 * ks + 8 * hb);
        float w[16];
#pragma unroll
        for (int j = 0; j < 4; ++j) { const v2u wp = *(const v2u*)(pA2 + (rowq + 2 * hb + (j >> 1)) * LA2 + A2_IW + (j & 1) * 4);
            w[4 * j] = blo(wp.x); w[4 * j + 1] = bhi(wp.x); w[4 * j + 2] = blo(wp.y); w[4 * j + 3] = bhi(wp.y); }
        int cnt0 = 0, cnt1 = 0, cnt2 = 0, cnt3 = 0; unsigned th0 = 0u, th1 = 0u, th2 = 0u, th3 = 0u;
        const int tp0 = t0 + 2 * hb, tp1 = tp0 + 1;
        const int ntile = (qt * 32 + 32 + IDX_KT - 1) / IDX_KT;
        v4u kn[2];
#pragma unroll
        for (int cc = 0; cc < 2; ++cc) { const int idx = tid + 512 * cc; kn[cc] = *(const v4u*)(pA2 + ((size_t)b * S + (idx >> 3)) * LA2 + A2_IK + (idx & 7) * 8); }
#pragma unroll 1
        for (int tile = 0; tile < ntile; ++tile) {
            __syncthreads();
#pragma unroll
            for (int cc = 0; cc < 2; ++cc) { const int idx = tid + 512 * cc; *(LAS v4u*)(KT + (idx >> 3) * IDX_KROW + (idx & 7) * 16) = kn[cc]; }
            __syncthreads();
            if (tile + 1 < ntile) {
#pragma unroll
                for (int cc = 0; cc < 2; ++cc) { const int idx = tid + 512 * cc; kn[cc] = *(const v4u*)(pA2 + ((size_t)b * S + (tile + 1) * IDX_KT + (idx >> 3)) * LA2 + A2_IK + (idx & 7) * 8); } }
            if (cnt0 > IDX_C - IDX_KT) wave_prune(lists, cnt0, th0, lane);
            if (cnt1 > IDX_C - IDX_KT) wave_prune(lists + IDX_C, cnt1, th1, lane);
            if (cnt2 > IDX_C - IDX_KT) wave_prune(lists + 2 * IDX_C, cnt2, th2, lane);
            if (cnt3 > IDX_C - IDX_KT) wave_prune(lists + 3 * IDX_C, cnt3, th3, lane);
            const unsigned thl0 = hb ? th2 : th0, thl1 = hb ? th3 : th1;
            if (tile * IDX_KT <= t0 + 3) {
#pragma unroll 1
            for (int kb = 0; kb < 4; ++kb) {
                f32x16_t acc;
#pragma unroll
                for (int i = 0; i < 16; ++i) acc[i] = 0.f;
#pragma unroll
                for (int ks = 0; ks < 4; ++ks) { const bf16x8 B = *(const LAS bf16x8*)(KT + (32 * kb + c) * IDX_KROW + (16 * ks + 8 * hb) * 2); acc = __builtin_amdgcn_mfma_f32_32x32x16_bf16(A[ks], B, acc, 0, 0, 0); }
                float s0 = 0.f, s1 = 0.f;
#pragma unroll
                for (int i = 0; i < 8; ++i) { s0 += w[i] * fmaxf(acc[i], 0.f); s1 += w[8 + i] * fmaxf(acc[8 + i], 0.f); }
                const int key = tile * IDX_KT + 32 * kb + c;
                const unsigned p0 = (key <= tp0) ? pack_score(s0, key) : 0u, p1 = (key <= tp1) ? pack_score(s1, key) : 0u;
                const unsigned long long m0 = __ballot(p0 > thl0), m1 = __ballot(p1 > thl1);
                if (m0 | m1) {
                    const unsigned long long below = (1ull << lane) - 1ull;
                    { const unsigned long long mk = m0 & 0xffffffffull; if (mk) { if (hb == 0 && ((m0 >> lane) & 1ull)) lists[cnt0 + __popcll(mk & below)] = p0; cnt0 += __popcll(mk); } }
                    { const unsigned long long mk = m1 & 0xffffffffull; if (mk) { if (hb == 0 && ((m1 >> lane) & 1ull)) lists[IDX_C + cnt1 + __popcll(mk & below)] = p1; cnt1 += __popcll(mk); } }
                    { const unsigned long long mk = m0 & 0xffffffff00000000ull; if (mk) { if (hb == 1 && ((m0 >> lane) & 1ull)) lists[2 * IDX_C + cnt2 + __popcll(mk & below)] = p0; cnt2 += __popcll(mk); } }
                    { const unsigned long long mk = m1 & 0xffffffff00000000ull; if (mk) { if (hb == 1 && ((m1 >> lane) & 1ull)) lists[3 * IDX_C + cnt3 + __popcll(mk & below)] = p1; cnt3 += __popcll(mk); } }
                }
            } }
        }
#pragma unroll
        for (int j = 0; j < 4; ++j) { int cn = (j == 0) ? cnt0 : (j == 1) ? cnt1 : (j == 2) ? cnt2 : cnt3; unsigned th = (j == 0) ? th0 : (j == 1) ? th1 : (j == 2) ? th2 : th3;
            LAS unsigned* lj = lists + j * IDX_C;
            if (cn > 256) wave_prune(lj, cn, th, lane);
            unsigned short* so = sel + (rowq + j) * 256;
#pragma unroll
            for (int i = 0; i < 4; ++i) { const int idx = lane + 64 * i; so[idx] = (idx < cn) ? (unsigned short)(lj[idx] & 0x1fffu) : (unsigned short)0xffffu; } }
    }
}

constexpr int ATA_ROW = 288, ATA_WAVE_LDS = 32 * ATA_ROW;
__device__ __forceinline__ void atta_phase(const bf16* pA2, bf16* ya, const bf16* rec, const unsigned short* sel, LAS unsigned char* lds) {
    const int tid = otid(), lane = tid & 63, wv = __builtin_amdgcn_readfirstlane(tid >> 6), fr = lane & 15, g = lane >> 4, q4 = fr >> 2, p4 = fr & 3;
    LAS unsigned char* img = lds + wv * ATA_WAVE_LDS;
    const int gw = obid() * NWAVES + wv, NGW = gridDim.x * NWAVES;
    const bf16x8 zero8 = {0, 0, 0, 0, 0, 0, 0, 0};
#pragma unroll 1
    for (int q = gw; q < T; q += NGW) {
        const int b = q / S, t = q % S, nvalid = (t + 1 < 256) ? t + 1 : 256;
        const bf16* recb = rec + (size_t)b * S * 256;
        bf16x8 Bq[8];
#pragma unroll
        for (int ks = 0; ks < 4; ++ks) Bq[ks] = (fr < 8) ? *(const bf16x8*)(ya + (size_t)q * 1024 + fr * 128 + 32 * ks + 8 * g) : zero8;
#pragma unroll
        for (int ks = 0; ks < 4; ++ks) Bq[4 + ks] = (fr < 8 && fr == 2 * ks + (g >> 1)) ? *(const bf16x8*)(pA2 + (size_t)q * LA2 + A2_QR + fr * 16 + 8 * (g & 1)) : zero8;
        const unsigned short* selq = sel + (size_t)q * 256;
#define ATA_SIDX(i) ((16 * (i) + fr < nvalid) ? (int)selq[16 * (i) + fr] : 0)
        f32x4_t O[8];
#pragma unroll
        for (int mb = 0; mb < 8; ++mb) O[mb] = (f32x4_t){0.f, 0.f, 0.f, 0.f};
        float m = -INFINITY, l = 0.f;
        bf16x8 Ab[16];
#pragma unroll
        for (int tl = 0; tl < 2; ++tl) { const int kx = ATA_SIDX(tl);
#pragma unroll
            for (int ks = 0; ks < 8; ++ks) Ab[tl * 8 + ks] = *(const bf16x8*)(recb + (size_t)kx * 256 + 32 * ks + 8 * g); }
#pragma unroll 1
        for (int s = 0; s < 8; ++s) {
            f32x4_t sc[2];
#pragma unroll
            for (int tl = 0; tl < 2; ++tl) { sc[tl] = (f32x4_t){0.f, 0.f, 0.f, 0.f};
#pragma unroll
                for (int ks = 0; ks < 8; ++ks) sc[tl] = mfma16(Ab[tl * 8 + ks], Bq[ks], sc[tl]);
#pragma unroll
                for (int ks = 0; ks < 4; ++ks) *(LAS bf16x8*)(img + (16 * tl + fr) * ATA_ROW + 64 * ks + 16 * g) = Ab[tl * 8 + ks];
#pragma unroll
                for (int i = 0; i < 4; ++i) if (32 * s + 16 * tl + 4 * g + i >= nvalid) sc[tl][i] = -INFINITY; }
            if (s + 1 < 8) {
#pragma unroll
                for (int tl = 0; tl < 2; ++tl) { const int kx = ATA_SIDX(2 * (s + 1) + tl);
#pragma unroll
                    for (int ks = 0; ks < 8; ++ks) Ab[tl * 8 + ks] = *(const bf16x8*)(recb + (size_t)kx * 256 + 32 * ks + 8 * g); }
            }
            float mx = fmaxf(fmaxf(fmaxf(sc[0][0], sc[0][1]), fmaxf(sc[0][2], sc[0][3])), fmaxf(fmaxf(sc[1][0], sc[1][1]), fmaxf(sc[1][2], sc[1][3])));
            mx = fmaxf(mx, __shfl_xor(mx, 16)); mx = fmaxf(mx, __shfl_xor(mx, 32));
            const float mn = fmaxf(m, mx), alpha = exp2f(m - mn); m = mn;
            float ps = 0.f; unsigned pw[4];
            { const float a0 = exp2f(sc[0][0] - mn), a1 = exp2f(sc[0][1] - mn), a2 = exp2f(sc[0][2] - mn), a3 = exp2f(sc[0][3] - mn), b0 = exp2f(sc[1][0] - mn), b1 = exp2f(sc[1][1] - mn), b2 = exp2f(sc[1][2] - mn), b3 = exp2f(sc[1][3] - mn);
              ps = ((a0 + a1) + (a2 + a3)) + ((b0 + b1) + (b2 + b3));
              pw[0] = cvtpk(a0, a1); pw[1] = cvtpk(a2, a3); pw[2] = cvtpk(b0, b1); pw[3] = cvtpk(b2, b3); }
            l = l * alpha + ps;
            const v4u pwv = {pw[0], pw[1], pw[2], pw[3]}; const bf16x8 pf = __builtin_bit_cast(bf16x8, pwv);
#pragma unroll
            for (int mb = 0; mb < 8; ++mb) { const int ca = (16 * mb + 4 * p4) * 2; const bf16x8 av = cat8(lds_tr(img + (4 * g + q4) * ATA_ROW + ca), lds_tr(img + (16 + 4 * g + q4) * ATA_ROW + ca));
                O[mb] = O[mb] * alpha; O[mb] = mfma16(av, pf, O[mb]); }
        }
        l += __shfl_xor(l, 16); l += __shfl_xor(l, 32);
        const float inv = 1.0f / l;
        if (fr < 8) {
#pragma unroll
            for (int mb = 0; mb < 8; ++mb) { v2u o; o.x = pk2(O[mb][0] * inv, O[mb][1] * inv); o.y = pk2(O[mb][2] * inv, O[mb][3] * inv);
                *(v2u*)(ya + (size_t)q * 1024 + fr * 128 + 16 * mb + 4 * g) = o; }
        }
    }
}

constexpr int ATB_ST = 68, ATB_VROW = 160, ATB_VIMG_OFF = 256 * ATB_ST * 4, ATB_VIMG = 32 * ATB_VROW;
__device__ __forceinline__ void attb_phase(const bf16* pB, bf16* yb, LAS unsigned char* lds) {
    const int tid = otid(), lane = tid & 63, wv = __builtin_amdgcn_readfirstlane(tid >> 6), fr = lane & 15, g = lane >> 4, q4 = fr >> 2, p4 = fr & 3;
    LAS float* st = (LAS float*)lds;
    LAS unsigned char* vimg = lds + ATB_VIMG_OFF + wv * ATB_VIMG;
#pragma unroll 1
    for (int u = obid(); u < NB * 4 * 32; u += gridDim.x) {
        const int b = u >> 7, hs = (u >> 5) & 3, T0 = (u & 31) * 256;
        const bf16* pb = pB + (size_t)b * S * LPB;
#pragma unroll 1
        for (int grp = 0; grp < 3; ++grp) {
            const int sh = 2 * grp, d = 1 << sh, head = grp * 4 + hs;
            __syncthreads();
#pragma unroll 1
            for (int tt = 0; tt < 2; ++tt) {
                const int ti = wv * 2 + tt, r = ti & (d - 1), y0 = 16 * (ti >> sh);
                const int xq = r + d * (y0 + fr), tq = T0 + xq;
                bf16x8 Bq[2];
#pragma unroll
                for (int ks = 0; ks < 2; ++ks) Bq[ks] = *(const bf16x8*)(pb + (size_t)tq * LPB + head * 64 + 32 * ks + 8 * g);
                f32x4_t O[4];
#pragma unroll
                for (int mb = 0; mb < 4; ++mb) O[mb] = (f32x4_t){0.f, 0.f, 0.f, 0.f};
                float m = -INFINITY, l = 0.f;
                bf16x8 Ak[2][2]; v4u Vv[2][2];
#define ATB_LOAD(s_) do { _Pragma("unroll") for (int tl = 0; tl < 2; ++tl) { int tk = T0 + r + d * (y0 - 128 + 16 * (2 * (s_) + tl) + fr); tk = tk < 0 ? 0 : (tk > S - 1 ? S - 1 : tk); \
        const bf16* kr = pb + (size_t)tk * LPB + head * 64; \
        _Pragma("unroll") for (int ks = 0; ks < 2; ++ks) Ak[tl][ks] = *(const bf16x8*)(kr + 768 + 32 * ks + 8 * g); \
        _Pragma("unroll") for (int c2 = 0; c2 < 2; ++c2) Vv[tl][c2] = *(const v4u*)(kr + 1536 + 8 * (g + 4 * c2)); } } while (0)
                ATB_LOAD(0);
#pragma unroll 1
                for (int s = 0; s < 5; ++s) {
                    f32x4_t sc[2];
#pragma unroll
                    for (int tl = 0; tl < 2; ++tl) { sc[tl] = (f32x4_t){0.f, 0.f, 0.f, 0.f};
#pragma unroll
                        for (int ks = 0; ks < 2; ++ks) sc[tl] = mfma16(Ak[tl][ks], Bq[ks], sc[tl]);
#pragma unroll
                        for (int c2 = 0; c2 < 2; ++c2) *(LAS v4u*)(vimg + (16 * tl + fr) * ATB_VROW + 16 * (g + 4 * c2)) = Vv[tl][c2];
#pragma unroll
                        for (int i = 0; i < 4; ++i) { const int yk = y0 - 128 + 16 * (2 * s + tl) + 4 * g + i, j = (y0 + fr) - yk, tk = T0 + r + d * yk;
                            if (j < 0 || j > 128 || tk < 0) sc[tl][i] = -INFINITY; } }
                    if (s + 1 < 5) ATB_LOAD(s + 1);
                    float mx = fmaxf(fmaxf(fmaxf(sc[0][0], sc[0][1]), fmaxf(sc[0][2], sc[0][3])), fmaxf(fmaxf(sc[1][0], sc[1][1]), fmaxf(sc[1][2], sc[1][3])));
                    mx = fmaxf(mx, __shfl_xor(mx, 16)); mx = fmaxf(mx, __shfl_xor(mx, 32));
                    const float mn = fmaxf(m, mx), mref = (mn == -INFINITY) ? 0.f : mn, alpha = exp2f(m - mref); m = mn;
                    const float a0 = exp2f(sc[0][0] - mref), a1 = exp2f(sc[0][1] - mref), a2 = exp2f(sc[0][2] - mref), a3 = exp2f(sc[0][3] - mref), b0 = exp2f(sc[1][0] - mref), b1 = exp2f(sc[1][1] - mref), b2 = exp2f(sc[1][2] - mref), b3 = exp2f(sc[1][3] - mref);
                    l = l * alpha + (((a0 + a1) + (a2 + a3)) + ((b0 + b1) + (b2 + b3)));
                    const v4u pwv = {cvtpk(a0, a1), cvtpk(a2, a3), cvtpk(b0, b1), cvtpk(b2, b3)}; const bf16x8 pf = __builtin_bit_cast(bf16x8, pwv);
#pragma unroll
                    for (int mb = 0; mb < 4; ++mb) { const int ca = (16 * mb + 4 * p4) * 2; const bf16x8 av = cat8(lds_tr(vimg + (4 * g + q4) * ATB_VROW + ca), lds_tr(vimg + (16 + 4 * g + q4) * ATB_VROW + ca));
                        O[mb] = O[mb] * alpha; O[mb] = mfma16(av, pf, O[mb]); }
                }
#undef ATB_LOAD
                l += __shfl_xor(l, 16); l += __shfl_xor(l, 32);
                LAS float* sp = st + xq * ATB_ST;
                if (grp > 0) { const float ms = sp[64], ls = sp[65]; const float M = fmaxf(m, ms), a = exp2f(m - M), as = exp2f(ms - M);
#pragma unroll
                    for (int mb = 0; mb < 4; ++mb) { const f32x4_t os = *(const LAS f32x4_t*)(sp + 16 * mb + 4 * g); O[mb] = O[mb] * a + os * as; }
                    l = l * a + ls * as; m = M; }
                if (grp < 2) {
#pragma unroll
                    for (int mb = 0; mb < 4; ++mb) *(LAS f32x4_t*)(sp + 16 * mb + 4 * g) = O[mb];
                    if (g == 0) { sp[64] = m; sp[65] = l; }
                } else { const float inv = 1.0f / l;
#pragma unroll
                    for (int mb = 0; mb < 4; ++mb) { v2u o; o.x = pk2(O[mb][0] * inv, O[mb][1] * inv); o.y = pk2(O[mb][2] * inv, O[mb][3] * inv);
                        *(v2u*)(yb + ((size_t)b * S + tq) * 256 + hs * 64 + 16 * mb + 4 * g) = o; } }
            }
        }
    }
}
constexpr int NPH = 19;
constexpr int ARGS_OFF = MISC_OFF + 128;
struct CtxK {
    const Args& a;
    __device__ __forceinline__ const float* in(int i) const { return a.in[i]; }
    __device__ __forceinline__ float* out() const { return a.out; }
    __device__ __forceinline__ unsigned char* ws() const { return opaque_ptr(a.ws); }
};
__device__ __forceinline__ unsigned char* lds_ptr64(const LAS unsigned* p) {
    const unsigned lo = __builtin_amdgcn_readfirstlane(p[0]), hi = __builtin_amdgcn_readfirstlane(p[1]);
    return (unsigned char*)(GAS unsigned char*)(((unsigned long long)hi << 32) | lo);
}
struct CtxL {
    LAS unsigned char* lds;
    __device__ __forceinline__ const float* in(int i) const { return (const float*)lds_ptr64((const LAS unsigned*)(lds + ARGS_OFF) + 2 * i); }
    __device__ __forceinline__ float* out() const { return (float*)lds_ptr64((const LAS unsigned*)(lds + ARGS_OFF) + 48); }
    __device__ __forceinline__ unsigned char* ws() const { return lds_ptr64((const LAS unsigned*)(lds + ARGS_OFF) + 50); }
};
template <int K, class C> __device__ __forceinline__ void phase_body(const C& cx, int l, LAS unsigned char* lds) {
    unsigned char* wq_ = cx.ws(); bf16* W = (bf16*)(wq_ + WS_W); float* cs = (float*)(wq_ + WS_CS); bf16* XN = (bf16*)(wq_ + WS_XN); bf16* FB = (bf16*)(wq_ + WS_FB);
    unsigned short* SEL = (unsigned short*)(wq_ + WS_FB); bf16* REC = (bf16*)(wq_ + WS_FB + 8 * MiB); bf16* YB = (bf16*)(wq_ + WS_YB); bf16* YA = (bf16*)(wq_ + WS_YA); bf16* YC = (bf16*)(wq_ + WS_YC); bf16* BIG = (bf16*)(wq_ + WS_BIG);
    bf16* KVT = (bf16*)(wq_ + WS_FB + 16 * MiB); float* DEC = (float*)(wq_ + WS_DEC); (void)KVT; (void)DEC;
    (void)W; (void)cs; (void)XN; (void)FB; (void)SEL; (void)REC; (void)YB; (void)YA; (void)YC; (void)BIG;
    LAS float* scr = (LAS float*)lds; (void)scr;
    if constexpr (K == 0) { if (l == 0) { cs_phase((const int*)cx.in(I_POS), cs); resid_phase(cx.in(I_X), cx.out(), nullptr, 0.f, nullptr, cx.in(I_F1PRE) + l * D, XN);
                cvt_ffn(cx.in(I_F1WIN), cx.in(I_F1WOUT), W + WO_W1, W + WO_W2, scr); } }
    if constexpr (K == 1) { pg8::Gemm g{XN, W + WO_W1, T, 2 * DFF, D}; pg8::StaticOrder So; So.init(T, 2 * DFF, gridDim.x, obid()); pg8::EpiSwiglu E{BIG, DFF};
            pg8::gemm_phase<pg8::EpiSwiglu, pg8::StaticOrder, true, true>(lds, g, So, E); }
    if constexpr (K == 2) { pg8::Gemm g{BIG, W + WO_W2, T, D, DFF}; pg8::StaticOrder So; So.init(T, D, gridDim.x, obid()); pg8::EpiStore E{FB, D};
            pg8::gemm_phase<pg8::EpiStore, pg8::StaticOrder, true, true>(lds, g, So, E); }
    if constexpr (K == 3) { resid_phase(cx.out(), cx.out(), FB, 0.5f, cx.in(I_F1POST) + l * D, cx.in(I_MIXPRE) + l * D, XN); cvt_mixer(cx, l, W, scr); }
    if constexpr (K == 4) { pg8::Gemm g{XN, W + WO_BIG + (size_t)RB0 * D, T, NRB, D}; pg8::StaticOrder So; So.init(T, NRB, gridDim.x, obid());
            pg8::EpiProj<0> E{BIG, LPB, 1000, BIG, LPB, cs, nullptr};
            pg8::gemm_phase<pg8::EpiProj<0>, pg8::StaticOrder, true, true>(lds, g, So, E); }
    if constexpr (K == 5) { attb_phase(BIG, YB, lds); }
    if constexpr (K == 6) { pg8::Gemm g{XN, W + WO_BIG + (size_t)RAC0 * D, T, NRAC, D}; pg8::StaticOrder So; So.init(T, NRAC, gridDim.x, obid());
            pg8::EpiProj<1> E{YA, 1024, 4, BIG, LA2, cs, nullptr};
            pg8::gemm_phase<pg8::EpiProj<1>, pg8::StaticOrder, true, true>(lds, g, So, E); }
    if constexpr (K == 7) { rec_phase(BIG, cx.in(I_AKVG) + l * 128, cs, REC); gla_chunk_phase<1>(BIG, cx.in(I_CBAL) + l * 256, nullptr, KVT, DEC, YC, lds); }
    if constexpr (K == 8) { gla_scan_phase(KVT, DEC); }
    if constexpr (K == 9) { gla_chunk_phase<3>(BIG, cx.in(I_CBAL) + l * 256, cx.in(I_CNORM) + l * 128, KVT, DEC, YC, lds); }
    if constexpr (K == 10) { idx_phase(BIG, SEL, lds); }
    if constexpr (K == 11) { atta_phase(BIG, YA, REC, SEL, lds); }
    if constexpr (K == 12) { pg8::Gemm g{XN, W + WO_BIG + (size_t)RG0 * D, T, NRG, D}; pg8::StaticOrder So; So.init(T, NRG, gridDim.x, obid());
            pg8::EpiProj<2> E{BIG, 3072, 1000, BIG, 3072, cs, cx.in(I_BGATE) + l * 3072};
            pg8::gemm_phase<pg8::EpiProj<2>, pg8::StaticOrder, true, true>(lds, g, So, E); }
    if constexpr (K == 13) { pg8::StaticOrder So; So.init(T, D, gridDim.x, obid());
            { pg8::Gemm g{YA, W + WO_MA, T, D, 1024}; pg8::EpiMerge<true> E{XN, D, BIG, 3072, 0}; pg8::gemm_phase<pg8::EpiMerge<true>, pg8::StaticOrder, true, true>(lds, g, So, E); }
            VM_WAIT(); __syncthreads();
            { pg8::Gemm g{YB, W + WO_MB, T, D, 256}; pg8::EpiMerge<false> E{XN, D, BIG, 3072, 1024}; pg8::gemm_phase<pg8::EpiMerge<false>, pg8::StaticOrder, true, true>(lds, g, So, E); }
            VM_WAIT(); __syncthreads();
            { pg8::Gemm g{YC, W + WO_MC, T, D, 512}; pg8::EpiMerge<false> E{XN, D, BIG, 3072, 2048}; pg8::gemm_phase<pg8::EpiMerge<false>, pg8::StaticOrder, true, true>(lds, g, So, E); } }
    if constexpr (K == 14) { pg8::Gemm g{XN, W + WO_WO, T, D, D}; pg8::StaticOrder So; So.init(T, D, gridDim.x, obid()); pg8::EpiStore E{FB, D};
            pg8::gemm_phase<pg8::EpiStore, pg8::StaticOrder, true, true>(lds, g, So, E); }
    if constexpr (K == 15) { resid_phase(cx.out(), cx.out(), FB, 1.0f, cx.in(I_MIXPOST) + l * D, cx.in(I_F2PRE) + l * D, XN);
            cvt_ffn(cx.in(I_F2WIN) + (size_t)l * D * 2 * DFF, cx.in(I_F2WOUT) + (size_t)l * DFF * D, W + WO_W1, W + WO_W2, scr); }
    if constexpr (K == 16) { pg8::Gemm g{XN, W + WO_W1, T, 2 * DFF, D}; pg8::StaticOrder So; So.init(T, 2 * DFF, gridDim.x, obid()); pg8::EpiSwiglu E{BIG, DFF};
            pg8::gemm_phase<pg8::EpiSwiglu, pg8::StaticOrder, true, true>(lds, g, So, E); }
    if constexpr (K == 17) { pg8::Gemm g{BIG, W + WO_W2, T, D, DFF}; pg8::StaticOrder So; So.init(T, D, gridDim.x, obid()); pg8::EpiStore E{FB, D};
            pg8::gemm_phase<pg8::EpiStore, pg8::StaticOrder, true, true>(lds, g, So, E); }
    if constexpr (K == 18) { if (l + 1 < DEPTH) { resid_phase(cx.out(), cx.out(), FB, 0.5f, cx.in(I_F2POST) + l * D, cx.in(I_F1PRE) + (l + 1) * D, XN);
                cvt_ffn(cx.in(I_F1WIN) + (size_t)(l + 1) * D * 2 * DFF, cx.in(I_F1WOUT) + (size_t)(l + 1) * DFF * D, W + WO_W1, W + WO_W2, scr); }
            else resid_phase(cx.out(), cx.out(), FB, 0.5f, cx.in(I_F2POST) + l * D, nullptr, nullptr); }
}

__device__ __forceinline__ void zero_lds_ctl(LAS unsigned char* lds) {
    for (int u = threadIdx.x; u < (LDS_BYTES - MISC_OFF) / 4; u += NTHR) ((LAS unsigned*)(lds + MISC_OFF))[u] = 0u;
    __syncthreads();
}
template <int K> __global__ void __launch_bounds__(NTHR, 2) mk_fwd(Args args) {
    extern __shared__ __attribute__((aligned(16))) unsigned char lds_raw[];
    LAS unsigned char* lds = (LAS unsigned char*)lds_raw;
    zero_lds_ctl(lds);
    CtxK cx{args};
    phase_body<K, CtxK>(cx, args.l, lds);
}
#if MK_ONE_LAUNCH
#if MK_ONE_LAUNCH == 2
#define phase_call_inl(K, l) do { extern __shared__ __attribute__((aligned(16))) unsigned char lds_raw2[]; CtxK cxk{args}; phase_body<K, CtxK>(cxk, l, (LAS unsigned char*)lds_raw2); } while (0)
template <int K> __device__ __forceinline__ void phase_call(int l) {
#else
template <int K> __device__ __attribute__((noinline)) void phase_call(int l) {
#endif
    extern __shared__ __attribute__((aligned(16))) unsigned char lds_raw[];
    LAS unsigned char* lds = (LAS unsigned char*)lds_raw;
    l = __builtin_amdgcn_readfirstlane(l);
    CtxL cx{lds};
    phase_body<K, CtxL>(cx, l, lds);
}
__global__ void __launch_bounds__(NTHR, 2) mk_one(Args args) {
    extern __shared__ __attribute__((aligned(16))) unsigned char lds_raw[];
    LAS unsigned char* lds = (LAS unsigned char*)lds_raw;
    zero_lds_ctl(lds);
#if MK_ONE_LAUNCH == 1
    if (threadIdx.x == 0) { LAS unsigned long long* la = (LAS unsigned long long*)(lds + ARGS_OFF);
#pragma unroll
        for (int i = 0; i < 24; ++i) la[i] = (unsigned long long)args.in[i];
        la[24] = (unsigned long long)args.out; la[25] = (unsigned long long)args.ws; }
    __syncthreads();
#endif
    volatile LAS unsigned* MISC = (volatile LAS unsigned*)(lds + MISC_OFF);
    unsigned* ctl = (unsigned*)((unsigned char*)(GAS unsigned char*)args.ws + WS_CTL);
    XcdBarrier bar = xcd_barrier_post(ctl + CW_BAR, MISC + 8);
#ifndef MK_PHMASK
#define MK_PHMASK 0x7ffff
#endif
#if MK_ONE_LAUNCH == 2
#define PH(K) do { if ((MK_PHMASK >> K) & 1) { phase_call_inl(K, l); xcd_barrier(bar); } } while (0)
#else
#define PH(K) do { if ((MK_PHMASK >> K) & 1) { phase_call<K>(l); xcd_barrier(bar); } } while (0)
#endif
    { const int l = 0; PH(0); }
#pragma unroll 1
    for (int l = 0; l < DEPTH; ++l) {
        PH(1); PH(2); PH(3); PH(4); PH(5); PH(6); PH(7); PH(8); PH(9); PH(10); PH(11); PH(12); PH(13); PH(14); PH(15); PH(16); PH(17);
#if MK_ONE_LAUNCH == 2
        phase_call_inl(18, l);
#else
        phase_call<18>(l);
#endif
        if (l + 1 < DEPTH) xcd_barrier(bar);
    }
#undef PH
}
#endif

#define MK_PHASES(X) X(0) X(1) X(2) X(3) X(4) X(5) X(6) X(7) X(8) X(9) X(10) X(11) X(12) X(13) X(14) X(15) X(16) X(17) X(18)
#if !MK_ONE_LAUNCH
static void launch_phase(int k, int grid, hipStream_t stream, const Args& a) {
    switch (k) {
#define X(K) case K: hipLaunchKernelGGL(mk_fwd<K>, dim3(grid), dim3(NTHR), LDS_BYTES, stream, a); break;
        MK_PHASES(X)
#undef X
        default: break;
    }
}
#endif
static bool set_lds_attr() {
    bool ok = true;
#if MK_ONE_LAUNCH
    ok = ok && (hipFuncSetAttribute((const void*)mk_one, hipFuncAttributeMaxDynamicSharedMemorySize, LDS_BYTES) == hipSuccess);
#else
#define X(K) ok = ok && (hipFuncSetAttribute((const void*)mk_fwd<K>, hipFuncAttributeMaxDynamicSharedMemorySize, LDS_BYTES) == hipSuccess);
    MK_PHASES(X)
#undef X
#endif
    return ok;
}
extern "C" void kernel_launch(void* const* d_in, const int* in_sizes, int n_in, void* d_out, int out_size, void* d_ws, size_t ws_size, hipStream_t stream) {
    static int grid = 0;
    if (grid == 0) {
        if (n_in != 24 || out_size != T * D || ws_size < WS_END) { fprintf(stderr, "kernel_launch: unexpected shapes (n_in %d out %d ws %zu)\n", n_in, out_size, ws_size); grid = -1; return; }
        int dev = 0, cus = 0;
        if (hipGetDevice(&dev) != hipSuccess || hipDeviceGetAttribute(&cus, hipDeviceAttributeMultiprocessorCount, dev) != hipSuccess) { grid = -1; return; }
        if (!set_lds_attr()) { fprintf(stderr, "kernel_launch: hipFuncSetAttribute failed\n"); grid = -1; return; }
        int per_cu = 0;
#if MK_ONE_LAUNCH
        if (hipOccupancyMaxActiveBlocksPerMultiprocessor(&per_cu, (const void*)mk_one, NTHR, LDS_BYTES) != hipSuccess || per_cu < 1) { fprintf(stderr, "kernel_launch: occupancy query reports %d\n", per_cu); grid = -1; return; }
#endif
        (void)hipGetLastError();
        grid = cus;
    }
    if (grid < 0) return;
    (void)hipMemsetAsync((char*)d_ws + WS_CTL, 0, CTL_ZERO_BYTES, stream);
    Args a{};
    for (int i = 0; i < 24; ++i) a.in[i] = (const float*)d_in[i];
    a.out = (float*)d_out; a.ws = (unsigned char*)d_ws;
#if MK_ONE_LAUNCH
    hipLaunchKernelGGL(mk_one, dim3(grid), dim3(NTHR), LDS_BYTES, stream, a);
#else
    for (int p = 0; p < DEPTH * NPH; ++p) {
        const int k = p % NPH, l = p / NPH;
        if (k == 0 && l > 0) continue;
        a.l = l;
        launch_phase(k, grid, stream, a);
    }
#endif
}
```

```cpp
#define MK_ONE_LAUNCH 2
#include <hip/hip_runtime.h>
#include <cstdio>
#include <cstdint>
#define GAS __attribute__((address_space(1)))
#define LAS __attribute__((address_space(3)))
#ifndef MK_ONE_LAUNCH
#define MK_ONE_LAUNCH 0
#endif
namespace pg8 {
#define PG8_LAS __attribute__((address_space(3)))
typedef unsigned short bf16_t;
typedef short bf16x8 __attribute__((ext_vector_type(8)));
typedef float f32x4 __attribute__((ext_vector_type(4)));
typedef unsigned u32x4 __attribute__((ext_vector_type(4)));
constexpr int BM = 256, BK = 64, HALF = 128, HTB = HALF * BK * 2  , STAGE_BYTES = 8 * HTB, NXCD = 8, WGM = 8;

__host__ __device__ __forceinline__ int lds_byte(int r, int c) { const int st = (r >> 4) * 2 + (c >> 5), rr = r & 15, cc = c & 31, ob = rr * 64 + cc * 2; return st * 1024 + (ob ^ (((ob >> 9) & 1) << 5)); }
__host__ __device__ __forceinline__ void stage_rc(int b, int& R, int& C) { const int st = b / 1024, sb = b % 1024, swz = sb ^ (((sb >> 9) & 1) << 5); R = (st >> 1) * 16 + swz / 64; C = (st & 1) * 32 + (swz % 64) / 2; }
__host__ __device__ __forceinline__ int perm32(int rho) { const int n = rho >> 4, i = rho & 15; return 8 * (i >> 2) + 4 * n + (i & 3); }

struct Unit { int pm, pn; };
struct Gemm { const bf16_t* A; const bf16_t* Bt; int M, N, K; };

struct StaticOrder {
    int nM, nN, nwg, G, c;
    __host__ __device__ void init(int M, int N, int G_, int c_) { nM = M / BM; nN = N / BM; nwg = nM * nN; G = G_; c = c_; }
    __host__ __device__ bool next(int i, Unit& u) const {
        const long L = (long)i * G + c; if (L >= nwg) return false;
        int wgid = (int)L; { const int q = nwg / NXCD, r = nwg % NXCD, xcd = wgid % NXCD, off = wgid / NXCD; wgid = (xcd < r ? xcd * (q + 1) : r * (q + 1) + (xcd - r) * q) + off; }
        const int nig = WGM * nN, gid = wgid / nig, fm = gid * WGM, gsz = (nM - fm) < WGM ? (nM - fm) : WGM;
        u.pm = fm + ((wgid % nig) % gsz); u.pn = (wgid % nig) / gsz; return true;
    }
    __device__ __forceinline__ void a_ready(const Unit&) const {}
    __device__ __forceinline__ void done(const Unit&) const {}
};

typedef float f32x2_t_ __attribute__((ext_vector_type(2))); typedef __bf16 bf16x2_t_ __attribute__((ext_vector_type(2)));
__device__ __forceinline__ unsigned cvt_pk_bf16(float lo, float hi) { const f32x2_t_ v = {lo, hi}; const bf16x2_t_ b = __builtin_convertvector(v, bf16x2_t_); return __builtin_bit_cast(unsigned, b); }
typedef float f32x2 __attribute__((ext_vector_type(2)));
__device__ __forceinline__ float bflo(unsigned w) { return __uint_as_float(w << 16); }
__device__ __forceinline__ float bfhi(unsigned w) { return __uint_as_float(w & 0xffff0000u); }
__device__ __forceinline__ u32x4 pack8(const f32x4 a, const f32x4 b) { u32x4 w; w.x = cvt_pk_bf16(a[0], a[1]); w.y = cvt_pk_bf16(a[2], a[3]); w.z = cvt_pk_bf16(b[0], b[1]); w.w = cvt_pk_bf16(b[2], b[3]); return w; }
__device__ __forceinline__ float fast_sigmoid(float x) { return __builtin_amdgcn_rcpf(1.0f + __expf(-x)); }

struct EpiSwiglu {
    static constexpr bool PERM = true, AFTER_DRAIN = false;
    bf16_t* O; int ldc; const float* rs; const float* cm;
    __device__ __forceinline__ void operator()(const f32x4 (&acc)[2][2][4][2], const Unit& u, int wr, int wc, int fr, int fq) const {
        const int row0 = u.pm * BM + wr * 64 + fr, col0 = u.pn * HALF + wc * 32 + 8 * fq;
        f32x4 sg0 = (f32x4){1.f, 1.f, 1.f, 1.f}, sg1 = sg0, su0 = sg0, su1 = sg0;
        float srow[2][4];
#pragma unroll
        for (int ai = 0; ai < 2; ++ai)
#pragma unroll
            for (int m = 0; m < 4; ++m) srow[ai][m] = rs ? rs[row0 + ai * HALF + m * 16] : 1.0f;
        if (rs) { const float k = 1.0f / 127.0f; sg0 = *(const f32x4*)(cm + col0) * k; sg1 = *(const f32x4*)(cm + col0 + 4) * k; su0 = *(const f32x4*)(cm + ldc + col0) * k; su1 = *(const f32x4*)(cm + ldc + col0 + 4) * k; }
#pragma unroll
        for (int ai = 0; ai < 2; ++ai)
#pragma unroll
            for (int m = 0; m < 4; ++m) { bf16_t* rowp = O + (size_t)(row0 + ai * HALF + m * 16) * ldc + col0;
                const float sc = srow[ai][m];
                f32x4 o0, o1;
#pragma unroll
                for (int j = 0; j < 4; ++j) { const float g0 = acc[ai][0][m][0][j] * (sc * sg0[j]), g1 = acc[ai][0][m][1][j] * (sc * sg1[j]);
                    o0[j] = g0 * fast_sigmoid(g0) * (acc[ai][1][m][0][j] * (sc * su0[j])); o1[j] = g1 * fast_sigmoid(g1) * (acc[ai][1][m][1][j] * (sc * su1[j])); }
                *(u32x4*)rowp = pack8(o0, o1); asm volatile("" ::: "memory"); }
    }
};
struct EpiStore {
    static constexpr bool PERM = true, AFTER_DRAIN = false;
    bf16_t* O; int ldc;
    __device__ __forceinline__ void operator()(const f32x4 (&acc)[2][2][4][2], const Unit& u, int wr, int wc, int fr, int fq) const {
        const int row0 = u.pm * BM + wr * 64 + fr, col0 = u.pn * BM + wc * 32 + 8 * fq;
#pragma unroll
        for (int ai = 0; ai < 2; ++ai)
#pragma unroll
            for (int m = 0; m < 4; ++m) { bf16_t* rowp = O + (size_t)(row0 + ai * HALF + m * 16) * ldc + col0;
#pragma unroll
                for (int bj = 0; bj < 2; ++bj) *(u32x4*)(rowp + bj * HALF) = pack8(acc[ai][bj][m][0], acc[ai][bj][m][1]); }
    }
};
enum { PM_PLAIN = 0, PM_ROPE64 = 1, PM_ROPE16 = 2, PM_SIGMOID = 3 };
template <int RANGE> __device__ __forceinline__ int proj_mode(int gcol) {
    if (RANGE == 0) return gcol < 1536 ? PM_ROPE64 : PM_PLAIN;
    if (RANGE == 1) { if (gcol < 256) return PM_PLAIN; const int g2 = gcol - 256;
        return g2 < 128 ? PM_ROPE16 : (g2 < 704 ? PM_ROPE64 : PM_PLAIN); }
    return PM_SIGMOID;
}
template <int RANGE> struct EpiProj {
    static constexpr bool PERM = true, AFTER_DRAIN = false;
    bf16_t* d0; int ld0; int nt0; bf16_t* d1; int ld1; const float* cs; const float* bias; const float* rs; const float* wsc;
    __device__ __forceinline__ void operator()(const f32x4 (&acc)[2][2][4][2], const Unit& u, int wr, int wc, int fr, int fq) const {
        const int row0 = u.pm * BM + wr * 64 + fr;
        bf16_t* dbase; int ld;
        if (u.pn < nt0) { dbase = d0 + u.pn * BM; ld = ld0; } else { dbase = d1 + (u.pn - nt0) * BM; ld = ld1; }
        float srow[2][4];
#pragma unroll
        for (int ai = 0; ai < 2; ++ai)
#pragma unroll
            for (int m = 0; m < 4; ++m) srow[ai][m] = rs ? rs[row0 + ai * HALF + m * 16] : 1.0f;
        int mode[2]; bool rope[2], lane_rope[2]; f32x4 qa[2], qb[2], ba[2], bb[2];
#pragma unroll
        for (int bj = 0; bj < 2; ++bj) { const int gcol = u.pn * BM + bj * HALF + wc * 32;
            mode[bj] = proj_mode<RANGE>(gcol);
            rope[bj] = (mode[bj] == PM_ROPE16) || (mode[bj] == PM_ROPE64 && (wc & 1) == 0);
            lane_rope[bj] = (mode[bj] == PM_ROPE16) || (fq < 2);
            qa[bj] = (f32x4){1.f, 1.f, 1.f, 1.f}; qb[bj] = qa[bj]; ba[bj] = (f32x4){0.f, 0.f, 0.f, 0.f}; bb[bj] = ba[bj];
            if (rs) { qa[bj] = *(const f32x4*)(wsc + gcol + 8 * fq); qb[bj] = *(const f32x4*)(wsc + gcol + 8 * fq + 4); }
#ifndef MK_NOBIAS
            if (mode[bj] == PM_SIGMOID) { ba[bj] = *(const f32x4*)(bias + gcol + 8 * fq); bb[bj] = *(const f32x4*)(bias + gcol + 8 * fq + 4); }
#endif
        }
        const bool any_rope = rope[0] | rope[1];
        f32x4 cc[2][4];
        if (any_rope) {
#pragma unroll
            for (int k = 0; k < 4; ++k) cc[0][k] = *(const f32x4*)(cs + (size_t)row0 * 16 + 4 * k); }
        const float sg = (fq & 1) ? 1.0f : -1.0f;
#pragma unroll
        for (int gi = 0; gi < 8; ++gi) { const int ai = gi >> 2, m = gi & 3; const int r = row0 + ai * HALF + m * 16;
            if (any_rope && gi + 1 < 8) { const int rn = row0 + ((gi + 1) >> 2) * HALF + ((gi + 1) & 3) * 16;
#pragma unroll
                for (int k = 0; k < 4; ++k) cc[(gi + 1) & 1][k] = *(const f32x4*)(cs + (size_t)rn * 16 + 4 * k); }
#pragma unroll
            for (int bj = 0; bj < 2; ++bj) {
                f32x4 v0 = acc[ai][bj][m][0], v1 = acc[ai][bj][m][1];
                if (rs) { const float sr = srow[ai][m]; v0 = v0 * (qa[bj] * sr); v1 = v1 * (qb[bj] * sr); }
                if (rope[bj]) { const f32x4 c0 = cc[gi & 1][0], c1 = cc[gi & 1][1], s0 = cc[gi & 1][2], s1 = cc[gi & 1][3]; f32x4 p0, p1;
#pragma unroll
                    for (int j = 0; j < 4; ++j) { p0[j] = __shfl_xor(v0[j], 16); p1[j] = __shfl_xor(v1[j], 16); }
                    if (lane_rope[bj]) { v0 = v0 * c0 + sg * (p0 * s0); v1 = v1 * c1 + sg * (p1 * s1); } }
                if (mode[bj] == PM_SIGMOID) {
#pragma unroll
                    for (int j = 0; j < 4; ++j) { v0[j] = fast_sigmoid(v0[j] + ba[bj][j]); v1[j] = fast_sigmoid(v1[j] + bb[bj][j]); } }
                *(u32x4*)(dbase + (size_t)r * ld + bj * HALF + wc * 32 + 8 * fq) = pack8(v0, v1); }
            asm volatile("" ::: "memory"); }
    }
};
template <bool FIRST> struct EpiMerge {
    static constexpr bool PERM = true, AFTER_DRAIN = false;
    bf16_t* O; int ldc; const bf16_t* G; int ldg; int gcol; const float* rs; const float* wsc;
    __device__ __forceinline__ void operator()(const f32x4 (&acc)[2][2][4][2], const Unit& u, int wr, int wc, int fr, int fq) const {
        const int row0 = u.pm * BM + wr * 64 + fr, col0 = u.pn * BM + wc * 32 + 8 * fq;
        float srow[2][4]; f32x4 qa[2], qb[2];
#pragma unroll
        for (int ai = 0; ai < 2; ++ai)
#pragma unroll
            for (int m = 0; m < 4; ++m) srow[ai][m] = rs ? rs[row0 + ai * HALF + m * 16] : 1.0f;
#pragma unroll
        for (int bj = 0; bj < 2; ++bj) { qa[bj] = (f32x4){1.f, 1.f, 1.f, 1.f}; qb[bj] = qa[bj]; if (rs) { qa[bj] = *(const f32x4*)(wsc + col0 + bj * HALF); qb[bj] = *(const f32x4*)(wsc + col0 + bj * HALF + 4); } }
        u32x4 gq[2], pq[2];
        gq[0] = *(const u32x4*)(G + (size_t)row0 * ldg + gcol + col0);
        if (!FIRST) pq[0] = *(const u32x4*)(O + (size_t)row0 * ldc + col0);
#pragma unroll
        for (int i = 0; i < 16; ++i) { const int ai = i >> 3, m = (i >> 1) & 3, bj = i & 1; const int r = row0 + ai * HALF + m * 16;
            if (i + 1 < 16) { const int an = (i + 1) >> 3, mn = ((i + 1) >> 1) & 3, bn = (i + 1) & 1; const int rn = row0 + an * HALF + mn * 16;
                gq[(i + 1) & 1] = *(const u32x4*)(G + (size_t)rn * ldg + gcol + col0 + bn * HALF);
                if (!FIRST) pq[(i + 1) & 1] = *(const u32x4*)(O + (size_t)rn * ldc + col0 + bn * HALF); }
            const u32x4 g = gq[i & 1];
            f32x4 a0 = acc[ai][bj][m][0], a1 = acc[ai][bj][m][1];
            if (rs) { a0 = a0 * (qa[bj] * srow[ai][m]); a1 = a1 * (qb[bj] * srow[ai][m]); }
            f32x4 o0, o1;
            o0[0] = bflo(g.x) * a0[0]; o0[1] = bfhi(g.x) * a0[1]; o0[2] = bflo(g.y) * a0[2]; o0[3] = bfhi(g.y) * a0[3];
            o1[0] = bflo(g.z) * a1[0]; o1[1] = bfhi(g.z) * a1[1]; o1[2] = bflo(g.w) * a1[2]; o1[3] = bfhi(g.w) * a1[3];
            bf16_t* op = O + (size_t)r * ldc + col0 + bj * HALF;
            if (!FIRST) { const u32x4 p = pq[i & 1];
                o0[0] += bflo(p.x); o0[1] += bfhi(p.x); o0[2] += bflo(p.y); o0[3] += bfhi(p.y); o1[0] += bflo(p.z); o1[1] += bfhi(p.z); o1[2] += bflo(p.w); o1[3] += bfhi(p.w); }
            *(u32x4*)op = pack8(o0, o1); asm volatile("" ::: "memory"); }
    }
};

typedef int i32x4 __attribute__((ext_vector_type(4)));
template <bool I8> __device__ __forceinline__ f32x4 mma_step(bf16x8 a, bf16x8 b, f32x4 c) {
    if constexpr (I8) return __builtin_bit_cast(f32x4, __builtin_amdgcn_mfma_i32_16x16x64_i8(__builtin_bit_cast(i32x4, a), __builtin_bit_cast(i32x4, b), __builtin_bit_cast(i32x4, c), 0, 0, 0));
    else return __builtin_amdgcn_mfma_f32_16x16x32_bf16(a, b, c, 0, 0, 0);
}
template <class Epi, class Sched, bool ALIGN_EPI = false, bool SP2 = false, bool I8 = false>
__device__ __forceinline__ void gemm_phase(PG8_LAS unsigned char* lds, const Gemm g, const Sched& S, const Epi& E) {
    int tid_o = threadIdx.x; asm volatile("" : "+v"(tid_o));
    const int tid = tid_o, wid = __builtin_amdgcn_readfirstlane(tid >> 6), lane = tid & 63, wr = wid >> 2, wc = wid & 3, fr = lane & 15, fq = lane >> 4;
    const int K = g.K, nt = K / BK;
    unsigned voffA[2], voffB[2];
#pragma unroll
    for (int i = 0; i < 2; ++i) { int R, C; stage_rc(tid * 16 + i * 8192, R, C); const int Rb = Epi::PERM ? ((R & ~31) + perm32(R & 31)) : R;
        voffA[i] = (unsigned)(R * K + C) * 2u; voffB[i] = (unsigned)(Rb * K + C) * 2u; }
    const size_t kstep = (size_t)(BK * 2);
    const size_t hstep = (size_t)HALF * K * 2;
    const size_t tstep = 2 * hstep;
    const unsigned ldsw = (unsigned)wid * 1024u;
    const int aoff = lds_byte(wr * 64 + fr, fq * 8), boff = lds_byte(wc * 32 + fr, fq * 8);
#define PG8_SA(b, h) (((b) * 2 + (h)) * HTB)
#define PG8_SB(b, h) ((4 + (b) * 2 + (h)) * HTB)
#define PG8_STAGE(bufoff, gbase, voff) do { _Pragma("unroll") for (int _i = 0; _i < 2; ++_i) \
        __builtin_amdgcn_global_load_lds((const unsigned*)((const char*)(gbase) + (voff)[_i]), (PG8_LAS unsigned*)(lds + (bufoff) + ldsw + _i * 8192), 16, 0, 0); } while (0)
#define PG8_LDA(dst, b, h) do { _Pragma("unroll") for (int m = 0; m < 4; ++m) _Pragma("unroll") for (int k = 0; k < 2; ++k) dst[m][k] = *(const PG8_LAS bf16x8*)(lds + PG8_SA(b, h) + aoff + m * 2048 + k * 1024); } while (0)
#define PG8_LDB(dst, b, h) do { _Pragma("unroll") for (int n = 0; n < 2; ++n) _Pragma("unroll") for (int k = 0; k < 2; ++k) dst[n][k] = *(const PG8_LAS bf16x8*)(lds + PG8_SB(b, h) + boff + n * 2048 + k * 1024); } while (0)
#define PG8_MMA(ai, bj, At, Bt) do { __builtin_amdgcn_s_setprio(1); _Pragma("unroll") for (int m = 0; m < 4; ++m) _Pragma("unroll") for (int n = 0; n < 2; ++n) _Pragma("unroll") for (int k = 0; k < 2; ++k) \
        acc[ai][bj][m][n] = mma_step<I8>(Bt[n][k], At[m][k], acc[ai][bj][m][n]); __builtin_amdgcn_s_setprio(0); } while (0)
#define PG8_WAIT_V(n) asm volatile("s_waitcnt vmcnt(" #n ")" ::: "memory")
#define PG8_WAIT_L(n) asm volatile("s_waitcnt lgkmcnt(" #n ")" ::: "memory")
#define PG8_BAR __builtin_amdgcn_s_barrier()
#define PG8_SCHED __builtin_amdgcn_sched_barrier(0)
    Unit cur, nxt; int ui = 0;
    if (!S.next(0, cur)) return;
    f32x4 acc[2][2][4][2];
#pragma unroll
    for (int a = 0; a < 2; ++a)
#pragma unroll
        for (int b = 0; b < 2; ++b)
#pragma unroll
            for (int m = 0; m < 4; ++m)
#pragma unroll
                for (int n = 0; n < 2; ++n) acc[a][b][m][n] = (f32x4){0.f, 0.f, 0.f, 0.f};
    bf16x8 At[4][2], B0[2][2], B1[2][2];
    const char* cA = (const char*)g.A + (size_t)cur.pm * tstep; const char* cB = (const char*)g.Bt + (size_t)cur.pn * tstep;
    S.a_ready(cur);
    if constexpr (SP2) {
        PG8_STAGE(PG8_SB(0, 0), cB, voffB); PG8_STAGE(PG8_SB(0, 1), cB + hstep, voffB); PG8_STAGE(PG8_SA(0, 0), cA, voffA); PG8_STAGE(PG8_SA(0, 1), cA + hstep, voffA);
        if (wr == 1) PG8_BAR;
        PG8_WAIT_V(2); PG8_BAR;
        PG8_STAGE(PG8_SB(1, 0), cB + kstep, voffB); PG8_STAGE(PG8_SA(1, 0), cA + kstep, voffA); PG8_STAGE(PG8_SB(1, 1), cB + hstep + kstep, voffB);
        PG8_WAIT_V(6); PG8_BAR;
    } else {
        PG8_STAGE(PG8_SB(0, 0), cB, voffB); PG8_STAGE(PG8_SA(0, 0), cA, voffA); PG8_STAGE(PG8_SB(0, 1), cB + hstep, voffB); PG8_STAGE(PG8_SA(0, 1), cA + hstep, voffA);
        if (wr == 1) PG8_BAR;
        PG8_WAIT_V(4); PG8_BAR;
        PG8_STAGE(PG8_SB(1, 0), cB + kstep, voffB); PG8_STAGE(PG8_SA(1, 0), cA + kstep, voffA); PG8_STAGE(PG8_SB(1, 1), cB + hstep + kstep, voffB);
        PG8_WAIT_V(6); PG8_BAR;
    }
    for (;;) {
        const bool has_next = S.next(ui + 1, nxt);
        const char* nA = has_next ? (const char*)g.A + (size_t)nxt.pm * tstep : cA; const char* nB = has_next ? (const char*)g.Bt + (size_t)nxt.pn * tstep : cB;
        for (int t = 0; t < nt; t += 2) {
            const bool last = (t == nt - 2);
            const char* a1 = cA + (size_t)(t + 1) * kstep;
            const char* a2 = last ? nA : cA + (size_t)(t + 2) * kstep; const char* b2 = last ? nB : cB + (size_t)(t + 2) * kstep;
            const char* a3 = a2 + kstep; const char* b3 = b2 + kstep;
            if (last && has_next) S.a_ready(nxt);
            if constexpr (SP2) {
            PG8_LDB(B0, 0, 0); PG8_LDB(B1, 0, 1); PG8_SCHED; PG8_LDA(At, 0, 0); PG8_STAGE(PG8_SA(1, 1), a1 + hstep, voffA);
            PG8_WAIT_V(8); PG8_WAIT_L(0); PG8_BAR; PG8_MMA(0, 0, At, B0); PG8_MMA(0, 1, At, B1); PG8_BAR; PG8_SCHED;
            PG8_LDA(At, 0, 1); PG8_STAGE(PG8_SB(0, 0), b2, voffB); PG8_STAGE(PG8_SB(0, 1), b2 + hstep, voffB); PG8_STAGE(PG8_SA(0, 0), a2, voffA);
            PG8_WAIT_V(8); PG8_WAIT_L(0); PG8_BAR; PG8_MMA(1, 0, At, B0); PG8_MMA(1, 1, At, B1); PG8_BAR; PG8_SCHED;
            PG8_LDB(B0, 1, 0); PG8_LDB(B1, 1, 1); PG8_SCHED; PG8_LDA(At, 1, 0); PG8_STAGE(PG8_SA(0, 1), a2 + hstep, voffA);
            PG8_WAIT_V(8); PG8_WAIT_L(0); PG8_BAR; PG8_MMA(0, 0, At, B0); PG8_MMA(0, 1, At, B1); PG8_BAR; PG8_SCHED;
            PG8_LDA(At, 1, 1); PG8_STAGE(PG8_SB(1, 0), b3, voffB); PG8_STAGE(PG8_SB(1, 1), b3 + hstep, voffB); PG8_STAGE(PG8_SA(1, 0), a3, voffA);
            PG8_WAIT_V(8); PG8_WAIT_L(0); PG8_BAR; PG8_MMA(1, 0, At, B0); PG8_MMA(1, 1, At, B1); PG8_BAR; PG8_SCHED;
            } else {
            PG8_LDB(B0, 0, 0); PG8_SCHED; PG8_LDA(At, 0, 0); PG8_STAGE(PG8_SA(1, 1), a1 + hstep, voffA);
            PG8_WAIT_L(8); PG8_BAR; PG8_WAIT_L(0); PG8_MMA(0, 0, At, B0); PG8_BAR; PG8_SCHED;
            PG8_LDB(B1, 0, 1); PG8_STAGE(PG8_SB(0, 0), b2, voffB);
            PG8_BAR; PG8_WAIT_L(0); PG8_MMA(0, 1, At, B1); PG8_BAR;
            PG8_LDA(At, 0, 1); PG8_STAGE(PG8_SA(0, 0), a2, voffA);
            PG8_BAR; PG8_WAIT_L(0); PG8_MMA(1, 0, At, B0); PG8_BAR; PG8_SCHED;
            PG8_STAGE(PG8_SB(0, 1), b2 + hstep, voffB);
            PG8_WAIT_V(6); PG8_BAR; PG8_MMA(1, 1, At, B1); PG8_BAR;
            PG8_LDB(B0, 1, 0); PG8_SCHED; PG8_LDA(At, 1, 0); PG8_STAGE(PG8_SA(0, 1), a2 + hstep, voffA);
            PG8_WAIT_L(8); PG8_BAR; PG8_WAIT_L(0); PG8_MMA(0, 0, At, B0); PG8_BAR; PG8_SCHED;
            PG8_LDB(B1, 1, 1); PG8_STAGE(PG8_SB(1, 0), b3, voffB);
            PG8_BAR; PG8_WAIT_L(0); PG8_MMA(0, 1, At, B1); PG8_BAR;
            PG8_LDA(At, 1, 1); PG8_STAGE(PG8_SA(1, 0), a3, voffA);
            PG8_BAR; PG8_WAIT_L(0); PG8_MMA(1, 0, At, B0); PG8_BAR; PG8_SCHED;
            PG8_STAGE(PG8_SB(1, 1), b3 + hstep, voffB);
            PG8_WAIT_V(6); PG8_BAR; PG8_MMA(1, 1, At, B1); PG8_BAR;
            }
        }
        if constexpr (ALIGN_EPI) { if (wr == 0) PG8_BAR; }
        if constexpr (I8) {
#pragma unroll
            for (int a = 0; a < 2; ++a)
#pragma unroll
                for (int b = 0; b < 2; ++b)
#pragma unroll
                    for (int m = 0; m < 4; ++m)
#pragma unroll
                        for (int n = 0; n < 2; ++n) acc[a][b][m][n] = __builtin_convertvector(__builtin_bit_cast(i32x4, acc[a][b][m][n]), f32x4); }
        if constexpr (!Epi::AFTER_DRAIN) { E(acc, cur, wr, wc, fr, fq); S.done(cur); }
        if (!has_next) break;
#pragma unroll
        for (int a = 0; a < 2; ++a)
#pragma unroll
            for (int b = 0; b < 2; ++b)
#pragma unroll
                for (int m = 0; m < 4; ++m)
#pragma unroll
                    for (int n = 0; n < 2; ++n) acc[a][b][m][n] = (f32x4){0.f, 0.f, 0.f, 0.f};
        cur = nxt; cA = nA; cB = nB; ++ui;
        if constexpr (ALIGN_EPI) { if (wr == 1) PG8_BAR; }
    }
    PG8_WAIT_V(0);
    if constexpr (!ALIGN_EPI) { if (wr == 0) PG8_BAR; }
    PG8_BAR;
    if constexpr (Epi::AFTER_DRAIN) { E.fused(acc, cur, wr, wc, fr, fq, lds, wid, lane); S.done(cur); }
#undef PG8_SA
#undef PG8_SB
#undef PG8_STAGE
#undef PG8_LDA
#undef PG8_LDB
#undef PG8_MMA
#undef PG8_WAIT_V
#undef PG8_WAIT_L
#undef PG8_BAR
#undef PG8_SCHED
}
}
#define XB_TMO      128
#define XB_XCNT(j)  (256  + 64 * (j))
#define XB_XSUB(j)  (1280 + 64 * (j))
#define XB_XGEN(j)  (2304 + 64 * (j))
#define XB_TOP      3328
#define XB_TOPGEN   3392
#define XCD_BAR_WORDS 3456
#define XB_SPIN_CAP (1u << 18)

__device__ __forceinline__ unsigned xb_ld(unsigned* p)              { return __hip_atomic_load(p, __ATOMIC_RELAXED, __HIP_MEMORY_SCOPE_AGENT); }
__device__ __forceinline__ unsigned xb_add(unsigned* p, unsigned v) { return __hip_atomic_fetch_add(p, v, __ATOMIC_RELAXED, __HIP_MEMORY_SCOPE_AGENT); }
__device__ __forceinline__ unsigned xb_xcc_id() { return (unsigned)__builtin_amdgcn_s_getreg((3 << 11) | 20) & 0xFu; }
#define XB_SPIN(cond, bar) do { unsigned _sp = 0; while (cond) { __builtin_amdgcn_s_sleep(1); \
    if ((++_sp & 255u) == 0u) { if (xb_ld(&(bar)[XB_TMO])) break; if (_sp > XB_SPIN_CAP) { atomicAdd(&(bar)[XB_TMO], 1u); break; } } } } while (0)

struct XcdBarrier {
    unsigned* bar; unsigned x;
    volatile LAS unsigned* st;
};

__device__ __forceinline__ XcdBarrier xcd_barrier_post(unsigned* bar, volatile LAS unsigned* st) {
    XcdBarrier b; b.bar = bar; b.x = xb_xcc_id(); b.st = st;
    if (threadIdx.x == 0) (void)xb_add(&bar[XB_XCNT(b.x)], 1u);
    return b;
}
__device__ __forceinline__ void xcd_barrier_complete(unsigned* bar, unsigned x, unsigned& nloc, unsigned& nx) {
    const unsigned G = gridDim.x * gridDim.y * gridDim.z;
    unsigned sum, cnt, mine, sp = 0u;
    for (;;) {
        sum = 0u; cnt = 0u; mine = 0u;
#pragma unroll
        for (unsigned j = 0; j < 16; ++j) { const unsigned c = xb_ld(&bar[XB_XCNT(j)]); sum += c; cnt += (c > 0u) ? 1u : 0u; mine = (j == x) ? c : mine; }
        if (sum == G) break;
        __builtin_amdgcn_s_sleep(1);
        if ((++sp & 255u) == 0u) { if (xb_ld(&bar[XB_TMO])) break; if (sp > XB_SPIN_CAP) { atomicAdd(&bar[XB_TMO], 1u); break; } }
    }
    nloc = mine > 0u ? mine : 1u; nx = cnt > 0u ? cnt : 1u;
}

__device__ __forceinline__ void xcd_barrier(const XcdBarrier& b) {
    asm volatile("s_waitcnt vmcnt(0)" ::: "memory");
    __syncthreads();
    if (threadIdx.x == 0) {
        unsigned* bar = b.bar;
        __builtin_amdgcn_s_waitcnt(0);
        unsigned nloc = b.st[0], nx = b.st[1];
        if (nloc == 0u) { xcd_barrier_complete(bar, b.x, nloc, nx); b.st[0] = nloc; b.st[1] = nx; }
        const unsigned old = xb_add(&bar[XB_XSUB(b.x)], 1u);
        const unsigned gen = old / nloc;
        if (old + 1u == (gen + 1u) * nloc) {
            __builtin_amdgcn_fence(__ATOMIC_RELEASE, "agent");
            asm volatile("s_waitcnt vmcnt(0)" ::: "memory");
            const unsigned og = xb_add(&bar[XB_TOP], 1u);
            const unsigned tg = og / nx;
            if (og + 1u == (tg + 1u) * nx) xb_add(&bar[XB_TOPGEN], 1u);
            else XB_SPIN(xb_ld(&bar[XB_TOPGEN]) == tg, bar);
            __builtin_amdgcn_fence(__ATOMIC_ACQUIRE, "agent");
            xb_add(&bar[XB_XGEN(b.x)], 1u);
            asm volatile("s_waitcnt vmcnt(0)" ::: "memory");
        } else {
            XB_SPIN(xb_ld(&bar[XB_XGEN(b.x)]) == gen, bar);
            __builtin_amdgcn_fence(__ATOMIC_ACQUIRE, "agent");
            asm volatile("s_waitcnt vmcnt(0)" ::: "memory");
        }
    }
    __syncthreads();
}
typedef unsigned short bf16;
typedef unsigned v4u __attribute__((ext_vector_type(4)));
typedef unsigned v2u __attribute__((ext_vector_type(2)));
typedef float f32x4 __attribute__((ext_vector_type(4)));
typedef short bf16x8 __attribute__((ext_vector_type(8)));
constexpr int NB = 2, S = 8192, T = NB * S, D = 1024, DEPTH = 2, DFF = 2816, DIN = 5080;
constexpr int NWAVES = 8, NTHR = 512;
#ifndef MK_FAKEQ
#define MK_FAKEQ 0
#endif
constexpr float RMS_EPS = 1e-6f;
constexpr int WI_AQ = 0, WI_CKV = 512, WI_IQ = 640, WI_IK = 1152, WI_IW = 1216, WI_BQKV = 1224, WI_CQ = 3528, WI_CK = 3784, WI_CV = 4040, WI_CG = 4552, WI_CA = 5064;
constexpr int NBIG = 9216, RB0 = 0, NRB = 3072, RAC0 = 3072, NRAC = 3072, RG0 = 6144, NRG = 3072;
constexpr int LA2 = 2816, A2_QR = 0, A2_IQ = 128, A2_IK = 640, A2_IW = 704, A2_CKV = 768, A2_KR = 896, A2_CQ = 1024, A2_CK = 1280, A2_CV = 1536, A2_CG = 2048, A2_CAL = 2560;
constexpr int LPB = 2304;
constexpr float QSCALE = 0.18033688011112042f;

constexpr size_t MiB = 1u << 20;
constexpr size_t WS_CTL = 0, CTL_ZERO_BYTES = 1 * MiB;
constexpr size_t WS_W = 1 * MiB;
constexpr size_t WS_CS = 25 * MiB;
constexpr size_t WS_XN = 26 * MiB;
constexpr size_t WS_FB = 58 * MiB;
constexpr size_t WS_YB = 90 * MiB;
constexpr size_t WS_YA = 98 * MiB;
constexpr size_t WS_YC = 130 * MiB;
constexpr size_t WS_BIG = 146 * MiB;
constexpr size_t WS_DEC = 242 * MiB;
constexpr size_t WS_MW = 243 * MiB;
constexpr size_t WS_END = 253 * MiB;
constexpr int NMW = 2432;
constexpr size_t WS_YA8 = 130 * MiB;
constexpr int CW_MWMAX = 8192;
constexpr size_t WO_W1 = 0, WO_W2 = (size_t)2 * DFF * D;
constexpr size_t WO_BIG = 0, WO_MA = (size_t)NBIG * D, WO_MB = WO_MA + (size_t)D * 1024, WO_MC = WO_MB + (size_t)D * 256, WO_WO = WO_MC + (size_t)D * 512;
static_assert((WO_WO + (size_t)D * D) * 2 <= 24 * MiB && (WO_W2 + (size_t)D * DFF) * 2 <= 24 * MiB, "weights region");
constexpr int CW_BAR = 4096;

constexpr int RING_BYTES = 131072, LDS_BYTES = 163840, MISC_OFF = LDS_BYTES - 1024;

#define RLX_AGENT __ATOMIC_RELAXED, __HIP_MEMORY_SCOPE_AGENT
#define LDS_WAIT() asm volatile("s_waitcnt lgkmcnt(0)" ::: "memory")
#define VM_WAIT() asm volatile("s_waitcnt vmcnt(0)" ::: "memory")
__device__ __forceinline__ unsigned char* opaque_ptr(unsigned char* p) { GAS unsigned char* g = (GAS unsigned char*)p; asm volatile("" : "+s"(g)); return (unsigned char*)g; }
__device__ __forceinline__ int otid() { int t = threadIdx.x; asm volatile("" : "+v"(t)); return t; }
__device__ __forceinline__ int obid() { int b = blockIdx.x; asm volatile("" : "+s"(b)); return b; }
__device__ __forceinline__ unsigned f2bf(float f) { unsigned u = __builtin_bit_cast(unsigned, f); return (u + 0x7fffu + ((u >> 16) & 1u)) >> 16; }
__device__ __forceinline__ unsigned pk2(float lo, float hi) { return f2bf(lo) | (f2bf(hi) << 16); }
__device__ __forceinline__ float bf2f(bf16 v) { return __uint_as_float((unsigned)v << 16); }
__device__ __forceinline__ float blo(unsigned w) { return __uint_as_float(w << 16); }
__device__ __forceinline__ float bhi(unsigned w) { return __uint_as_float(w & 0xffff0000u); }
__device__ __forceinline__ float wave_sum(float v) {
#pragma unroll
    for (int o = 1; o < 64; o <<= 1) v += __shfl_xor(v, o);
    return v;
}
__device__ __forceinline__ float wave_max(float v) {
#pragma unroll
    for (int o = 1; o < 64; o <<= 1) v = fmaxf(v, __shfl_xor(v, o));
    return v;
}

struct Args {
    const float* in[24]; float* out; unsigned char* ws; int l, pad;
};
enum { I_X = 0, I_POS, I_F1PRE, I_F1WIN, I_F1WOUT, I_F1POST, I_MIXPRE, I_WIN, I_AKVG, I_AWKV, I_CWAL, I_CBAL, I_CNORM, I_WBA, I_WBB, I_WBC, I_WGATE, I_BGATE, I_WOUT, I_MIXPOST, I_F2PRE, I_F2WIN, I_F2WOUT, I_F2POST };

constexpr int CVT_WSCR = 64 * 65;
__device__ __forceinline__ void cvt_tile(const float* src, int ld, int col0, int ncols, int k0, bf16* dst, int K, int drow0, float scale, bool zfill, LAS float* scr, int lane) {
    const int c4 = 4 * (lane & 15), kr = lane >> 4;
    f32x4 v[16];
#pragma unroll
    for (int i = 0; i < 16; ++i) v[i] = (c4 < ncols) ? *(const f32x4*)(src + (size_t)(k0 + 4 * i + kr) * ld + col0 + c4) : (f32x4){0.f, 0.f, 0.f, 0.f};
    asm volatile("" ::: "memory");
#pragma unroll
    for (int i = 0; i < 16; ++i) { LAS float* p = scr + (4 * i + kr) * 65 + c4; p[0] = v[i][0] * scale; p[1] = v[i][1] * scale; p[2] = v[i][2] * scale; p[3] = v[i][3] * scale; }
    asm volatile("" ::: "memory");
    const int n8 = lane >> 3, c = lane & 7;
#pragma unroll
    for (int p = 0; p < 8; ++p) { const int n = 8 * p + n8; const LAS float* s = scr + (8 * c) * 65 + n;
        v4u o; o.x = pk2(s[0], s[65]); o.y = pk2(s[2 * 65], s[3 * 65]); o.z = pk2(s[4 * 65], s[5 * 65]); o.w = pk2(s[6 * 65], s[7 * 65]);
        if (n < ncols || zfill) *(v4u*)(dst + (size_t)(drow0 + n) * K + k0 + 8 * c) = o; }
    asm volatile("" ::: "memory");
}
__device__ __forceinline__ void cvt_tile8(const float* src, int ld, int col0, int ncols, int k0, signed char* dst, int K, int drow0, const float* cmax, bool zfill, float sfac, float* wsc, LAS float* scr, int lane) {
    const int c4 = 4 * (lane & 15), kr = lane >> 4;
    f32x4 v[16], sc4 = (f32x4){0.f, 0.f, 0.f, 0.f};
    if (c4 < ncols) { const f32x4 cm = *(const f32x4*)(cmax + col0 + c4);
#pragma unroll
        for (int j = 0; j < 4; ++j) sc4[j] = cm[j] > 0.f ? 127.0f / cm[j] : 0.f; }
    if (wsc && k0 == 0 && (lane < ncols || zfill)) wsc[drow0 + lane] = (lane < ncols) ? sfac * cmax[col0 + lane] * (1.0f / 127.0f) : 0.f;
#pragma unroll
    for (int i = 0; i < 16; ++i) v[i] = (c4 < ncols) ? *(const f32x4*)(src + (size_t)(k0 + 4 * i + kr) * ld + col0 + c4) : (f32x4){0.f, 0.f, 0.f, 0.f};
    asm volatile("" ::: "memory");
#pragma unroll
    for (int i = 0; i < 16; ++i) { LAS float* p = scr + (4 * i + kr) * 65 + c4; p[0] = v[i][0] * sc4[0]; p[1] = v[i][1] * sc4[1]; p[2] = v[i][2] * sc4[2]; p[3] = v[i][3] * sc4[3]; }
    asm volatile("" ::: "memory");
    const int n8 = lane >> 3, c = lane & 7;
#pragma unroll
    for (int p = 0; p < 8; ++p) { const int n = 8 * p + n8; const LAS float* s = scr + (8 * c) * 65 + n;
        unsigned w0 = 0u, w1 = 0u;
#pragma unroll
        for (int j = 0; j < 4; ++j) { const int a = __float2int_rn(s[j * 65]), b = __float2int_rn(s[(4 + j) * 65]);
            w0 |= (unsigned)((a < -127 ? -127 : (a > 127 ? 127 : a)) & 0xff) << (8 * j); w1 |= (unsigned)((b < -127 ? -127 : (b > 127 ? 127 : b)) & 0xff) << (8 * j); }
        if (n < ncols || zfill) { v2u o; o.x = w0; o.y = w1; *(v2u*)(dst + (size_t)(drow0 + n) * K + k0 + 8 * c) = o; } }
    asm volatile("" ::: "memory");
}
__device__ __forceinline__ void cvt_block8(const float* src, int ld, int col0, int ncols, int K, signed char* dst, int drow0, const float* cmax, bool zfill, float sfac, float* wsc, LAS float* scr, int& rot) {
    const int G = gridDim.x * NWAVES, nct = (ncols + 63) / 64, nkt = K / 64, nt = nct * nkt, wv = __builtin_amdgcn_readfirstlane(otid() >> 6), gw = wv * gridDim.x + obid();
    for (int t = (gw - rot % G + G) % G; t < nt; t += G) { const int ct = t / nkt, kt = t % nkt; const int nc = ncols - 64 * ct < 64 ? ncols - 64 * ct : 64;
        cvt_tile8(src, ld, col0 + 64 * ct, nc, 64 * kt, dst, K, drow0 + 64 * ct, cmax, zfill, sfac, wsc, scr + wv * CVT_WSCR, otid() & 63); }
    rot += nt;
}
__device__ __forceinline__ void colmax_phase(const float* w, int Kr, int N, unsigned* cmax, LAS float* scr, int unit0) {
    const int tid = otid(), lane = tid & 63, wv = tid >> 6, nch = (N + 255) / 256, nrb = Kr / 128, G = gridDim.x;
    for (int u = (obid() - unit0 % G + G) % G; u < nch * nrb; u += G) { const int ch = u / nrb, rb = u % nrb, c0 = 256 * ch + 4 * lane;
        f32x4 mx = (f32x4){0.f, 0.f, 0.f, 0.f};
        if (c0 < N) {
#pragma unroll
            for (int i = 0; i < 16; ++i) { const f32x4 v = *(const f32x4*)(w + (size_t)(rb * 128 + wv * 16 + i) * N + c0);
                mx[0] = fmaxf(mx[0], fabsf(v[0])); mx[1] = fmaxf(mx[1], fabsf(v[1])); mx[2] = fmaxf(mx[2], fabsf(v[2])); mx[3] = fmaxf(mx[3], fabsf(v[3])); } }
        __syncthreads(); *(LAS f32x4*)(scr + wv * 256 + 4 * lane) = mx; __syncthreads();
        if (tid < 256 && 256 * ch + tid < N) { float v = scr[tid];
#pragma unroll
            for (int g2 = 1; g2 < 8; ++g2) v = fmaxf(v, scr[g2 * 256 + tid]);
            atomicMax(cmax + 256 * ch + tid, __float_as_uint(v)); }
    }
}
__device__ __forceinline__ void wmax_phase(const float* w, size_t n4, unsigned* slot) {
    const int gt = obid() * NTHR + otid(), GT = gridDim.x * NTHR; float m = 0.f;
    for (size_t i = gt; i < n4; i += GT) { const f32x4 v = ((const f32x4*)w)[i]; m = fmaxf(m, fmaxf(fmaxf(fabsf(v[0]), fabsf(v[1])), fmaxf(fabsf(v[2]), fabsf(v[3])))); }
    m = wave_max(m);
    if ((otid() & 63) == 0) atomicMax(slot, __float_as_uint(m));
}
__device__ __forceinline__ void cvt_block(const float* src, int ld, int col0, int ncols, int K, bf16* dst, int drow0, float scale, bool zfill, LAS float* scr, int& rot) {
    const int G = gridDim.x * NWAVES, nct = (ncols + 63) / 64, nkt = K / 64, nt = nct * nkt, wv = __builtin_amdgcn_readfirstlane(otid() >> 6), gw = wv * gridDim.x + obid();
    for (int t = (gw - rot % G + G) % G; t < nt; t += G) { const int ct = t / nkt, kt = t % nkt; const int nc = ncols - 64 * ct < 64 ? ncols - 64 * ct : 64;
        cvt_tile(src, ld, col0 + 64 * ct, nc, 64 * kt, dst, K, drow0 + 64 * ct, scale, zfill, scr + wv * CVT_WSCR, otid() & 63); }
    rot += nt;
}
__device__ __forceinline__ void cvt_ffn(const float* w_in, const float* w_out, bf16* W1t, bf16* W2t, LAS float* scr, const float* cmax) {
    const int G = gridDim.x * NWAVES, wv = __builtin_amdgcn_readfirstlane(otid() >> 6), gw = wv * gridDim.x + obid();
    __syncthreads();
    constexpr int NRT = 2 * DFF / 64, NKT = D / 64;
    for (int t = gw; t < NRT * NKT; t += G) { const int rt = t / NKT, kt = t % NKT; const int pn = rt >> 2, w = (rt & 3) * 64;
        const int col = (w < 128) ? 128 * pn + w : DFF + 128 * pn + (w - 128);
        cvt_tile8(w_in, 2 * DFF, col, 64, 64 * kt, (signed char*)W1t, D, 64 * rt, cmax, false, 1.0f, nullptr, scr + wv * CVT_WSCR, otid() & 63); }
    int rot = NRT * NKT;
    cvt_block(w_out, D, 0, D, DFF, W2t, 0, 1.0f, false, scr, rot);
}
template <int NO, int NK, bool B_O_MINOR, class FA, class FB, class FS>
__device__ __forceinline__ void small_gemm_tile(FA fa, FB fb, FS fs, LAS float* lds) {
    LAS float* As = lds; LAS float* Bs = lds + 64 * (NK + 1);
    const int tid = otid();
    __syncthreads();
    for (int e = tid; e < 64 * NK; e += NTHR) { const int i = e / NK, k = e % NK; As[i * (NK + 1) + k] = fa(i, k); }
    for (int e = tid; e < NO * NK; e += NTHR) { const int o = B_O_MINOR ? e % NO : e / NK, k = B_O_MINOR ? e / NO : e % NK; Bs[o * (NK + 1) + k] = fb(o, k); }
    __syncthreads();
    constexpr int PER = NO / 8; const int i = tid & 63, oq = tid >> 6;
    float acc[PER];
#pragma unroll
    for (int mm = 0; mm < PER; ++mm) acc[mm] = 0.f;
#pragma unroll 4
    for (int k = 0; k < NK; ++k) { const float av = As[i * (NK + 1) + k];
#pragma unroll
        for (int mm = 0; mm < PER; ++mm) acc[mm] += av * Bs[(oq * PER + mm) * (NK + 1) + k]; }
#pragma unroll
    for (int mm = 0; mm < PER; ++mm) fs(oq * PER + mm, i, acc[mm]);
}
template <class C> __device__ __forceinline__ void merged_pre(const C& a, int l, bf16* MW, unsigned* mwmax, LAS float* scr, int rot2) {
    const float* w_in = a.in(I_WIN) + (size_t)l * D * DIN;
    const float* wkv = a.in(I_AWKV) + (size_t)l * 128 * 1024;
    const int G = gridDim.x;
    auto put = [&](int row, int d, float v) { MW[(size_t)row * D + d] = (bf16)f2bf(v); const float am = wave_max(fabsf(v)); if ((otid() & 63) == 0) atomicMax(mwmax + row, __float_as_uint(am)); };
    for (int un = (obid() - rot2 % G + G) % G; un < 8 * 16; un += G) { const int h = un >> 4, d0 = (un & 15) * 64;
        small_gemm_tile<128, 48, false>([&](int i, int k) { return w_in[(size_t)(d0 + i) * DIN + WI_AQ + 64 * h + 16 + k]; },
                                        [&](int o, int k) { return wkv[(size_t)o * 1024 + 128 * h + 16 + k] * QSCALE; },
                                        [&](int o, int i, float v) { put(h * 128 + o, d0 + i, v); }, scr); }
    rot2 += 128;
    const float* gkv = a.in(I_AKVG) + (size_t)l * 128;
    for (int un = (obid() - rot2 % G + G) % G; un < 16; un += G) { const int d0 = un * 64;
        small_gemm_tile<128, 128, true>([&](int i, int k) { return w_in[(size_t)(d0 + i) * DIN + WI_CKV + k]; },
                                        [&](int o, int k) { return gkv[k] * wkv[(size_t)k * 1024 + 128 * (o >> 4) + (o & 15)]; },
                                        [&](int o, int i, float v) { put(1024 + o, d0 + i, v); }, scr); }
    rot2 += 16;
    const float* wal = a.in(I_CWAL) + (size_t)l * 16 * 256;
    for (int un = (obid() - rot2 % G + G) % G; un < 32; un += G) { const int n0 = (un >> 4) * 128, d0 = (un & 15) * 64;
        small_gemm_tile<128, 16, true>([&](int i, int k) { return w_in[(size_t)(d0 + i) * DIN + WI_CA + k]; },
                                       [&](int o, int k) { return wal[k * 256 + n0 + o]; },
                                       [&](int o, int i, float v) { put(1152 + n0 + o, d0 + i, v); }, scr); }
    rot2 += 32;
    const float* wba = a.in(I_WBA) + (size_t)l * 512 * D;
    for (int un = (obid() - rot2 % G + G) % G; un < 8 * 2 * 8; un += G) { const int h = un >> 4, c0 = ((un >> 3) & 1) * 64, n0 = (un & 7) * 128;
        small_gemm_tile<128, 64, true>([&](int i, int k) { return wkv[(size_t)(c0 + i) * 1024 + 128 * h + 64 + k]; },
                                       [&](int o, int k) { return wba[(size_t)(64 * h + k) * D + n0 + o]; },
                                       [&](int o, int i, float v) { put(1408 + n0 + o, h * 128 + c0 + i, v); }, scr); }
}
template <class C> __device__ __forceinline__ void cvt_mixer(const C& a, int l, bf16* W, LAS float* scr, const float* cmw, const float* cmg, const bf16* MW, const unsigned* mwmax, float* wsc) {
    const float* w_in = a.in(I_WIN) + (size_t)l * D * DIN;
    const float* wkv = a.in(I_AWKV) + (size_t)l * 128 * 1024;
    signed char* W8 = (signed char*)(W + WO_BIG);
    int rot = 0;
    __syncthreads();
    cvt_block8(w_in, DIN, WI_BQKV, 768, D, W8, RB0, cmw, false, QSCALE, wsc, scr, rot);
    cvt_block8(w_in, DIN, WI_BQKV + 768, 1536, D, W8, RB0 + 768, cmw, false, 1.0f, wsc, scr, rot);
    const int R2 = RAC0 + 256;
#pragma unroll 1
    for (int h = 0; h < 8; ++h) cvt_block8(w_in, DIN, WI_AQ + 64 * h, 16, D, W8, R2 + A2_QR + 16 * h, cmw, false, QSCALE, wsc, scr, rot);
    cvt_block8(w_in, DIN, WI_IQ, 512, D, W8, R2 + A2_IQ, cmw, false, 1.0f, wsc, scr, rot);
    cvt_block8(w_in, DIN, WI_IK, 64, D, W8, R2 + A2_IK, cmw, false, 1.0f, wsc, scr, rot);
    cvt_block8(w_in, DIN, WI_IW, 8, D, W8, R2 + A2_IW, cmw, true, 1.0f, wsc, scr, rot);
    cvt_block8(w_in, DIN, WI_CKV, 128, D, W8, R2 + A2_CKV, cmw, false, 1.0f, wsc, scr, rot);
    cvt_block8(w_in, DIN, WI_CQ, 256, D, W8, R2 + A2_CQ, cmw, false, 0.125f, wsc, scr, rot);
    cvt_block8(w_in, DIN, WI_CK, 256 + 512 + 512, D, W8, R2 + A2_CK, cmw, false, 1.0f, wsc, scr, rot);
    cvt_block8(a.in(I_WGATE) + (size_t)l * D * 3072, 3072, 0, 3072, D, W8, RG0, cmg, false, 1.0f, wsc, scr, rot);
    cvt_block(a.in(I_WBB) + (size_t)l * 256 * D, D, 0, D, 256, W + WO_MB, 0, 1.0f, false, scr, rot);
    cvt_block(a.in(I_WBC) + (size_t)l * 512 * D, D, 0, D, 512, W + WO_MC, 0, 1.0f, false, scr, rot);
    cvt_block(a.in(I_WOUT) + (size_t)l * D * D, D, 0, D, D, W + WO_WO, 0, 1.0f, false, scr, rot);
    { const int lane = otid() & 63, gw = obid() * NWAVES + (otid() >> 6), NGW = gridDim.x * NWAVES;
      for (int r = gw; r < NMW; r += NGW) { const int dr = r < 768 ? 2304 + r : r < 1024 ? RAC0 + (r - 768) : r < 1152 ? R2 + A2_KR + (r - 1024) : r < 1408 ? R2 + A2_CAL + (r - 1152) : NBIG + (r - 1408);
          const float mx = __uint_as_float(mwmax[r]), qs = mx > 0.f ? 127.0f / mx : 0.f;
          const v4u p0 = *(const v4u*)(MW + (size_t)r * D + 16 * lane), p1 = *(const v4u*)(MW + (size_t)r * D + 16 * lane + 8);
          const unsigned pw[8] = {p0.x, p0.y, p0.z, p0.w, p1.x, p1.y, p1.z, p1.w}; unsigned ow[4];
#pragma unroll
          for (int j = 0; j < 4; ++j) { const int q0 = __float2int_rn(blo(pw[2 * j]) * qs), q1 = __float2int_rn(bhi(pw[2 * j]) * qs), q2 = __float2int_rn(blo(pw[2 * j + 1]) * qs), q3 = __float2int_rn(bhi(pw[2 * j + 1]) * qs);
              ow[j] = (unsigned)(q0 & 0xff) | ((unsigned)(q1 & 0xff) << 8) | ((unsigned)(q2 & 0xff) << 16) | ((unsigned)(q3 & 0xff) << 24); }
          v4u o; o.x = ow[0]; o.y = ow[1]; o.z = ow[2]; o.w = ow[3]; *(v4u*)(W8 + (size_t)dr * D + 16 * lane) = o;
          if (lane == 0) wsc[dr] = mx * (1.0f / 127.0f); } }
}

__device__ __forceinline__ void cs_phase(const int* pos, float* cs) {
    const int gt = obid() * NTHR + otid(), GT = gridDim.x * NTHR;
    for (int e = gt; e < T * 8; e += GT) { const int t = e >> 3, i = e & 7;
        const double frev = (i == 0) ? 0.15915494309189535 : (i == 1) ? 0.03086376340470123 : (i == 2) ? 0.005985185712713705 : (i == 3) ? 0.001160663641240061 :
                            (i == 4) ? 0.00022507907903927653 : (i == 5) ? 4.364795279280289e-05 : (i == 6) ? 8.464330808241401e-06 : 1.6414262627950345e-06;
        const double rev = (double)pos[t] * frev; const float fr = (float)(rev - __builtin_floor(rev));
        cs[(size_t)t * 16 + i] = __builtin_amdgcn_cosf(fr); cs[(size_t)t * 16 + 8 + i] = __builtin_amdgcn_sinf(fr); }
}
__device__ __forceinline__ void resid_phase(const float* hin, float* hout, const bf16* f, float w, const float* gpost, const float* gpre, bf16* xn, bool dry = false, float* rsout = nullptr, const bf16* hin16 = nullptr, bf16* hout16 = nullptr) {
    const int lane = otid() & 63, gw = obid() * NWAVES + (otid() >> 6), NGW = gridDim.x * NWAVES;
    (void)dry;
    for (int r0 = gw; r0 < T; r0 += 2 * NGW) {
        const bool two = r0 + NGW < T; const int rr[2] = {r0, two ? r0 + NGW : r0};
        f32x4 v[2][4]; v2u fp[2][4];
#pragma unroll
        for (int q = 0; q < 2; ++q)
#pragma unroll
            for (int j = 0; j < 4; ++j) { if (hin16) { const v2u p = *(const v2u*)(hin16 + (size_t)rr[q] * D + 256 * j + 4 * lane); v[q][j] = (f32x4){blo(p.x), bhi(p.x), blo(p.y), bhi(p.y)}; }
                else v[q][j] = *(const f32x4*)(hin + (size_t)rr[q] * D + 256 * j + 4 * lane);
                if (f) fp[q][j] = *(const v2u*)(f + (size_t)rr[q] * D + 256 * j + 4 * lane); }
        if (f) {
#pragma unroll
            for (int q = 0; q < 2; ++q) { f32x4 fv[4]; float s = 0.f;
#pragma unroll
                for (int j = 0; j < 4; ++j) { const v2u p = fp[q][j]; fv[j] = (f32x4){blo(p.x), bhi(p.x), blo(p.y), bhi(p.y)};
                    s += (fv[j][0] * fv[j][0] + fv[j][1] * fv[j][1]) + (fv[j][2] * fv[j][2] + fv[j][3] * fv[j][3]); }
                const float rstd = w * __builtin_amdgcn_rsqf(wave_sum(s) * (1.0f / D) + RMS_EPS);
#pragma unroll
                for (int j = 0; j < 4; ++j) { const f32x4 g = *(const f32x4*)(gpost + 256 * j + 4 * lane); v[q][j] = v[q][j] + fv[j] * rstd * g; } } }
#pragma unroll
        for (int q = 0; q < 2; ++q) { const int r = rr[q]; if (q == 1 && !two) break;
            if (hout) {
#pragma unroll
                for (int j = 0; j < 4; ++j) *(f32x4*)(hout + (size_t)r * D + 256 * j + 4 * lane) = v[q][j]; }
            if (hout16) {
#pragma unroll
                for (int j = 0; j < 4; ++j) { v2u p; p.x = pk2(v[q][j][0], v[q][j][1]); p.y = pk2(v[q][j][2], v[q][j][3]); *(v2u*)(hout16 + (size_t)r * D + 256 * j + 4 * lane) = p; } }
            if (xn) { float s = 0.f;
#pragma unroll
                for (int j = 0; j < 4; ++j) s += (v[q][j][0] * v[q][j][0] + v[q][j][1] * v[q][j][1]) + (v[q][j][2] * v[q][j][2] + v[q][j][3] * v[q][j][3]);
                const float rstd = __builtin_amdgcn_rsqf(wave_sum(s) * (1.0f / D) + RMS_EPS);
                f32x4 o[4];
#pragma unroll
                for (int j = 0; j < 4; ++j) { const f32x4 g = *(const f32x4*)(gpre + 256 * j + 4 * lane); o[j] = v[q][j] * rstd * g; }
                if (!rsout) {
#pragma unroll
                    for (int j = 0; j < 4; ++j) { v2u p; p.x = pk2(o[j][0], o[j][1]); p.y = pk2(o[j][2], o[j][3]); *(v2u*)(xn + (size_t)r * D + 256 * j + 4 * lane) = p; }
                } else { float am = 0.f;
#pragma unroll
                    for (int j = 0; j < 4; ++j) am = fmaxf(am, fmaxf(fmaxf(fabsf(o[j][0]), fabsf(o[j][1])), fmaxf(fabsf(o[j][2]), fabsf(o[j][3]))));
                    am = wave_max(am); const float qs = am > 0.f ? 127.0f / am : 0.f;
#pragma unroll
                    for (int j = 0; j < 4; ++j) { const int q0 = __float2int_rn(o[j][0] * qs), q1 = __float2int_rn(o[j][1] * qs), q2 = __float2int_rn(o[j][2] * qs), q3 = __float2int_rn(o[j][3] * qs);
                        ((unsigned*)xn)[(size_t)r * 256 + 64 * j + lane] = (unsigned)(q0 & 0xff) | ((unsigned)(q1 & 0xff) << 8) | ((unsigned)(q2 & 0xff) << 16) | ((unsigned)(q3 & 0xff) << 24); }
                    if (lane == 0) rsout[r] = am * (1.0f / 127.0f); } }
        }
    }
}
__device__ __forceinline__ void rec_phase(const bf16* pA2, const float* gkv, const float* cs, bf16* rec) {
    const int lane = otid() & 63, gw = obid() * NWAVES + (otid() >> 6), NGW = gridDim.x * NWAVES;
    for (int r = gw; r < T; r += NGW) {
        const unsigned pc = *(const unsigned*)(pA2 + (size_t)r * LA2 + A2_CKV + 2 * lane), pk = *(const unsigned*)(pA2 + (size_t)r * LA2 + A2_KR + 2 * lane);
        const float c0 = blo(pc), c1 = bhi(pc);
        const float rstd = __builtin_amdgcn_rsqf(wave_sum(c0 * c0 + c1 * c1) * (1.0f / 128.0f) + RMS_EPS);
        *(unsigned short*)((unsigned char*)rec + (size_t)r * 256 + 2 * lane) = (unsigned short)__builtin_amdgcn_cvt_pk_fp8_f32(c0 * rstd * gkv[2 * lane], c1 * rstd * gkv[2 * lane + 1], 0, false);
        const float k0 = blo(pk) * rstd, k1 = bhi(pk) * rstd;
        const float q0 = __shfl_xor(k0, 4), q1 = __shfl_xor(k1, 4);
        const int i0 = (2 * lane) & 7; const bool hi = ((2 * lane) & 8) != 0;
        const float cc0 = cs[(size_t)r * 16 + i0], cc1 = cs[(size_t)r * 16 + i0 + 1], ss0 = cs[(size_t)r * 16 + 8 + i0], ss1 = cs[(size_t)r * 16 + 8 + i0 + 1];
        const float o0 = hi ? k0 * cc0 + q0 * ss0 : k0 * cc0 - q0 * ss0, o1 = hi ? k1 * cc1 + q1 * ss1 : k1 * cc1 - q1 * ss1;
        *(unsigned short*)((unsigned char*)rec + (size_t)r * 256 + 128 + 2 * lane) = (unsigned short)__builtin_amdgcn_cvt_pk_fp8_f32(o0, o1, 0, false);
    }
}
__device__ __forceinline__ unsigned pack_score(float sc, int idx) {
    const unsigned u = __float_as_uint(sc); const unsigned m = u ^ ((u >> 31) ? 0xffffffffu : 0x80000000u);
    return (m & 0xffffe000u) | (unsigned)idx;
}
typedef short v4i16_t __attribute__((ext_vector_type(4)));
typedef float f32x4_t __attribute__((ext_vector_type(4)));
__device__ __forceinline__ v4i16_t lds_tr(LAS unsigned char* p) { return __builtin_amdgcn_ds_read_tr16_b64_v4i16((LAS v4i16_t*)p); }
__device__ __forceinline__ bf16x8 cat8(v4i16_t a, v4i16_t b) { return __builtin_shufflevector(a, b, 0, 1, 2, 3, 4, 5, 6, 7); }
__device__ __forceinline__ unsigned cvtpk(float lo, float hi) { return pg8::cvt_pk_bf16(lo, hi); }
__device__ __forceinline__ float fast_sig(float x) { return __builtin_amdgcn_rcpf(1.0f + __expf(-x)); }
__device__ __forceinline__ f32x4_t mfma16(bf16x8 a, bf16x8 b, f32x4_t c) { return __builtin_amdgcn_mfma_f32_16x16x32_bf16(a, b, c, 0, 0, 0); }

constexpr int GLA_HEAD_LDS = 39936;
template <int MODE> __device__ __forceinline__ void gla_chunk_phase(const bf16* pA2, const float* cbal, const float* cng, bf16* KVT, float* DEC, bf16* yc, LAS unsigned char* lds) {
    const int tid = otid(), lane = tid & 63, wv = __builtin_amdgcn_readfirstlane(tid >> 6), hh = wv >> 2, sub = wv & 3, ht = tid & 255;
    const int d = ht & 63, fr = lane & 15, g = lane >> 4, q4 = fr >> 2, p4 = fr & 3;
    LAS unsigned char* L = lds + hh * GLA_HEAD_LDS;
    LAS float* tot = (LAS float*)L;
    LAS unsigned char* KI = L + 1024;
    LAS unsigned char* QD = L + 1024 + 10240;
    LAS unsigned char* VI = L + 1024 + 10240 + 9216;
    for (int u = obid(); u < NB * 128 * 2; u += gridDim.x) {
        const int b = u >> 8, n = (u >> 1) & 127, h = (u & 1) * 2 + hh, bh = b * 4 + h;
        const size_t row0 = (size_t)b * S + (size_t)n * 64;
        __syncthreads();
        unsigned short xa_[16], kk_[16], qq_[16]; v4u vv_[4];
#pragma unroll
        for (int i = 0; i < 16; ++i) { const size_t rb = (row0 + sub * 16 + i) * LA2 + h * 64 + d; xa_[i] = pA2[rb + A2_CAL]; kk_[i] = pA2[rb + A2_CK]; if (MODE != 1) qq_[i] = pA2[rb + A2_CQ]; }
#pragma unroll
        for (int c = 0; c < 4; ++c) { const int idx = ht + 256 * c, t = idx >> 4, ch = idx & 15; vv_[c] = *(const v4u*)(pA2 + (row0 + t) * LA2 + A2_CV + h * 128 + ch * 8); }
        bf16x8 as_[2][8]; v2u gp_[8];
        if (MODE != 1) { const bf16* sp = KVT + ((size_t)bh * 128 + n) * 8192;
#pragma unroll
            for (int ks = 0; ks < 2; ++ks)
#pragma unroll
                for (int mb = 0; mb < 8; ++mb) as_[ks][mb] = *(const bf16x8*)(sp + (16 * mb + fr) * 64 + 32 * ks + 8 * g);
#pragma unroll
            for (int mb = 0; mb < 8; ++mb) gp_[mb] = *(const v2u*)(pA2 + (row0 + 16 * sub + fr) * LA2 + A2_CG + h * 128 + 16 * mb + 4 * g); }
        float bl_[16]; float run = 0.f; const float bias = cbal[h * 64 + d];
#pragma unroll
        for (int i = 0; i < 16; ++i) { const float x = bf2f(xa_[i]) + bias;
            run += (fminf(x, 0.f) - __logf(1.0f + __expf(-fabsf(x)))) * (1.0f / 16.0f); bl_[i] = run; }
        tot[sub * 64 + d] = run;
        __syncthreads();
        float pre = 0.f, all = 0.f;
#pragma unroll
        for (int p = 0; p < 4; ++p) { const float v = tot[p * 64 + d]; pre += (p < sub) ? v : 0.f; all += v; }
#pragma unroll
        for (int i = 0; i < 16; ++i) { const int t = sub * 16 + i; const float bt = bl_[i] + pre; const float kk = bf2f(kk_[i]);
            if (MODE == 1) { *(LAS unsigned short*)(KI + t * 160 + d * 2) = (unsigned short)f2bf(kk * __expf(all - bt)); }
            else { const float qq = bf2f(qq_[i]);
                *(LAS unsigned short*)(KI + t * 144 + d * 2) = (unsigned short)f2bf(kk * __expf(-bt)); *(LAS unsigned short*)(QD + t * 144 + d * 2) = (unsigned short)f2bf(qq * __expf(bt)); } }
        if (MODE == 1 && sub == 0) DEC[((size_t)bh * 128 + n) * 64 + d] = __expf(all);
#pragma unroll
        for (int c = 0; c < 4; ++c) { const int idx = ht + 256 * c, t = idx >> 4, ch = idx & 15;
            *(LAS v4u*)(VI + t * 288 + ch * 16) = vv_[c]; }
        __syncthreads();
        if (MODE == 1) {
            f32x4_t acc[2][4];
#pragma unroll
            for (int j = 0; j < 2; ++j)
#pragma unroll
                for (int mb = 0; mb < 4; ++mb) acc[j][mb] = (f32x4_t){0.f, 0.f, 0.f, 0.f};
#pragma unroll
            for (int ks = 0; ks < 2; ++ks) { const int r0 = 32 * ks + 4 * g + q4, r1 = r0 + 16;
                bf16x8 bfr[2];
#pragma unroll
                for (int j = 0; j < 2; ++j) { const int cb = (16 * (2 * sub + j) + 4 * p4) * 2; bfr[j] = cat8(lds_tr(VI + r0 * 288 + cb), lds_tr(VI + r1 * 288 + cb)); }
#pragma unroll
                for (int mb = 0; mb < 4; ++mb) { const int ca = (16 * mb + 4 * p4) * 2; const bf16x8 af = cat8(lds_tr(KI + r0 * 160 + ca), lds_tr(KI + r1 * 160 + ca));
#pragma unroll
                    for (int j = 0; j < 2; ++j) acc[j][mb] = mfma16(af, bfr[j], acc[j][mb]); } }
#pragma unroll
            for (int j = 0; j < 2; ++j)
#pragma unroll
                for (int mb = 0; mb < 4; ++mb) { v2u o; o.x = cvtpk(acc[j][mb][0], acc[j][mb][1]); o.y = cvtpk(acc[j][mb][2], acc[j][mb][3]);
                    *(v2u*)(KVT + (((size_t)bh * 128 + n) * 128 + 16 * (2 * sub + j) + fr) * 64 + 16 * mb + 4 * g) = o; }
        } else {
            const int tq = 16 * sub + fr;
            bf16x8 bq[2];
#pragma unroll
            for (int ks = 0; ks < 2; ++ks) bq[ks] = *(const LAS bf16x8*)(QD + tq * 144 + (32 * ks + 8 * g) * 2);
            unsigned pw[2][4];
#pragma unroll
            for (int ms = 0; ms < 4; ++ms) { f32x4_t sacc = (f32x4_t){0.f, 0.f, 0.f, 0.f};
#pragma unroll
                for (int ks = 0; ks < 2; ++ks) { const bf16x8 ak = *(const LAS bf16x8*)(KI + (16 * ms + fr) * 144 + (32 * ks + 8 * g) * 2); sacc = mfma16(ak, bq[ks], sacc); }
#pragma unroll
                for (int i = 0; i < 4; ++i) if (16 * ms + 4 * g + i > tq) sacc[i] = 0.f;
                pw[ms >> 1][(ms & 1) * 2 + 0] = cvtpk(sacc[0], sacc[1]); pw[ms >> 1][(ms & 1) * 2 + 1] = cvtpk(sacc[2], sacc[3]); }
            f32x4_t oacc[8];
#pragma unroll
            for (int mb = 0; mb < 8; ++mb) oacc[mb] = (f32x4_t){0.f, 0.f, 0.f, 0.f};
#pragma unroll
            for (int ks2 = 0; ks2 < 2; ++ks2) { const int r0 = 32 * ks2 + 4 * g + q4, r1 = r0 + 16;
                const v4u pwv = {pw[ks2][0], pw[ks2][1], pw[ks2][2], pw[ks2][3]}; const bf16x8 pf = __builtin_bit_cast(bf16x8, pwv);
#pragma unroll
                for (int mb = 0; mb < 8; ++mb) { const int ca = (16 * mb + 4 * p4) * 2; const bf16x8 av = cat8(lds_tr(VI + r0 * 288 + ca), lds_tr(VI + r1 * 288 + ca)); oacc[mb] = mfma16(av, pf, oacc[mb]); } }
#pragma unroll
            for (int ks = 0; ks < 2; ++ks)
#pragma unroll
                for (int mb = 0; mb < 8; ++mb) oacc[mb] = mfma16(as_[ks][mb], bq[ks], oacc[mb]);
            float ss = 0.f;
#pragma unroll
            for (int mb = 0; mb < 8; ++mb) ss += (oacc[mb][0] * oacc[mb][0] + oacc[mb][1] * oacc[mb][1]) + (oacc[mb][2] * oacc[mb][2] + oacc[mb][3] * oacc[mb][3]);
            ss += __shfl_xor(ss, 16); ss += __shfl_xor(ss, 32);
            const float rstd = __builtin_amdgcn_rsqf(ss * (1.0f / 128.0f) + RMS_EPS);
#pragma unroll
            for (int mb = 0; mb < 8; ++mb) { const int v0 = 16 * mb + 4 * g; const v2u gp = gp_[mb]; const f32x4_t cn = *(const f32x4_t*)(cng + v0);
                const float g0 = blo(gp.x), g1 = bhi(gp.x), g2 = blo(gp.y), g3 = bhi(gp.y);
                const float y0 = oacc[mb][0] * rstd * cn[0] * g0 * fast_sig(g0), y1 = oacc[mb][1] * rstd * cn[1] * g1 * fast_sig(g1), y2 = oacc[mb][2] * rstd * cn[2] * g2 * fast_sig(g2), y3 = oacc[mb][3] * rstd * cn[3] * g3 * fast_sig(g3);
                v2u o; o.x = pk2(y0, y1); o.y = pk2(y2, y3); *(v2u*)(yc + (row0 + tq) * 512 + h * 128 + v0) = o; }
        }
    }
}
__device__ __forceinline__ void gla_scan_phase(bf16* KVT, const float* DEC, bool dry = false) {
    const int tid = otid();
    if (tid < 256) for (int e = obid() * 256 + tid; e < 8 * 8192; e += gridDim.x * 256) { const int bh = e >> 13, vd = e & 8191, d = vd & 63;
        float St = 0.f; bf16* kp = KVT + (size_t)bh * 128 * 8192 + vd; const float* dp = DEC + (size_t)bh * 128 * 64 + d;
#pragma unroll 1
        for (int n0 = 0; n0 < 128; n0 += 32) {
            float kv[32], dc[32];
#pragma unroll
            for (int j = 0; j < 32; ++j) { kv[j] = bf2f(kp[(size_t)(n0 + j) * 8192]); dc[j] = dp[(n0 + j) * 64]; }
#pragma unroll
            for (int j = 0; j < 32; ++j) { if (!(dry && St != 12345.0f)) kp[(size_t)(n0 + j) * 8192] = (bf16)f2bf(St); St = dc[j] * St + kv[j]; } } }
}

typedef float f32x16_t __attribute__((ext_vector_type(16)));
#ifndef IDX_PMAX
#define IDX_PMAX 384
#define IDX_PLO 448
#endif
constexpr int IDX_C = 960, IDX_KT = 128, IDX_KROW = 144, IDX_KBUF = IDX_KT * IDX_KROW, IDX_KT_OFF = 8 * 4 * IDX_C * 4;
static_assert(IDX_KT_OFF + 2 * IDX_KBUF <= MISC_OFF, "indexer LDS map");
__device__ __forceinline__ float score_floor(unsigned thr) {
    const unsigned m = thr & 0xffffe000u; const unsigned u = (m & 0x80000000u) ? (m ^ 0x80000000u) : ~m;
    return thr == 0u ? -INFINITY : __uint_as_float(u);
}
template <int NV> __device__ __forceinline__ unsigned wave_select(const unsigned (&v)[NV], unsigned lo0, unsigned& hi_io, int cmax, int& cout) {
    unsigned lo = lo0, hi = hi_io; int c = 0;
#pragma unroll 1
    for (int it = 0; it < 40; ++it) { const unsigned mid = lo + ((hi - lo) >> 1); c = 0;
#pragma unroll
        for (int i = 0; i < NV; ++i) c += __popcll(__ballot(v[i] >= mid));
        if (c >= 256 && c <= cmax) { cout = c; hi_io = hi; return mid; }
        if (c > cmax) lo = mid; else hi = mid; }
    cout = c; hi_io = hi; return lo;
}
__device__ __forceinline__ void wave_prune(LAS unsigned* list, int& cnt, unsigned& thr, int lane, int cmax) {
    unsigned hi;
    if (cnt > 384) {
    unsigned v[16]; unsigned vmax = 0u;
#pragma unroll
    for (int i = 0; i < 16; ++i) { const int idx = lane + 64 * i; v[i] = idx < cnt ? list[idx] : 0u; vmax = v[i] > vmax ? v[i] : vmax; }
#pragma unroll
    for (int o = 1; o < 64; o <<= 1) { const unsigned t = __shfl_xor(vmax, o); vmax = t > vmax ? t : vmax; }
    hi = __builtin_amdgcn_readfirstlane(vmax) + 1u;
    int c1; const unsigned T = wave_select<16>(v, thr + 1u, hi, cmax > 384 ? cmax : 384, c1);
    int base = 0;
#pragma unroll
    for (int i = 0; i < 16; ++i) { const bool keep = v[i] >= T; const unsigned long long m = __ballot(keep);
        if (keep) list[base + __popcll(m & ((1ull << lane) - 1ull))] = v[i];
        base += __popcll(m); }
    cnt = base; thr = T - 1u;
    } else hi = 0xffffffffu;
    if (cnt > cmax) {
        unsigned x[6];
#pragma unroll
        for (int i = 0; i < 6; ++i) { const int idx = lane + 64 * i; x[i] = idx < cnt ? list[idx] : 0u; }
        int c2; const unsigned T2 = wave_select<6>(x, thr + 1u, hi, cmax, c2);
        int b2 = 0;
#pragma unroll
        for (int i = 0; i < 6; ++i) { const bool keep = x[i] >= T2; const unsigned long long m = __ballot(keep);
            if (keep) list[b2 + __popcll(m & ((1ull << lane) - 1ull))] = x[i];
            b2 += __popcll(m); }
        cnt = b2; thr = T2 - 1u; }
}
__device__ __forceinline__ void idx_phase(const bf16* pA2, unsigned short* sel, LAS unsigned char* lds, float* diag = nullptr) {
#ifdef MK_DIAG
    unsigned long long tA = 0, tB = 0, tC = 0, tD = 0; const unsigned long long tS = __builtin_amdgcn_s_memrealtime(), cS = __builtin_amdgcn_s_memtime();
#define DG_T0() const unsigned long long dg0_ = __builtin_amdgcn_s_memrealtime()
#define DG_ADD(x) x += __builtin_amdgcn_s_memrealtime() - dg0_
#else
#define DG_T0()
#define DG_ADD(x)
#endif
    const int tid = otid(), lane = tid & 63, wv = __builtin_amdgcn_readfirstlane(tid >> 6), c = lane & 31, hb = lane >> 5;
    LAS unsigned char* KT = lds + IDX_KT_OFF;
    volatile LAS unsigned* pflag = (volatile LAS unsigned*)(lds + MISC_OFF + 512);
    LAS unsigned* lists = (LAS unsigned*)lds + wv * 4 * IDX_C;
    const int r = lane & 31, a_tk = 2 * ((r >> 2) & 1) + (r >> 4), a_hd = ((r >> 3) & 1) * 4 + (r & 3);
    for (int u = obid(); u < 512; u += gridDim.x) {
        const int b = u >> 8, qt = (u < 256) ? u : 511 - u, t0 = qt * 32 + wv * 4;
        const size_t rowq = (size_t)b * S + t0;
        bf16x8 A[4];
#pragma unroll
        for (int ks = 0; ks < 4; ++ks) A[ks] = *(const bf16x8*)(pA2 + (rowq + a_tk) * LA2 + A2_IQ + a_hd * 64 + 16 * ks + 8 * hb);
        float w[16];
#pragma unroll
        for (int j = 0; j < 4; ++j) { const v2u wp = *(const v2u*)(pA2 + (rowq + 2 * hb + (j >> 1)) * LA2 + A2_IW + (j & 1) * 4);
            w[4 * j] = blo(wp.x); w[4 * j + 1] = bhi(wp.x); w[4 * j + 2] = blo(wp.y); w[4 * j + 3] = bhi(wp.y); }
        int cnt0 = 0, cnt1 = 0, cnt2 = 0, cnt3 = 0; unsigned th0 = 0u, th1 = 0u, th2 = 0u, th3 = 0u;
        const int tp0 = t0 + 2 * hb, tp1 = tp0 + 1;
        const int ntile = (qt * 32 + 32 + IDX_KT - 1) / IDX_KT;
        v4u kn[2];
#define IDX_KLOAD(t_) do { _Pragma("unroll") for (int cc = 0; cc < 2; ++cc) { const int idx = tid + 512 * cc; kn[cc] = *(const v4u*)(pA2 + ((size_t)b * S + (t_) * IDX_KT + (idx >> 3)) * LA2 + A2_IK + (idx & 7) * 8); } } while (0)
#define IDX_KSTORE(t_) do { _Pragma("unroll") for (int cc = 0; cc < 2; ++cc) { const int idx = tid + 512 * cc; *(LAS v4u*)(KT + ((t_) & 1) * IDX_KBUF + (idx >> 3) * IDX_KROW + (idx & 7) * 16) = kn[cc]; } } while (0)
        IDX_KLOAD(0);
        asm volatile("s_waitcnt lgkmcnt(0)" ::: "memory"); __builtin_amdgcn_s_barrier(); asm volatile("" ::: "memory");
        IDX_KSTORE(0);
        if (ntile > 1) IDX_KLOAD(1);
        asm volatile("s_waitcnt lgkmcnt(0)" ::: "memory"); __builtin_amdgcn_s_barrier(); asm volatile("" ::: "memory");
#pragma unroll 1
        for (int tile = 0; tile < ntile; ++tile) {
            const unsigned pf = __builtin_amdgcn_readfirstlane(pflag[tile % 3]);
            if (tid == 0) pflag[(tile + 2) % 3] = 0u;
            if (pf) { DG_T0();
                if (cnt0 > IDX_PLO) wave_prune(lists, cnt0, th0, lane, IDX_PMAX);
                if (cnt1 > IDX_PLO) wave_prune(lists + IDX_C, cnt1, th1, lane, IDX_PMAX);
                if (cnt2 > IDX_PLO) wave_prune(lists + 2 * IDX_C, cnt2, th2, lane, IDX_PMAX);
                if (cnt3 > IDX_PLO) wave_prune(lists + 3 * IDX_C, cnt3, th3, lane, IDX_PMAX);
                DG_ADD(tA); }
            const LAS unsigned char* KTc = KT + (tile & 1) * IDX_KBUF;
            const unsigned thl0 = hb ? th2 : th0, thl1 = hb ? th3 : th1;
            const float thf0 = score_floor(thl0), thf1 = score_floor(thl1);
            if (tile * IDX_KT <= t0 + 3) { DG_T0();
#pragma unroll
            for (int kb2 = 0; kb2 < 2; ++kb2) {
                bf16x8 Bf[2][4];
#pragma unroll
                for (int h2 = 0; h2 < 2; ++h2)
#pragma unroll
                    for (int ks = 0; ks < 4; ++ks) Bf[h2][ks] = *(const LAS bf16x8*)(KTc + (32 * (2 * kb2 + h2) + c) * IDX_KROW + (16 * ks + 8 * hb) * 2);
                f32x16_t acc[2];
#pragma unroll
                for (int h2 = 0; h2 < 2; ++h2)
#pragma unroll
                    for (int i = 0; i < 16; ++i) acc[h2][i] = 0.f;
#pragma unroll
                for (int ks = 0; ks < 4; ++ks)
#pragma unroll
                    for (int h2 = 0; h2 < 2; ++h2) acc[h2] = __builtin_amdgcn_mfma_f32_32x32x16_bf16(A[ks], Bf[h2][ks], acc[h2], 0, 0, 0);
#pragma unroll
                for (int h2 = 0; h2 < 2; ++h2) {
                    float s0a = 0.f, s0b = 0.f, s1a = 0.f, s1b = 0.f;
#pragma unroll
                    for (int i = 0; i < 4; ++i) {
                        s0a = __builtin_fmaf(w[i], __int_as_float(max(__float_as_int(acc[h2][i]), 0)), s0a); s0b = __builtin_fmaf(w[4 + i], __int_as_float(max(__float_as_int(acc[h2][4 + i]), 0)), s0b);
                        s1a = __builtin_fmaf(w[8 + i], __int_as_float(max(__float_as_int(acc[h2][8 + i]), 0)), s1a); s1b = __builtin_fmaf(w[12 + i], __int_as_float(max(__float_as_int(acc[h2][12 + i]), 0)), s1b);
                        asm("" : "+v"(s0a)); asm("" : "+v"(s0b)); asm("" : "+v"(s1a)); asm("" : "+v"(s1b)); }
                    const float s0 = s0a + s0b, s1 = s1a + s1b;
                    const int key = tile * IDX_KT + 32 * (2 * kb2 + h2) + c;
                    const bool c0 = (key <= tp0) & (s0 >= thf0), c1 = (key <= tp1) & (s1 >= thf1);
                    if (__ballot(c0 | c1)) {
                    const unsigned p0 = c0 ? pack_score(s0, key) : 0u, p1 = c1 ? pack_score(s1, key) : 0u;
                    const unsigned long long m0 = __ballot(p0 > thl0), m1 = __ballot(p1 > thl1);
                    if (m0 | m1) {
                        const unsigned long long below = (1ull << lane) - 1ull;
                        { const unsigned long long mk = m0 & 0xffffffffull; if (mk) { if (hb == 0 && ((m0 >> lane) & 1ull)) lists[cnt0 + __popcll(mk & below)] = p0; cnt0 += __popcll(mk); } }
                        { const unsigned long long mk = m1 & 0xffffffffull; if (mk) { if (hb == 0 && ((m1 >> lane) & 1ull)) lists[IDX_C + cnt1 + __popcll(mk & below)] = p1; cnt1 += __popcll(mk); } }
                        { const unsigned long long mk = m0 & 0xffffffff00000000ull; if (mk) { if (hb == 1 && ((m0 >> lane) & 1ull)) lists[2 * IDX_C + cnt2 + __popcll(mk & below)] = p0; cnt2 += __popcll(mk); } }
                        { const unsigned long long mk = m1 & 0xffffffff00000000ull; if (mk) { if (hb == 1 && ((m1 >> lane) & 1ull)) lists[3 * IDX_C + cnt3 + __popcll(mk & below)] = p1; cnt3 += __popcll(mk); } }
                    }
                    }
                }
            }
            DG_ADD(tD); }
            { DG_T0();
            if (tile + 1 < ntile) { IDX_KSTORE(tile + 1); if (tile + 2 < ntile) IDX_KLOAD(tile + 2); }
            if (((cnt0 > IDX_C - IDX_KT) | (cnt1 > IDX_C - IDX_KT) | (cnt2 > IDX_C - IDX_KT) | (cnt3 > IDX_C - IDX_KT)) && lane == 0) pflag[(tile + 1) % 3] = 1u;
            asm volatile("s_waitcnt lgkmcnt(0)" ::: "memory"); __builtin_amdgcn_s_barrier(); asm volatile("" ::: "memory");
            DG_ADD(tB); }
        }
#undef IDX_KLOAD
#undef IDX_KSTORE
        { DG_T0();
#pragma unroll
        for (int j = 0; j < 4; ++j) { int cn = (j == 0) ? cnt0 : (j == 1) ? cnt1 : (j == 2) ? cnt2 : cnt3; unsigned th = (j == 0) ? th0 : (j == 1) ? th1 : (j == 2) ? th2 : th3;
            LAS unsigned* lj = lists + j * IDX_C;
            if (cn > 256) wave_prune(lj, cn, th, lane, 256);
            unsigned short* so = sel + (rowq + j) * 256;
#pragma unroll
            for (int i = 0; i < 4; ++i) { const int idx = lane + 64 * i; so[idx] = (idx < cn) ? (unsigned short)(lj[idx] & 0x1fffu) : (unsigned short)0xffffu; } }
        DG_ADD(tC); }
    }
#ifdef MK_DIAG
    if (diag && obid() == MK_DIAG_WG && tid == 64 * MK_DIAG_WAVE) { const float tot = (float)(__builtin_amdgcn_s_memrealtime() - tS); const float cyc = (float)(__builtin_amdgcn_s_memtime() - cS); const float fr_ = (MK_DIAG == 1 ? (float)tA / tot : MK_DIAG == 2 ? (float)tB / tot : MK_DIAG == 3 ? (float)tC / tot : MK_DIAG == 4 ? (float)tD / tot : MK_DIAG == 6 ? cyc / tot / 30.0f : tot * 1e-5f); diag[0] = (fr_ > MK_DIAG_THR) ? 0.5f : 0.0f; }
#endif
}

constexpr int ATA_ROWB = 272, ATA_WAVE_LDS = 32 * ATA_ROWB;
typedef int v2i_t __attribute__((ext_vector_type(2)));
typedef float f32x2_t __attribute__((ext_vector_type(2)));
__device__ __forceinline__ long q8_pack(bf16x8 v) {
    const v4u w = __builtin_bit_cast(v4u, v); unsigned lo = 0u, hi = 0u;
    lo = __builtin_amdgcn_cvt_pk_fp8_f32(blo(w.x) * 16.f, bhi(w.x) * 16.f, lo, false); lo = __builtin_amdgcn_cvt_pk_fp8_f32(blo(w.y) * 16.f, bhi(w.y) * 16.f, lo, true);
    hi = __builtin_amdgcn_cvt_pk_fp8_f32(blo(w.z) * 16.f, bhi(w.z) * 16.f, hi, false); hi = __builtin_amdgcn_cvt_pk_fp8_f32(blo(w.w) * 16.f, bhi(w.w) * 16.f, hi, true);
    return (long)(((unsigned long long)hi << 32) | lo);
}
__device__ __forceinline__ void atta_phase(const bf16* pA2, const bf16* ya, const bf16* rec, const unsigned short* sel, LAS unsigned char* lds, signed char* ya8, float* rsa) {
    const int tid = otid(), lane = tid & 63, wv = __builtin_amdgcn_readfirstlane(tid >> 6), fr = lane & 15, g = lane >> 4;
    LAS unsigned char* img = lds + wv * ATA_WAVE_LDS;
    const int wrow = (16 * (g & 1) + (g >> 1)) * ATA_ROWB + 16 * fr;
    const int arow = 2 * fr * ATA_ROWB + 16 * g;
    const int trow = (2 * (4 * g + ((fr >> 1) & 3)) + (fr >> 3)) * ATA_ROWB + 8 * (fr & 1);
    const int bid = obid(), G = gridDim.x, b = (G > 1) ? (bid & 1) : 0, nb = (G > 1) ? 2 : 1, wsl = (G > 1) ? ((bid >> 1) * NWAVES + wv) : wv, nws = ((G + (1 - b)) / nb) * NWAVES;
    const bf16x8 zero8 = {0, 0, 0, 0, 0, 0, 0, 0};
#pragma unroll 1
    for (int qq = wsl; qq < S * (3 - nb); qq += nws) {
        const int t = qq % S, bq = (nb == 2) ? b : qq / S;
        int lane_o = lane; asm volatile("" : "+v"(lane_o));
        const int fro = lane_o & 15, go = lane_o >> 4;
        { const int qn = qq + nws;
          if (qn < S * (3 - nb)) { const int tn = qn % S, bn = (nb == 2) ? b : qn / S; const size_t rn = (size_t)bn * S + tn;
              const char* pp = lane_o < 4 ? (const char*)(sel + rn * 256) + 128 * lane_o : lane_o < 20 ? (const char*)(ya + rn * 1024) + 128 * (lane_o - 4) : (const char*)(pA2 + rn * LA2 + A2_QR) + 128 * (lane_o - 20);
              if (lane_o < 22) { const unsigned pre_ = *(const volatile unsigned*)pp; (void)pre_; } } }
        const int q = bq * S + t, nvalid = (t + 1 < 256) ? t + 1 : 256;
        const unsigned char* recb = (const unsigned char*)rec + (size_t)bq * S * 256 + 16 * fro;
        const unsigned short* selq = sel + (size_t)q * 256 + 8 * go;
        v4u ix[2];
#pragma unroll
        for (int j = 0; j < 2; ++j) ix[j] = __builtin_nontemporal_load((const v4u*)(selq + 32 * j));
        f32x4_t O[8];
#pragma unroll
        for (int mb = 0; mb < 8; ++mb) O[mb] = (f32x4_t){0.f, 0.f, 0.f, 0.f};
        float m = -INFINITY, l = 0.f, mlim = -INFINITY;
        v4u R0[8], R1[8];
#define ATA_IXW(v_, i_) ((i_) >> 1 == 0 ? (v_).x : (i_) >> 1 == 1 ? (v_).y : (i_) >> 1 == 2 ? (v_).z : (v_).w)
#define ATA_FETCH(R_, s_, SL_, MASK_) do { _Pragma("unroll") for (int i = 0; i < 8; ++i) { unsigned kx = ((i) & 1) ? (ATA_IXW(ix[SL_], i) >> 16) : (ATA_IXW(ix[SL_], i) & 0xffffu); \
            if (MASK_) kx = (32 * (s_) + 8 * g + i < nvalid) ? kx : 0u;                            \
            R_[i] = *(const v4u*)(recb + (size_t)kx * 256); } \
        if ((s_) + 2 < 8) ix[SL_] = __builtin_nontemporal_load((const v4u*)(selq + 32 * ((s_) + 2))); } while (0)
#define ATA_STEP(R_, s_, P_, MASK_) do { \
            _Pragma("unroll") for (int i = 0; i < 8; ++i) *(LAS v4u*)(img + wrow + 2 * i * ATA_ROWB) = R_[i]; \
            if ((s_) + 2 < 8) ATA_FETCH(R_, (s_) + 2, (P_), MASK_);     \
            f32x4_t sc[2]; \
            _Pragma("unroll") for (int tl = 0; tl < 2; ++tl) { sc[tl] = (f32x4_t){0.f, 0.f, 0.f, 0.f}; \
                _Pragma("unroll") for (int kp = 0; kp < 4; ++kp) { const v4u av = *(const LAS v4u*)(img + arow + tl * ATA_ROWB + 64 * kp); \
                    sc[tl] = __builtin_amdgcn_mfma_f32_16x16x32_fp8_fp8((long)(((unsigned long long)av.y << 32) | av.x), Bq[2 * kp], sc[tl], 0, 0, 0); \
                    sc[tl] = __builtin_amdgcn_mfma_f32_16x16x32_fp8_fp8((long)(((unsigned long long)av.w << 32) | av.z), Bq[2 * kp + 1], sc[tl], 0, 0, 0); } \
                if (MASK_) { _Pragma("unroll") for (int i = 0; i < 4; ++i) sc[tl][i] = (32 * (s_) + 16 * tl + 4 * g + i >= nvalid) ? -INFINITY : sc[tl][i]; } } \
            float mx = fmaxf(fmaxf(fmaxf(sc[0][0], sc[0][1]), fmaxf(sc[0][2], sc[0][3])), fmaxf(fmaxf(sc[1][0], sc[1][1]), fmaxf(sc[1][2], sc[1][3]))); \
              \
            if (__any(mx > mlim)) { mx = fmaxf(mx, __shfl_xor(mx, 16)); mx = fmaxf(mx, __shfl_xor(mx, 32)); const float mn = fmaxf(m, mx * 0.0625f); const float alpha = __builtin_amdgcn_exp2f(m - mn); m = mn; mlim = (mn + 4.0f) * 16.0f; l *= alpha; \
                _Pragma("unroll") for (int mb = 0; mb < 8; ++mb) O[mb] = O[mb] * alpha; } \
            const float mneg = 4.0f - m;                                             \
            const float a0 = __builtin_amdgcn_exp2f(__builtin_fmaf(sc[0][0], 0.0625f, mneg)), a1 = __builtin_amdgcn_exp2f(__builtin_fmaf(sc[0][1], 0.0625f, mneg)), a2 = __builtin_amdgcn_exp2f(__builtin_fmaf(sc[0][2], 0.0625f, mneg)), a3 = __builtin_amdgcn_exp2f(__builtin_fmaf(sc[0][3], 0.0625f, mneg)), \
                        b0 = __builtin_amdgcn_exp2f(__builtin_fmaf(sc[1][0], 0.0625f, mneg)), b1 = __builtin_amdgcn_exp2f(__builtin_fmaf(sc[1][1], 0.0625f, mneg)), b2 = __builtin_amdgcn_exp2f(__builtin_fmaf(sc[1][2], 0.0625f, mneg)), b3 = __builtin_amdgcn_exp2f(__builtin_fmaf(sc[1][3], 0.0625f, mneg)); \
            l += (((a0 + a1) + (a2 + a3)) + ((b0 + b1) + (b2 + b3))); \
            unsigned plo = __builtin_amdgcn_cvt_pk_fp8_f32(a0, a1, 0u, false); plo = __builtin_amdgcn_cvt_pk_fp8_f32(a2, a3, plo, true); \
            unsigned phi = __builtin_amdgcn_cvt_pk_fp8_f32(b0, b1, 0u, false); phi = __builtin_amdgcn_cvt_pk_fp8_f32(b2, b3, phi, true); \
            const long pf = (long)(((unsigned long long)phi << 32) | plo);     \
            _Pragma("unroll") for (int mb = 0; mb < 8; ++mb) { const v2i_t a2 = __builtin_amdgcn_ds_read_tr8_b64_v2i32((LAS v2i_t*)(img + trow + 16 * mb)); \
                O[mb] = __builtin_amdgcn_mfma_f32_16x16x32_fp8_fp8((long)(((unsigned long long)(unsigned)a2.y << 32) | (unsigned)a2.x), pf, O[mb], 0, 0, 0); } } while (0)
        long Bq[8];
        if (nvalid == 256) { ATA_FETCH(R0, 0, 0, false); ATA_FETCH(R1, 1, 1, false); } else { ATA_FETCH(R0, 0, 0, true); ATA_FETCH(R1, 1, 1, true); }
#pragma unroll
        for (int kp = 0; kp < 2; ++kp)
#pragma unroll
            for (int h = 0; h < 2; ++h) Bq[2 * kp + h] = q8_pack((fr < 8) ? __builtin_nontemporal_load((const bf16x8*)(ya + (size_t)q * 1024 + fro * 128 + 64 * kp + 16 * go + 8 * h)) : zero8);
#pragma unroll
        for (int kp = 2; kp < 4; ++kp)
#pragma unroll
            for (int h = 0; h < 2; ++h) Bq[2 * kp + h] = q8_pack((fr < 8 && fr == 4 * (kp - 2) + g) ? *(const bf16x8*)(pA2 + (size_t)q * LA2 + A2_QR + fro * 16 + 8 * h) : zero8);
        if (nvalid == 256) {
#pragma unroll 1
            for (int s2 = 0; s2 < 4; ++s2) { ATA_STEP(R0, 2 * s2, 0, false); ATA_STEP(R1, 2 * s2 + 1, 1, false); }
        } else {
#pragma unroll 1
            for (int s2 = 0; s2 < 4; ++s2) { ATA_STEP(R0, 2 * s2, 0, true); ATA_STEP(R1, 2 * s2 + 1, 1, true); } }
#undef ATA_STEP
#undef ATA_FETCH
#undef ATA_IXW
        l += __shfl_xor(l, 16); l += __shfl_xor(l, 32);
        const float inv = 1.0f / l;
        float am = 0.f;
#pragma unroll
        for (int mb = 0; mb < 8; ++mb) { O[mb] = O[mb] * inv; am = fmaxf(am, fmaxf(fmaxf(fabsf(O[mb][0]), fabsf(O[mb][1])), fmaxf(fabsf(O[mb][2]), fabsf(O[mb][3])))); }
        am = wave_max(fr < 8 ? am : 0.f); const float qs = am > 0.f ? 127.0f / am : 0.f;
        if (fr < 8) {
#pragma unroll
            for (int mb = 0; mb < 8; ++mb) { const int q0 = __float2int_rn(O[mb][0] * qs), q1 = __float2int_rn(O[mb][1] * qs), q2 = __float2int_rn(O[mb][2] * qs), q3 = __float2int_rn(O[mb][3] * qs);
                *(unsigned*)(ya8 + (size_t)q * 1024 + fro * 128 + 16 * mb + 4 * go) = (unsigned)(q0 & 0xff) | ((unsigned)(q1 & 0xff) << 8) | ((unsigned)(q2 & 0xff) << 16) | ((unsigned)(q3 & 0xff) << 24); }
        }
        if (lane == 0) rsa[q] = am * (1.0f / 127.0f);
    }
}

constexpr int ATB_ST = 68, ATB_VROW = 160, ATB_VIMG_OFF = 256 * ATB_ST * 4, ATB_VIMG = 32 * ATB_VROW, ATB_KROW = 144, ATB_KIMG = 32 * ATB_KROW, ATB_KIMG_OFF = ATB_VIMG_OFF + 8 * ATB_VIMG;
static_assert(ATB_KIMG_OFF + 8 * ATB_KIMG <= MISC_OFF, "dilated attention LDS map");
__device__ __forceinline__ void attb_phase(const bf16* pB, bf16* yb, LAS unsigned char* lds) {
    const int tid = otid(), lane = tid & 63, wv = __builtin_amdgcn_readfirstlane(tid >> 6), fr = lane & 15, g = lane >> 4, q4 = fr >> 2, p4 = fr & 3;
    LAS float* st = (LAS float*)lds;
    LAS unsigned char* vimg = lds + ATB_VIMG_OFF + wv * ATB_VIMG;
    LAS unsigned char* kimg = lds + ATB_KIMG_OFF + wv * ATB_KIMG;
#pragma unroll 1
    for (int u = obid(); u < NB * 4 * 32; u += gridDim.x) {
        const int b = u >> 7, hs = (u >> 5) & 3, T0 = (u & 31) * 256;
        const bf16* pb = pB + (size_t)b * S * LPB;
#pragma unroll 1
        for (int grp = 0; grp < 3; ++grp) {
            const int sh = 2 * grp, d = 1 << sh, head = grp * 4 + hs;
            __syncthreads();
#pragma unroll 1
            for (int tt = 0; tt < 2; ++tt) {
                const int ti = wv * 2 + tt, r = ti & (d - 1), y0 = 16 * (ti >> sh);
                const int xq = r + d * (y0 + fr), tq = T0 + xq;
                bf16x8 Bq[2];
#pragma unroll
                for (int ks = 0; ks < 2; ++ks) Bq[ks] = *(const bf16x8*)(pb + (size_t)tq * LPB + head * 64 + 32 * ks + 8 * g);
                f32x4_t O[4];
#pragma unroll
                for (int mb = 0; mb < 4; ++mb) O[mb] = (f32x4_t){0.f, 0.f, 0.f, 0.f};
                float m = -1e30f, l = 0.f;
                v4u Kv[2][2], Vv[2][2];
#define ATB_LOAD(s_) do { _Pragma("unroll") for (int tl = 0; tl < 2; ++tl) { \
        _Pragma("unroll") for (int c2 = 0; c2 < 2; ++c2) { int tv = T0 + r + d * (y0 - 128 + 16 * (2 * (s_) + tl) + 8 * c2 + (lane >> 3)); tv = tv < 0 ? 0 : (tv > S - 1 ? S - 1 : tv);     \
            Vv[tl][c2] = *(const v4u*)(pb + (size_t)tv * LPB + head * 64 + 1536 + 8 * (lane & 7)); Kv[tl][c2] = *(const v4u*)(pb + (size_t)tv * LPB + head * 64 + 768 + 8 * (lane & 7)); } } } while (0)
                ATB_LOAD(0);
                float mlim = -INFINITY;
#define ATB_STEP(s_, MODE_) do { \
                    f32x4_t sc[2]; \
                    _Pragma("unroll") for (int tl = 0; tl < 2; ++tl) { sc[tl] = (f32x4_t){0.f, 0.f, 0.f, 0.f}; \
                        _Pragma("unroll") for (int c2 = 0; c2 < 2; ++c2) { *(LAS v4u*)(kimg + (16 * tl + 8 * c2 + (lane >> 3)) * ATB_KROW + 16 * (lane & 7)) = Kv[tl][c2]; \
                            *(LAS v4u*)(vimg + (16 * tl + 8 * c2 + (lane >> 3)) * ATB_VROW + 16 * (lane & 7)) = Vv[tl][c2]; } \
                        if (!((MODE_) == 3 && tl == 1)) { \
                        _Pragma("unroll") for (int ks = 0; ks < 2; ++ks) sc[tl] = mfma16(*(const LAS bf16x8*)(kimg + (16 * tl + fr) * ATB_KROW + 64 * ks + 16 * g), Bq[ks], sc[tl]); } \
                        if ((MODE_) == 1) { _Pragma("unroll") for (int i = 0; i < 4; ++i) { const int yk = y0 - 128 + 16 * (2 * (s_) + tl) + 4 * g + i, j = (y0 + fr) - yk, tk = T0 + r + d * yk; \
                            if (j < 0 || j > 128 || tk < 0) sc[tl][i] = -INFINITY; } } \
                        if ((MODE_) == 2 && tl == 0) { _Pragma("unroll") for (int i = 0; i < 4; ++i) if (dj > i) sc[tl][i] = -INFINITY; } \
                        if ((MODE_) == 3 && tl == 0) { _Pragma("unroll") for (int i = 0; i < 4; ++i) if (dj < i) sc[tl][i] = -INFINITY; } \
                        if ((MODE_) == 3 && tl == 1) sc[tl] = (f32x4_t){-INFINITY, -INFINITY, -INFINITY, -INFINITY}; } \
                    if ((s_) + 1 < 5) ATB_LOAD((s_) + 1); \
                    float mx = fmaxf(fmaxf(fmaxf(sc[0][0], sc[0][1]), fmaxf(sc[0][2], sc[0][3])), fmaxf(fmaxf(sc[1][0], sc[1][1]), fmaxf(sc[1][2], sc[1][3]))); \
                      \
                    if (__any(mx > mlim)) { mx = fmaxf(mx, __shfl_xor(mx, 16)); mx = fmaxf(mx, __shfl_xor(mx, 32)); const float mn = fmaxf(m, mx); const float alpha = __builtin_amdgcn_exp2f(m - mn); m = mn; mlim = mn + 40.0f; l *= alpha; \
                        _Pragma("unroll") for (int mb = 0; mb < 4; ++mb) O[mb] = O[mb] * alpha; } \
                    const float mref = m; \
                    const float a0 = __builtin_amdgcn_exp2f(sc[0][0] - mref), a1 = __builtin_amdgcn_exp2f(sc[0][1] - mref), a2 = __builtin_amdgcn_exp2f(sc[0][2] - mref), a3 = __builtin_amdgcn_exp2f(sc[0][3] - mref), b0 = __builtin_amdgcn_exp2f(sc[1][0] - mref), b1 = __builtin_amdgcn_exp2f(sc[1][1] - mref), b2 = __builtin_amdgcn_exp2f(sc[1][2] - mref), b3 = __builtin_amdgcn_exp2f(sc[1][3] - mref); \
                    l += (((a0 + a1) + (a2 + a3)) + ((b0 + b1) + (b2 + b3))); \
                    const v4u pwv = {cvtpk(a0, a1), cvtpk(a2, a3), cvtpk(b0, b1), cvtpk(b2, b3)}; const bf16x8 pf = __builtin_bit_cast(bf16x8, pwv); \
                    _Pragma("unroll") for (int mb = 0; mb < 4; ++mb) { const int ca = (16 * mb + 4 * p4) * 2; const bf16x8 av = cat8(lds_tr(vimg + (4 * g + q4) * ATB_VROW + ca), lds_tr(vimg + (16 + 4 * g + q4) * ATB_VROW + ca)); \
                        O[mb] = mfma16(av, pf, O[mb]); } } while (0)
                const int dj = fr - 4 * g;
                if (T0 + r + d * (y0 - 128) < 0) {
#pragma unroll 1
                    for (int s = 0; s < 5; ++s) ATB_STEP(s, 1);
                } else {
                    ATB_STEP(0, 2);
#pragma unroll 1
                    for (int s = 1; s < 4; ++s) ATB_STEP(s, 0);
                    ATB_STEP(4, 3); }
#undef ATB_STEP
#undef ATB_LOAD
                l += __shfl_xor(l, 16); l += __shfl_xor(l, 32);
                LAS float* sp = st + xq * ATB_ST;
                if (grp > 0) { const float ms = sp[64], ls = sp[65]; const float M = fmaxf(m, ms), a = __builtin_amdgcn_exp2f(m - M), as = __builtin_amdgcn_exp2f(ms - M);
#pragma unroll
                    for (int mb = 0; mb < 4; ++mb) { const f32x4_t os = *(const LAS f32x4_t*)(sp + 16 * mb + 4 * g); O[mb] = O[mb] * a + os * as; }
                    l = l * a + ls * as; m = M; }
                if (grp < 2) {
#pragma unroll
                    for (int mb = 0; mb < 4; ++mb) *(LAS f32x4_t*)(sp + 16 * mb + 4 * g) = O[mb];
                    if (g == 0) { sp[64] = m; sp[65] = l; }
                } else { const float inv = 1.0f / l;
#pragma unroll
                    for (int mb = 0; mb < 4; ++mb) { v2u o; o.x = pk2(O[mb][0] * inv, O[mb][1] * inv); o.y = pk2(O[mb][2] * inv, O[mb][3] * inv);
                        *(v2u*)(yb + ((size_t)b * S + tq) * 256 + hs * 64 + 16 * mb + 4 * g) = o; } }
            }
        }
    }
}
constexpr int NPH = 19;
constexpr int ARGS_OFF = MISC_OFF + 128;
struct CtxK {
    const Args& a;
    __device__ __forceinline__ const float* in(int i) const { return a.in[i]; }
    __device__ __forceinline__ float* out() const { return a.out; }
    __device__ __forceinline__ unsigned char* ws() const { return opaque_ptr(a.ws); }
};
__device__ __forceinline__ unsigned char* lds_ptr64(const LAS unsigned* p) {
    const unsigned lo = __builtin_amdgcn_readfirstlane(p[0]), hi = __builtin_amdgcn_readfirstlane(p[1]);
    return (unsigned char*)(GAS unsigned char*)(((unsigned long long)hi << 32) | lo);
}
struct CtxL {
    LAS unsigned char* lds;
    __device__ __forceinline__ const float* in(int i) const { return (const float*)lds_ptr64((const LAS unsigned*)(lds + ARGS_OFF) + 2 * i); }
    __device__ __forceinline__ float* out() const { return (float*)lds_ptr64((const LAS unsigned*)(lds + ARGS_OFF) + 48); }
    __device__ __forceinline__ unsigned char* ws() const { return lds_ptr64((const LAS unsigned*)(lds + ARGS_OFF) + 50); }
};
template <int K, class C> __device__ __forceinline__ void phase_body(const C& cx, int l, LAS unsigned char* lds) {
    unsigned char* wq_ = cx.ws(); bf16* W = (bf16*)(wq_ + WS_W); float* cs = (float*)(wq_ + WS_CS); bf16* XN = (bf16*)(wq_ + WS_XN); bf16* FB = (bf16*)(wq_ + WS_FB);
    unsigned short* SEL = (unsigned short*)(wq_ + WS_FB); bf16* REC = (bf16*)(wq_ + WS_FB + 8 * MiB); unsigned char* ob_ = (unsigned char*)cx.out(); bf16* YB = (bf16*)ob_; bf16* YA = (bf16*)(ob_ + 8 * MiB); bf16* YC = (bf16*)(ob_ + 40 * MiB); bf16* H16 = (bf16*)(wq_ + WS_YA); (void)H16; signed char* YA8 = (signed char*)(wq_ + WS_YA8); float* RSA = (float*)(wq_ + WS_DEC + 640 * 1024); (void)YA8; (void)RSA;   bf16* BIG = (bf16*)(wq_ + WS_BIG);
    bf16* KVT = (bf16*)(wq_ + WS_FB + 16 * MiB); float* DEC = (float*)(wq_ + WS_DEC); (void)KVT; (void)DEC;
    float* RS = (float*)(wq_ + WS_DEC + 512 * 1024); float* CMX = (float*)((unsigned*)(wq_ + WS_CTL) + 16384); (void)RS; (void)CMX;
    float* CMW = CMX + 4 * 2 * DFF; float* CMG = CMW + 2 * 5120; float* WSC = (float*)(wq_ + WS_DEC + 896 * 1024); bf16* MW = (bf16*)(wq_ + WS_MW); unsigned* MWMAX = (unsigned*)(wq_ + WS_CTL) + CW_MWMAX; (void)CMW; (void)CMG; (void)WSC; (void)MW; (void)MWMAX;
    (void)W; (void)cs; (void)XN; (void)FB; (void)SEL; (void)REC; (void)YB; (void)YA; (void)YC; (void)BIG;
    LAS float* scr = (LAS float*)lds; (void)scr;
    if constexpr (K == 0) { if (l == 0) { cs_phase((const int*)cx.in(I_POS), cs);
            resid_phase(cx.in(I_X), nullptr, nullptr, 0.f, nullptr, cx.in(I_F1PRE) + l * D, XN, false, RS);
#pragma unroll 1
            for (int j = 0; j < 4; ++j) colmax_phase((j & 1 ? cx.in(I_F2WIN) : cx.in(I_F1WIN)) + (size_t)(j >> 1) * D * 2 * DFF, D, 2 * DFF, (unsigned*)CMX + j * 2 * DFF, scr, j * 176);
#pragma unroll 1
            for (int j = 0; j < 2; ++j) { colmax_phase(cx.in(I_WIN) + (size_t)j * D * DIN, D, DIN, (unsigned*)CMW + j * 5120, scr, 704 + j * 256); colmax_phase(cx.in(I_WGATE) + (size_t)j * D * 3072, D, 3072, (unsigned*)CMG + j * 3072, scr, 704 + j * 256 + 160);
                merged_pre(cx, j, MW + (size_t)j * NMW * D, MWMAX + j * NMW, scr, 608 + j * 176); } } }
    if constexpr (K == 19) { if (l == 0) cvt_ffn(cx.in(I_F1WIN), cx.in(I_F1WOUT), W + WO_W1, W + WO_W2, scr, CMX); }
    if constexpr (K == 1) { pg8::Gemm g{XN, W + WO_W1, T, 2 * DFF, D / 2}; pg8::StaticOrder So; So.init(T, 2 * DFF, gridDim.x, obid()); pg8::EpiSwiglu E{BIG, DFF, RS, CMX + (2 * l) * 2 * DFF};
            pg8::gemm_phase<pg8::EpiSwiglu, pg8::StaticOrder, true, true, true>(lds, g, So, E); }
    if constexpr (K == 2) { pg8::Gemm g{BIG, W + WO_W2, T, D, DFF}; pg8::StaticOrder So; So.init(T, D, gridDim.x, obid()); pg8::EpiStore E{FB, D};
            pg8::gemm_phase<pg8::EpiStore, pg8::StaticOrder, true, true>(lds, g, So, E); }
    if constexpr (K == 3) { resid_phase(cx.in(I_X), nullptr, FB, 0.5f, cx.in(I_F1POST) + l * D, cx.in(I_MIXPRE) + l * D, XN, false, RS, l == 0 ? nullptr : H16, H16);
        cvt_mixer(cx, l, W, scr, CMW + l * 5120, CMG + l * 3072, MW + (size_t)l * NMW * D, MWMAX + l * NMW, WSC);
#ifdef MK_REPEAT_CVT
        __syncthreads(); cvt_mixer(cx, l, W, scr, CMW + l * 5120, CMG + l * 3072, MW + (size_t)l * NMW * D, MWMAX + l * NMW, WSC);
#endif
    }
    if constexpr (K == 4) { pg8::Gemm g{XN, W + WO_BIG + (size_t)RB0 * D / 2, T, NRB, D / 2}; pg8::StaticOrder So; So.init(T, NRB, gridDim.x, obid());
            pg8::EpiProj<0> E{BIG, LPB, 9, YA, 1024, cs, nullptr, RS, WSC + RB0};
            pg8::gemm_phase<pg8::EpiProj<0>, pg8::StaticOrder, true, true, true>(lds, g, So, E); }
    if constexpr (K == 5) { attb_phase(BIG, YB, lds); }
    if constexpr (K == 6) { pg8::Gemm g{XN, W + WO_BIG + (size_t)RAC0 * D / 2, T, NRAC, D / 2}; pg8::StaticOrder So; So.init(T, NRAC, gridDim.x, obid());
            pg8::EpiProj<1> E{YA + 768, 1024, 1, BIG, LA2, cs, nullptr, RS, WSC + RAC0};
            pg8::gemm_phase<pg8::EpiProj<1>, pg8::StaticOrder, true, true, true>(lds, g, So, E); }
    if constexpr (K == 7) { rec_phase(BIG, cx.in(I_AKVG) + l * 128, cs, REC); gla_chunk_phase<1>(BIG, cx.in(I_CBAL) + l * 256, nullptr, KVT, DEC, YC, lds); }
    if constexpr (K == 8) {
#if defined(MK_DRY) && (MK_DRY & 0x100)
        gla_scan_phase(KVT, DEC, true); __syncthreads();
#endif
        gla_scan_phase(KVT, DEC); }
    if constexpr (K == 9) { gla_chunk_phase<3>(BIG, cx.in(I_CBAL) + l * 256, cx.in(I_CNORM) + l * 128, KVT, DEC, YC, lds); }
    if constexpr (K == 10) { idx_phase(BIG, SEL, lds, (float*)(wq_ + WS_CTL + 64)); }
    if constexpr (K == 11) {
#if defined(MK_DRY) && (MK_DRY & 0x800)
#endif
        atta_phase(BIG, YA, REC, SEL, lds, YA8, RSA); }
    if constexpr (K == 12) { pg8::Gemm g{XN, W + WO_BIG + (size_t)RG0 * D / 2, T, NRG, D / 2}; pg8::StaticOrder So; So.init(T, NRG, gridDim.x, obid());
            pg8::EpiProj<2> E{BIG, 3072, 1000, BIG, 3072, cs, cx.in(I_BGATE) + l * 3072, RS, WSC + RG0};
            pg8::gemm_phase<pg8::EpiProj<2>, pg8::StaticOrder, true, true, true>(lds, g, So, E); }
    if constexpr (K == 13) { pg8::StaticOrder So; So.init(T, D, gridDim.x, obid());
            { pg8::Gemm g{(const bf16*)YA8, W + WO_BIG + (size_t)NBIG * D / 2, T, D, 1024 / 2}; pg8::EpiMerge<true> E{XN, D, BIG, 3072, 0, RSA, WSC + NBIG}; pg8::gemm_phase<pg8::EpiMerge<true>, pg8::StaticOrder, true, true, true>(lds, g, So, E); }
            VM_WAIT(); __syncthreads();
            { pg8::Gemm g{YB, W + WO_MB, T, D, 256}; pg8::EpiMerge<false> E{XN, D, BIG, 3072, 1024, nullptr, nullptr}; pg8::gemm_phase<pg8::EpiMerge<false>, pg8::StaticOrder, true, true>(lds, g, So, E); }
            VM_WAIT(); __syncthreads();
            { pg8::Gemm g{YC, W + WO_MC, T, D, 512}; pg8::EpiMerge<false> E{XN, D, BIG, 3072, 2048, nullptr, nullptr}; pg8::gemm_phase<pg8::EpiMerge<false>, pg8::StaticOrder, true, true>(lds, g, So, E); } }
    if constexpr (K == 14) { pg8::Gemm g{XN, W + WO_WO, T, D, D}; pg8::StaticOrder So; So.init(T, D, gridDim.x, obid()); pg8::EpiStore E{FB, D};
            pg8::gemm_phase<pg8::EpiStore, pg8::StaticOrder, true, true>(lds, g, So, E); }
    if constexpr (K == 15) { resid_phase(nullptr, nullptr, FB, 1.0f, cx.in(I_MIXPOST) + l * D, cx.in(I_F2PRE) + l * D, XN, false, RS, H16, H16);
        cvt_ffn(cx.in(I_F2WIN) + (size_t)l * D * 2 * DFF, cx.in(I_F2WOUT) + (size_t)l * DFF * D, W + WO_W1, W + WO_W2, scr, CMX + (2 * l + 1) * 2 * DFF); }
    if constexpr (K == 16) { pg8::Gemm g{XN, W + WO_W1, T, 2 * DFF, D / 2}; pg8::StaticOrder So; So.init(T, 2 * DFF, gridDim.x, obid()); pg8::EpiSwiglu E{BIG, DFF, RS, CMX + (2 * l + 1) * 2 * DFF};
            pg8::gemm_phase<pg8::EpiSwiglu, pg8::StaticOrder, true, true, true>(lds, g, So, E); }
    if constexpr (K == 17) { pg8::Gemm g{BIG, W + WO_W2, T, D, DFF}; pg8::StaticOrder So; So.init(T, D, gridDim.x, obid()); pg8::EpiStore E{FB, D};
            pg8::gemm_phase<pg8::EpiStore, pg8::StaticOrder, true, true>(lds, g, So, E); }
    if constexpr (K == 18) { if (l + 1 < DEPTH) { resid_phase(nullptr, nullptr, FB, 0.5f, cx.in(I_F2POST) + l * D, cx.in(I_F1PRE) + (l + 1) * D, XN, false, RS, H16, H16);
                cvt_ffn(cx.in(I_F1WIN) + (size_t)(l + 1) * D * 2 * DFF, cx.in(I_F1WOUT) + (size_t)(l + 1) * DFF * D, W + WO_W1, W + WO_W2, scr, CMX + (2 * (l + 1)) * 2 * DFF); }
            else { resid_phase(nullptr, cx.out(), FB, 0.5f, cx.in(I_F2POST) + l * D, nullptr, nullptr, false, nullptr, H16, nullptr);
#ifdef MK_DIAG
                __syncthreads(); { const float sc_ = 1.0f + ((const float*)(wq_ + WS_CTL + 64))[0]; float* o_ = cx.out(); const int lane_ = otid() & 63, gw_ = obid() * NWAVES + (otid() >> 6);
                  for (int r_ = gw_; r_ < T; r_ += gridDim.x * NWAVES) for (int j_ = 0; j_ < 16; ++j_) o_[(size_t)r_ * D + 64 * j_ + lane_] *= sc_; }
#endif
            } }
}

__device__ __forceinline__ void zero_lds_ctl(LAS unsigned char* lds) {
    for (int u = threadIdx.x; u < (LDS_BYTES - MISC_OFF) / 4; u += NTHR) ((LAS unsigned*)(lds + MISC_OFF))[u] = 0u;
    __syncthreads();
}
template <int K> __global__ void __launch_bounds__(NTHR, 2) mk_fwd(Args args) {
    extern __shared__ __attribute__((aligned(16))) unsigned char lds_raw[];
    LAS unsigned char* lds = (LAS unsigned char*)lds_raw;
    zero_lds_ctl(lds);
    CtxK cx{args};
    phase_body<K, CtxK>(cx, args.l, lds);
}
#if MK_ONE_LAUNCH
#if MK_ONE_LAUNCH == 2
#define phase_call_inl(K, l) do { extern __shared__ __attribute__((aligned(16))) unsigned char lds_raw2[]; CtxK cxk{args}; phase_body<K, CtxK>(cxk, l, (LAS unsigned char*)lds_raw2); } while (0)
template <int K> __device__ __forceinline__ void phase_call(int l) {
#else
template <int K> __device__ __attribute__((noinline)) void phase_call(int l) {
#endif
    extern __shared__ __attribute__((aligned(16))) unsigned char lds_raw[];
    LAS unsigned char* lds = (LAS unsigned char*)lds_raw;
    l = __builtin_amdgcn_readfirstlane(l);
    CtxL cx{lds};
    phase_body<K, CtxL>(cx, l, lds);
}
__global__ void __launch_bounds__(NTHR, 2) mk_one(Args args) {
    extern __shared__ __attribute__((aligned(16))) unsigned char lds_raw[];
    LAS unsigned char* lds = (LAS unsigned char*)lds_raw;
    zero_lds_ctl(lds);
#if MK_ONE_LAUNCH == 1
    if (threadIdx.x == 0) { LAS unsigned long long* la = (LAS unsigned long long*)(lds + ARGS_OFF);
#pragma unroll
        for (int i = 0; i < 24; ++i) la[i] = (unsigned long long)args.in[i];
        la[24] = (unsigned long long)args.out; la[25] = (unsigned long long)args.ws; }
    __syncthreads();
#endif
    volatile LAS unsigned* MISC = (volatile LAS unsigned*)(lds + MISC_OFF);
    unsigned* ctl = (unsigned*)((unsigned char*)(GAS unsigned char*)args.ws + WS_CTL);
    (void)xcd_barrier_post(ctl + CW_BAR, MISC + 8);
#ifndef MK_BAR2
#define MK_BAR2 0
#endif
#define GRID_BAR() do { GRID_BAR1(); if (MK_BAR2) GRID_BAR1(); } while (0)
#define GRID_BAR1() do { XcdBarrier bb_; bb_.bar = (unsigned*)((unsigned char*)(GAS unsigned char*)args.ws + WS_CTL) + CW_BAR; bb_.x = xb_xcc_id(); bb_.st = (volatile LAS unsigned*)(lds + MISC_OFF) + 8; xcd_barrier(bb_); } while (0)
#ifndef MK_PHMASK
#define MK_PHMASK 0xfffff
#endif
#if MK_ONE_LAUNCH == 2
#ifndef MK_REPEAT
#define MK_REPEAT 0
#endif
#define PH(K) do { if ((MK_PHMASK >> K) & 1) { phase_call_inl(K, l); if ((MK_REPEAT >> K) & 1) { __syncthreads(); phase_call_inl(K, l); } GRID_BAR(); } } while (0)
#else
#define PH(K) do { if ((MK_PHMASK >> K) & 1) { phase_call<K>(l); GRID_BAR(); } } while (0)
#endif
    { const int l = 0; PH(0); PH(19); }
#pragma unroll 1
    for (int l = 0; l < DEPTH; ++l) {
#if MK_ONE_LAUNCH == 2
        PH(1); PH(2); PH(3); PH(4); PH(5); PH(6);
        phase_call_inl(10, l); __syncthreads();
        if ((MK_REPEAT >> 10) & 1) { phase_call_inl(10, l); __syncthreads(); }
        phase_call_inl(7, l); GRID_BAR();
        phase_call_inl(8, l); __syncthreads(); phase_call_inl(11, l); GRID_BAR();
        PH(9); PH(12); PH(13); PH(14); PH(15); PH(16); PH(17);
#else
        PH(1); PH(2); PH(3); PH(4); PH(5); PH(6); PH(7); PH(8); PH(9); PH(10); PH(11); PH(12); PH(13); PH(14); PH(15); PH(16); PH(17);
#endif
#if MK_ONE_LAUNCH == 2
        phase_call_inl(18, l);
#else
        phase_call<18>(l);
#endif
        if (l + 1 < DEPTH) GRID_BAR();
    }
#undef PH
}
#endif

#define MK_PHASES(X) X(0) X(1) X(2) X(3) X(4) X(5) X(6) X(7) X(8) X(9) X(10) X(11) X(12) X(13) X(14) X(15) X(16) X(17) X(18) X(19)
#if !MK_ONE_LAUNCH
static void launch_phase(int k, int grid, hipStream_t stream, const Args& a) {
    switch (k) {
#define X(K) case K: hipLaunchKernelGGL(mk_fwd<K>, dim3(grid), dim3(NTHR), LDS_BYTES, stream, a); break;
        MK_PHASES(X)
#undef X
        default: break;
    }
}
#endif
static bool set_lds_attr() {
    bool ok = true;
#if MK_ONE_LAUNCH
    ok = ok && (hipFuncSetAttribute((const void*)mk_one, hipFuncAttributeMaxDynamicSharedMemorySize, LDS_BYTES) == hipSuccess);
#else
#define X(K) ok = ok && (hipFuncSetAttribute((const void*)mk_fwd<K>, hipFuncAttributeMaxDynamicSharedMemorySize, LDS_BYTES) == hipSuccess);
    MK_PHASES(X)
#undef X
#endif
    return ok;
}
extern "C" void kernel_launch(void* const* d_in, const int* in_sizes, int n_in, void* d_out, int out_size, void* d_ws, size_t ws_size, hipStream_t stream) {
    static int grid = 0;
    if (grid == 0) {
        if (n_in != 24 || out_size != T * D || ws_size < WS_END) { fprintf(stderr, "kernel_launch: unexpected shapes (n_in %d out %d ws %zu)\n", n_in, out_size, ws_size); grid = -1; return; }
        int dev = 0, cus = 0;
        if (hipGetDevice(&dev) != hipSuccess || hipDeviceGetAttribute(&cus, hipDeviceAttributeMultiprocessorCount, dev) != hipSuccess) { grid = -1; return; }
        if (!set_lds_attr()) { fprintf(stderr, "kernel_launch: hipFuncSetAttribute failed\n"); grid = -1; return; }
        int per_cu = 0;
#if MK_ONE_LAUNCH
        if (hipOccupancyMaxActiveBlocksPerMultiprocessor(&per_cu, (const void*)mk_one, NTHR, LDS_BYTES) != hipSuccess || per_cu < 1) { fprintf(stderr, "kernel_launch: occupancy query reports %d\n", per_cu); grid = -1; return; }
#endif
        (void)hipGetLastError();
        grid = cus;
    }
    if (grid < 0) return;
    (void)hipMemsetAsync((char*)d_ws + WS_CTL, 0, CTL_ZERO_BYTES, stream);
    Args a{};
    for (int i = 0; i < 24; ++i) a.in[i] = (const float*)d_in[i];
    a.out = (float*)d_out; a.ws = (unsigned char*)d_ws;
#if MK_ONE_LAUNCH
    hipLaunchKernelGGL(mk_one, dim3(grid), dim3(NTHR), LDS_BYTES, stream, a);
#else
    for (int p = 0; p < DEPTH * NPH; ++p) {
        const int k = p % NPH, l = p / NPH;
        if (k == 0 && l > 0) continue;
        a.l = l;
        launch_phase(k, grid, stream, a);
        if (k == 0) launch_phase(19, grid, stream, a);
    }
#endif
}
```

```cpp
#define MK_ONE_LAUNCH 2
#define ATB_MAP 2
#include <hip/hip_runtime.h>
#include <cstdio>
#include <cstdint>
#define GAS __attribute__((address_space(1)))
#define LAS __attribute__((address_space(3)))
#ifndef MK_ONE_LAUNCH
#define MK_ONE_LAUNCH 0
#endif
namespace pg8 {
#define PG8_LAS __attribute__((address_space(3)))
typedef unsigned short bf16_t;
typedef short bf16x8 __attribute__((ext_vector_type(8)));
typedef float f32x4 __attribute__((ext_vector_type(4)));
typedef unsigned u32x4 __attribute__((ext_vector_type(4)));
constexpr int BM = 256, BK = 64, HALF = 128, HTB = HALF * BK * 2  , STAGE_BYTES = 8 * HTB, NXCD = 8, WGM = 8;

__host__ __device__ __forceinline__ int lds_byte(int r, int c) { const int st = (r >> 4) * 2 + (c >> 5), rr = r & 15, cc = c & 31, ob = rr * 64 + cc * 2; return st * 1024 + (ob ^ (((ob >> 9) & 1) << 5)); }
__host__ __device__ __forceinline__ void stage_rc(int b, int& R, int& C) { const int st = b / 1024, sb = b % 1024, swz = sb ^ (((sb >> 9) & 1) << 5); R = (st >> 1) * 16 + swz / 64; C = (st & 1) * 32 + (swz % 64) / 2; }
__host__ __device__ __forceinline__ int perm32(int rho) { const int n = rho >> 4, i = rho & 15; return 8 * (i >> 2) + 4 * n + (i & 3); }

struct Unit { int pm, pn; };
struct Gemm { const bf16_t* A; const bf16_t* Bt; int M, N, K; };

struct StaticOrder {
    int nM, nN, nwg, G, c;
    __host__ __device__ void init(int M, int N, int G_, int c_) { nM = M / BM; nN = N / BM; nwg = nM * nN; G = G_; c = c_; }
    __host__ __device__ bool next(int i, Unit& u) const {
        const long L = (long)i * G + c; if (L >= nwg) return false;
        int wgid = (int)L; { const int q = nwg / NXCD, r = nwg % NXCD, xcd = wgid % NXCD, off = wgid / NXCD; wgid = (xcd < r ? xcd * (q + 1) : r * (q + 1) + (xcd - r) * q) + off; }
        const int nig = WGM * nN, gid = wgid / nig, fm = gid * WGM, gsz = (nM - fm) < WGM ? (nM - fm) : WGM;
        u.pm = fm + ((wgid % nig) % gsz); u.pn = (wgid % nig) / gsz; return true;
    }
    __device__ __forceinline__ void a_ready(const Unit&) const {}
    __device__ __forceinline__ void done(const Unit&) const {}
};

typedef float f32x2_t_ __attribute__((ext_vector_type(2))); typedef __bf16 bf16x2_t_ __attribute__((ext_vector_type(2)));
__device__ __forceinline__ unsigned cvt_pk_bf16(float lo, float hi) { const f32x2_t_ v = {lo, hi}; const bf16x2_t_ b = __builtin_convertvector(v, bf16x2_t_); return __builtin_bit_cast(unsigned, b); }
typedef float f32x2 __attribute__((ext_vector_type(2)));
__device__ __forceinline__ float bflo(unsigned w) { return __uint_as_float(w << 16); }
__device__ __forceinline__ float bfhi(unsigned w) { return __uint_as_float(w & 0xffff0000u); }
__device__ __forceinline__ u32x4 pack8(const f32x4 a, const f32x4 b) { u32x4 w; w.x = cvt_pk_bf16(a[0], a[1]); w.y = cvt_pk_bf16(a[2], a[3]); w.z = cvt_pk_bf16(b[0], b[1]); w.w = cvt_pk_bf16(b[2], b[3]); return w; }
__device__ __forceinline__ float fast_sigmoid(float x) { return __builtin_amdgcn_rcpf(1.0f + __expf(-x)); }

struct EpiSwiglu {
    static constexpr bool PERM = true, AFTER_DRAIN = false;
    bf16_t* O; int ldc; const float* rs; const float* cm;
    __device__ __forceinline__ void operator()(const f32x4 (&acc)[2][2][4][2], const Unit& u, int wr, int wc, int fr, int fq) const {
        const int row0 = u.pm * BM + wr * 64 + fr, col0 = u.pn * HALF + wc * 32 + 8 * fq;
        f32x4 sg0 = (f32x4){1.f, 1.f, 1.f, 1.f}, sg1 = sg0, su0 = sg0, su1 = sg0;
        float srow[2][4];
#pragma unroll
        for (int ai = 0; ai < 2; ++ai)
#pragma unroll
            for (int m = 0; m < 4; ++m) srow[ai][m] = rs ? rs[row0 + ai * HALF + m * 16] : 1.0f;
        if (rs) { const float k = 1.0f / 127.0f; sg0 = *(const f32x4*)(cm + col0) * k; sg1 = *(const f32x4*)(cm + col0 + 4) * k; su0 = *(const f32x4*)(cm + ldc + col0) * k; su1 = *(const f32x4*)(cm + ldc + col0 + 4) * k; }
#pragma unroll
        for (int ai = 0; ai < 2; ++ai)
#pragma unroll
            for (int m = 0; m < 4; ++m) { bf16_t* rowp = O + (size_t)(row0 + ai * HALF + m * 16) * ldc + col0;
                const float sc = srow[ai][m];
                f32x4 o0, o1;
#pragma unroll
                for (int j = 0; j < 4; ++j) { const float g0 = acc[ai][0][m][0][j] * (sc * sg0[j]), g1 = acc[ai][0][m][1][j] * (sc * sg1[j]);
                    o0[j] = g0 * fast_sigmoid(g0) * (acc[ai][1][m][0][j] * (sc * su0[j])); o1[j] = g1 * fast_sigmoid(g1) * (acc[ai][1][m][1][j] * (sc * su1[j])); }
                *(u32x4*)rowp = pack8(o0, o1); asm volatile("" ::: "memory"); }
    }
};
struct EpiStore {
    static constexpr bool PERM = true, AFTER_DRAIN = false;
    bf16_t* O; int ldc;
    __device__ __forceinline__ void operator()(const f32x4 (&acc)[2][2][4][2], const Unit& u, int wr, int wc, int fr, int fq) const {
        const int row0 = u.pm * BM + wr * 64 + fr, col0 = u.pn * BM + wc * 32 + 8 * fq;
#pragma unroll
        for (int ai = 0; ai < 2; ++ai)
#pragma unroll
            for (int m = 0; m < 4; ++m) { bf16_t* rowp = O + (size_t)(row0 + ai * HALF + m * 16) * ldc + col0;
#pragma unroll
                for (int bj = 0; bj < 2; ++bj) *(u32x4*)(rowp + bj * HALF) = pack8(acc[ai][bj][m][0], acc[ai][bj][m][1]); }
    }
};
enum { PM_PLAIN = 0, PM_ROPE64 = 1, PM_ROPE16 = 2, PM_SIGMOID = 3 };
template <int RANGE> __device__ __forceinline__ int proj_mode(int gcol) {
    if (RANGE == 0) return gcol < 1536 ? PM_ROPE64 : PM_PLAIN;
    if (RANGE == 1) { if (gcol < 256) return PM_PLAIN; const int g2 = gcol - 256;
        return g2 < 128 ? PM_ROPE16 : (g2 < 704 ? PM_ROPE64 : PM_PLAIN); }
    return PM_SIGMOID;
}
template <int RANGE> struct EpiProj {
    static constexpr bool PERM = true, AFTER_DRAIN = false;
    bf16_t* d0; int ld0; int nt0; bf16_t* d1; int ld1; const float* cs; const float* bias; const float* rs; const float* wsc;
    __device__ __forceinline__ void operator()(const f32x4 (&acc)[2][2][4][2], const Unit& u, int wr, int wc, int fr, int fq) const {
        const int row0 = u.pm * BM + wr * 64 + fr;
        bf16_t* dbase; int ld;
        if (u.pn < nt0) { dbase = d0 + u.pn * BM; ld = ld0; } else { dbase = d1 + (u.pn - nt0) * BM; ld = ld1; }
        float srow[2][4];
#pragma unroll
        for (int ai = 0; ai < 2; ++ai)
#pragma unroll
            for (int m = 0; m < 4; ++m) srow[ai][m] = rs ? rs[row0 + ai * HALF + m * 16] : 1.0f;
        int mode[2]; bool rope[2], lane_rope[2]; f32x4 qa[2], qb[2], ba[2], bb[2];
#pragma unroll
        for (int bj = 0; bj < 2; ++bj) { const int gcol = u.pn * BM + bj * HALF + wc * 32;
            mode[bj] = proj_mode<RANGE>(gcol);
            rope[bj] = (mode[bj] == PM_ROPE16) || (mode[bj] == PM_ROPE64 && (wc & 1) == 0);
            lane_rope[bj] = (mode[bj] == PM_ROPE16) || (fq < 2);
            qa[bj] = (f32x4){1.f, 1.f, 1.f, 1.f}; qb[bj] = qa[bj]; ba[bj] = (f32x4){0.f, 0.f, 0.f, 0.f}; bb[bj] = ba[bj];
            if (rs) { qa[bj] = *(const f32x4*)(wsc + gcol + 8 * fq); qb[bj] = *(const f32x4*)(wsc + gcol + 8 * fq + 4); }
#ifndef MK_NOBIAS
            if (mode[bj] == PM_SIGMOID) { ba[bj] = *(const f32x4*)(bias + gcol + 8 * fq); bb[bj] = *(const f32x4*)(bias + gcol + 8 * fq + 4); }
#endif
        }
        const bool any_rope = rope[0] | rope[1];
        f32x4 cc[2][4];
        if (any_rope) {
#pragma unroll
            for (int k = 0; k < 4; ++k) cc[0][k] = *(const f32x4*)(cs + (size_t)row0 * 16 + 4 * k); }
        const float sg = (fq & 1) ? 1.0f : -1.0f;
#pragma unroll
        for (int gi = 0; gi < 8; ++gi) { const int ai = gi >> 2, m = gi & 3; const int r = row0 + ai * HALF + m * 16;
            if (any_rope && gi + 1 < 8) { const int rn = row0 + ((gi + 1) >> 2) * HALF + ((gi + 1) & 3) * 16;
#pragma unroll
                for (int k = 0; k < 4; ++k) cc[(gi + 1) & 1][k] = *(const f32x4*)(cs + (size_t)rn * 16 + 4 * k); }
#pragma unroll
            for (int bj = 0; bj < 2; ++bj) {
                f32x4 v0 = acc[ai][bj][m][0], v1 = acc[ai][bj][m][1];
                if (rs) { const float sr = srow[ai][m]; v0 = v0 * (qa[bj] * sr); v1 = v1 * (qb[bj] * sr); }
                if (rope[bj]) { const f32x4 c0 = cc[gi & 1][0], c1 = cc[gi & 1][1], s0 = cc[gi & 1][2], s1 = cc[gi & 1][3]; f32x4 p0, p1;
#pragma unroll
                    for (int j = 0; j < 4; ++j) { p0[j] = __shfl_xor(v0[j], 16); p1[j] = __shfl_xor(v1[j], 16); }
                    if (lane_rope[bj]) { v0 = v0 * c0 + sg * (p0 * s0); v1 = v1 * c1 + sg * (p1 * s1); } }
                if (mode[bj] == PM_SIGMOID) {
#pragma unroll
                    for (int j = 0; j < 4; ++j) { v0[j] = fast_sigmoid(v0[j] + ba[bj][j]); v1[j] = fast_sigmoid(v1[j] + bb[bj][j]); } }
                *(u32x4*)(dbase + (size_t)r * ld + bj * HALF + wc * 32 + 8 * fq) = pack8(v0, v1); }
            asm volatile("" ::: "memory"); }
    }
};
template <bool FIRST> struct EpiMerge {
    static constexpr bool PERM = true, AFTER_DRAIN = false;
    bf16_t* O; int ldc; const bf16_t* G; int ldg; int gcol; const float* rs; const float* wsc;
    __device__ __forceinline__ void operator()(const f32x4 (&acc)[2][2][4][2], const Unit& u, int wr, int wc, int fr, int fq) const {
        const int row0 = u.pm * BM + wr * 64 + fr, col0 = u.pn * BM + wc * 32 + 8 * fq;
        float srow[2][4]; f32x4 qa[2], qb[2];
#pragma unroll
        for (int ai = 0; ai < 2; ++ai)
#pragma unroll
            for (int m = 0; m < 4; ++m) srow[ai][m] = rs ? rs[row0 + ai * HALF + m * 16] : 1.0f;
#pragma unroll
        for (int bj = 0; bj < 2; ++bj) { qa[bj] = (f32x4){1.f, 1.f, 1.f, 1.f}; qb[bj] = qa[bj]; if (rs) { qa[bj] = *(const f32x4*)(wsc + col0 + bj * HALF); qb[bj] = *(const f32x4*)(wsc + col0 + bj * HALF + 4); } }
        u32x4 gq[2], pq[2];
        gq[0] = *(const u32x4*)(G + (size_t)row0 * ldg + gcol + col0);
        if (!FIRST) pq[0] = *(const u32x4*)(O + (size_t)row0 * ldc + col0);
#pragma unroll
        for (int i = 0; i < 16; ++i) { const int ai = i >> 3, m = (i >> 1) & 3, bj = i & 1; const int r = row0 + ai * HALF + m * 16;
            if (i + 1 < 16) { const int an = (i + 1) >> 3, mn = ((i + 1) >> 1) & 3, bn = (i + 1) & 1; const int rn = row0 + an * HALF + mn * 16;
                gq[(i + 1) & 1] = *(const u32x4*)(G + (size_t)rn * ldg + gcol + col0 + bn * HALF);
                if (!FIRST) pq[(i + 1) & 1] = *(const u32x4*)(O + (size_t)rn * ldc + col0 + bn * HALF); }
            const u32x4 g = gq[i & 1];
            f32x4 a0 = acc[ai][bj][m][0], a1 = acc[ai][bj][m][1];
            if (rs) { a0 = a0 * (qa[bj] * srow[ai][m]); a1 = a1 * (qb[bj] * srow[ai][m]); }
            f32x4 o0, o1;
            o0[0] = bflo(g.x) * a0[0]; o0[1] = bfhi(g.x) * a0[1]; o0[2] = bflo(g.y) * a0[2]; o0[3] = bfhi(g.y) * a0[3];
            o1[0] = bflo(g.z) * a1[0]; o1[1] = bfhi(g.z) * a1[1]; o1[2] = bflo(g.w) * a1[2]; o1[3] = bfhi(g.w) * a1[3];
            bf16_t* op = O + (size_t)r * ldc + col0 + bj * HALF;
            if (!FIRST) { const u32x4 p = pq[i & 1];
                o0[0] += bflo(p.x); o0[1] += bfhi(p.x); o0[2] += bflo(p.y); o0[3] += bfhi(p.y); o1[0] += bflo(p.z); o1[1] += bfhi(p.z); o1[2] += bflo(p.w); o1[3] += bfhi(p.w); }
            *(u32x4*)op = pack8(o0, o1); asm volatile("" ::: "memory"); }
    }
};

typedef int i32x4 __attribute__((ext_vector_type(4)));
template <bool I8> __device__ __forceinline__ f32x4 mma_step(bf16x8 a, bf16x8 b, f32x4 c) {
    if constexpr (I8) return __builtin_bit_cast(f32x4, __builtin_amdgcn_mfma_i32_16x16x64_i8(__builtin_bit_cast(i32x4, a), __builtin_bit_cast(i32x4, b), __builtin_bit_cast(i32x4, c), 0, 0, 0));
    else return __builtin_amdgcn_mfma_f32_16x16x32_bf16(a, b, c, 0, 0, 0);
}
template <class Epi, class Sched, bool ALIGN_EPI = false, bool SP2 = false, bool I8 = false>
__device__ __forceinline__ void gemm_phase(PG8_LAS unsigned char* lds, const Gemm g, const Sched& S, const Epi& E) {
    int tid_o = threadIdx.x; asm volatile("" : "+v"(tid_o));
    const int tid = tid_o, wid = __builtin_amdgcn_readfirstlane(tid >> 6), lane = tid & 63, wr = wid >> 2, wc = wid & 3, fr = lane & 15, fq = lane >> 4;
    const int K = g.K, nt = K / BK;
    unsigned voffA[2], voffB[2];
#pragma unroll
    for (int i = 0; i < 2; ++i) { int R, C; stage_rc(tid * 16 + i * 8192, R, C); const int Rb = Epi::PERM ? ((R & ~31) + perm32(R & 31)) : R;
        voffA[i] = (unsigned)(R * K + C) * 2u; voffB[i] = (unsigned)(Rb * K + C) * 2u; }
    const size_t kstep = (size_t)(BK * 2);
    const size_t hstep = (size_t)HALF * K * 2;
    const size_t tstep = 2 * hstep;
    const unsigned ldsw = (unsigned)wid * 1024u;
    const int aoff = lds_byte(wr * 64 + fr, fq * 8), boff = lds_byte(wc * 32 + fr, fq * 8);
#define PG8_SA(b, h) (((b) * 2 + (h)) * HTB)
#define PG8_SB(b, h) ((4 + (b) * 2 + (h)) * HTB)
#define PG8_STAGE(bufoff, gbase, voff) do { _Pragma("unroll") for (int _i = 0; _i < 2; ++_i) \
        __builtin_amdgcn_global_load_lds((const unsigned*)((const char*)(gbase) + (voff)[_i]), (PG8_LAS unsigned*)(lds + (bufoff) + ldsw + _i * 8192), 16, 0, 0); } while (0)
#define PG8_LDA(dst, b, h) do { _Pragma("unroll") for (int m = 0; m < 4; ++m) _Pragma("unroll") for (int k = 0; k < 2; ++k) dst[m][k] = *(const PG8_LAS bf16x8*)(lds + PG8_SA(b, h) + aoff + m * 2048 + k * 1024); } while (0)
#define PG8_LDB(dst, b, h) do { _Pragma("unroll") for (int n = 0; n < 2; ++n) _Pragma("unroll") for (int k = 0; k < 2; ++k) dst[n][k] = *(const PG8_LAS bf16x8*)(lds + PG8_SB(b, h) + boff + n * 2048 + k * 1024); } while (0)
#define PG8_MMA(ai, bj, At, Bt) do { __builtin_amdgcn_s_setprio(1); _Pragma("unroll") for (int m = 0; m < 4; ++m) _Pragma("unroll") for (int n = 0; n < 2; ++n) _Pragma("unroll") for (int k = 0; k < 2; ++k) \
        acc[ai][bj][m][n] = mma_step<I8>(Bt[n][k], At[m][k], acc[ai][bj][m][n]); __builtin_amdgcn_s_setprio(0); } while (0)
#define PG8_WAIT_V(n) asm volatile("s_waitcnt vmcnt(" #n ")" ::: "memory")
#define PG8_WAIT_L(n) asm volatile("s_waitcnt lgkmcnt(" #n ")" ::: "memory")
#define PG8_BAR __builtin_amdgcn_s_barrier()
#define PG8_SCHED __builtin_amdgcn_sched_barrier(0)
    Unit cur, nxt; int ui = 0;
    if (!S.next(0, cur)) return;
    f32x4 acc[2][2][4][2];
#pragma unroll
    for (int a = 0; a < 2; ++a)
#pragma unroll
        for (int b = 0; b < 2; ++b)
#pragma unroll
            for (int m = 0; m < 4; ++m)
#pragma unroll
                for (int n = 0; n < 2; ++n) acc[a][b][m][n] = (f32x4){0.f, 0.f, 0.f, 0.f};
    bf16x8 At[4][2], B0[2][2], B1[2][2];
    const char* cA = (const char*)g.A + (size_t)cur.pm * tstep; const char* cB = (const char*)g.Bt + (size_t)cur.pn * tstep;
    S.a_ready(cur);
    if constexpr (SP2) {
        PG8_STAGE(PG8_SB(0, 0), cB, voffB); PG8_STAGE(PG8_SB(0, 1), cB + hstep, voffB); PG8_STAGE(PG8_SA(0, 0), cA, voffA); PG8_STAGE(PG8_SA(0, 1), cA + hstep, voffA);
        if (wr == 1) PG8_BAR;
        PG8_WAIT_V(2); PG8_BAR;
        PG8_STAGE(PG8_SB(1, 0), cB + kstep, voffB); PG8_STAGE(PG8_SA(1, 0), cA + kstep, voffA); PG8_STAGE(PG8_SB(1, 1), cB + hstep + kstep, voffB);
        PG8_WAIT_V(6); PG8_BAR;
    } else {
        PG8_STAGE(PG8_SB(0, 0), cB, voffB); PG8_STAGE(PG8_SA(0, 0), cA, voffA); PG8_STAGE(PG8_SB(0, 1), cB + hstep, voffB); PG8_STAGE(PG8_SA(0, 1), cA + hstep, voffA);
        if (wr == 1) PG8_BAR;
        PG8_WAIT_V(4); PG8_BAR;
        PG8_STAGE(PG8_SB(1, 0), cB + kstep, voffB); PG8_STAGE(PG8_SA(1, 0), cA + kstep, voffA); PG8_STAGE(PG8_SB(1, 1), cB + hstep + kstep, voffB);
        PG8_WAIT_V(6); PG8_BAR;
    }
    for (;;) {
        const bool has_next = S.next(ui + 1, nxt);
        const char* nA = has_next ? (const char*)g.A + (size_t)nxt.pm * tstep : cA; const char* nB = has_next ? (const char*)g.Bt + (size_t)nxt.pn * tstep : cB;
        for (int t = 0; t < nt; t += 2) {
            const bool last = (t == nt - 2);
            const char* a1 = cA + (size_t)(t + 1) * kstep;
            const char* a2 = last ? nA : cA + (size_t)(t + 2) * kstep; const char* b2 = last ? nB : cB + (size_t)(t + 2) * kstep;
            const char* a3 = a2 + kstep; const char* b3 = b2 + kstep;
            if (last && has_next) S.a_ready(nxt);
            if constexpr (SP2) {
            PG8_LDB(B0, 0, 0); PG8_LDB(B1, 0, 1); PG8_SCHED; PG8_LDA(At, 0, 0); PG8_STAGE(PG8_SA(1, 1), a1 + hstep, voffA);
            PG8_WAIT_V(8); PG8_WAIT_L(0); PG8_BAR; PG8_MMA(0, 0, At, B0); PG8_MMA(0, 1, At, B1); PG8_BAR; PG8_SCHED;
            PG8_LDA(At, 0, 1); PG8_STAGE(PG8_SB(0, 0), b2, voffB); PG8_STAGE(PG8_SB(0, 1), b2 + hstep, voffB); PG8_STAGE(PG8_SA(0, 0), a2, voffA);
            PG8_WAIT_V(8); PG8_WAIT_L(0); PG8_BAR; PG8_MMA(1, 0, At, B0); PG8_MMA(1, 1, At, B1); PG8_BAR; PG8_SCHED;
            PG8_LDB(B0, 1, 0); PG8_LDB(B1, 1, 1); PG8_SCHED; PG8_LDA(At, 1, 0); PG8_STAGE(PG8_SA(0, 1), a2 + hstep, voffA);
            PG8_WAIT_V(8); PG8_WAIT_L(0); PG8_BAR; PG8_MMA(0, 0, At, B0); PG8_MMA(0, 1, At, B1); PG8_BAR; PG8_SCHED;
            PG8_LDA(At, 1, 1); PG8_STAGE(PG8_SB(1, 0), b3, voffB); PG8_STAGE(PG8_SB(1, 1), b3 + hstep, voffB); PG8_STAGE(PG8_SA(1, 0), a3, voffA);
            PG8_WAIT_V(8); PG8_WAIT_L(0); PG8_BAR; PG8_MMA(1, 0, At, B0); PG8_MMA(1, 1, At, B1); PG8_BAR; PG8_SCHED;
            } else {
            PG8_LDB(B0, 0, 0); PG8_SCHED; PG8_LDA(At, 0, 0); PG8_STAGE(PG8_SA(1, 1), a1 + hstep, voffA);
            PG8_WAIT_L(8); PG8_BAR; PG8_WAIT_L(0); PG8_MMA(0, 0, At, B0); PG8_BAR; PG8_SCHED;
            PG8_LDB(B1, 0, 1); PG8_STAGE(PG8_SB(0, 0), b2, voffB);
            PG8_BAR; PG8_WAIT_L(0); PG8_MMA(0, 1, At, B1); PG8_BAR;
            PG8_LDA(At, 0, 1); PG8_STAGE(PG8_SA(0, 0), a2, voffA);
            PG8_BAR; PG8_WAIT_L(0); PG8_MMA(1, 0, At, B0); PG8_BAR; PG8_SCHED;
            PG8_STAGE(PG8_SB(0, 1), b2 + hstep, voffB);
            PG8_WAIT_V(6); PG8_BAR; PG8_MMA(1, 1, At, B1); PG8_BAR;
            PG8_LDB(B0, 1, 0); PG8_SCHED; PG8_LDA(At, 1, 0); PG8_STAGE(PG8_SA(0, 1), a2 + hstep, voffA);
            PG8_WAIT_L(8); PG8_BAR; PG8_WAIT_L(0); PG8_MMA(0, 0, At, B0); PG8_BAR; PG8_SCHED;
            PG8_LDB(B1, 1, 1); PG8_STAGE(PG8_SB(1, 0), b3, voffB);
            PG8_BAR; PG8_WAIT_L(0); PG8_MMA(0, 1, At, B1); PG8_BAR;
            PG8_LDA(At, 1, 1); PG8_STAGE(PG8_SA(1, 0), a3, voffA);
            PG8_BAR; PG8_WAIT_L(0); PG8_MMA(1, 0, At, B0); PG8_BAR; PG8_SCHED;
            PG8_STAGE(PG8_SB(1, 1), b3 + hstep, voffB);
            PG8_WAIT_V(6); PG8_BAR; PG8_MMA(1, 1, At, B1); PG8_BAR;
            }
        }
        if constexpr (ALIGN_EPI) { if (wr == 0) PG8_BAR; }
        if constexpr (I8) {
#pragma unroll
            for (int a = 0; a < 2; ++a)
#pragma unroll
                for (int b = 0; b < 2; ++b)
#pragma unroll
                    for (int m = 0; m < 4; ++m)
#pragma unroll
                        for (int n = 0; n < 2; ++n) acc[a][b][m][n] = __builtin_convertvector(__builtin_bit_cast(i32x4, acc[a][b][m][n]), f32x4); }
        if constexpr (!Epi::AFTER_DRAIN) { E(acc, cur, wr, wc, fr, fq); S.done(cur); }
        if (!has_next) break;
#pragma unroll
        for (int a = 0; a < 2; ++a)
#pragma unroll
            for (int b = 0; b < 2; ++b)
#pragma unroll
                for (int m = 0; m < 4; ++m)
#pragma unroll
                    for (int n = 0; n < 2; ++n) acc[a][b][m][n] = (f32x4){0.f, 0.f, 0.f, 0.f};
        cur = nxt; cA = nA; cB = nB; ++ui;
        if constexpr (ALIGN_EPI) { if (wr == 1) PG8_BAR; }
    }
    PG8_WAIT_V(0);
    if constexpr (!ALIGN_EPI) { if (wr == 0) PG8_BAR; }
    PG8_BAR;
    if constexpr (Epi::AFTER_DRAIN) { E.fused(acc, cur, wr, wc, fr, fq, lds, wid, lane); S.done(cur); }
#undef PG8_SA
#undef PG8_SB
#undef PG8_STAGE
#undef PG8_LDA
#undef PG8_LDB
#undef PG8_MMA
#undef PG8_WAIT_V
#undef PG8_WAIT_L
#undef PG8_BAR
#undef PG8_SCHED
}
}
#define XB_TMO      128
#define XB_XCNT(j)  (256  + 64 * (j))
#define XB_XSUB(j)  (1280 + 64 * (j))
#define XB_XGEN(j)  (2304 + 64 * (j))
#define XB_TOP      3328
#define XB_TOPGEN   3392
#define XCD_BAR_WORDS 3456
#define XB_SPIN_CAP (1u << 18)

__device__ __forceinline__ unsigned xb_ld(unsigned* p)              { return __hip_atomic_load(p, __ATOMIC_RELAXED, __HIP_MEMORY_SCOPE_AGENT); }
__device__ __forceinline__ unsigned xb_add(unsigned* p, unsigned v) { return __hip_atomic_fetch_add(p, v, __ATOMIC_RELAXED, __HIP_MEMORY_SCOPE_AGENT); }
__device__ __forceinline__ unsigned xb_xcc_id() { return (unsigned)__builtin_amdgcn_s_getreg((3 << 11) | 20) & 0xFu; }
#define XB_SPIN(cond, bar) do { unsigned _sp = 0; while (cond) { __builtin_amdgcn_s_sleep(1); \
    if ((++_sp & 255u) == 0u) { if (xb_ld(&(bar)[XB_TMO])) break; if (_sp > XB_SPIN_CAP) { atomicAdd(&(bar)[XB_TMO], 1u); break; } } } } while (0)

struct XcdBarrier {
    unsigned* bar; unsigned x;
    volatile LAS unsigned* st;
};

__device__ __forceinline__ XcdBarrier xcd_barrier_post(unsigned* bar, volatile LAS unsigned* st) {
    XcdBarrier b; b.bar = bar; b.x = xb_xcc_id(); b.st = st;
    if (threadIdx.x == 0) (void)xb_add(&bar[XB_XCNT(b.x)], 1u);
    return b;
}
__device__ __forceinline__ void xcd_barrier_complete(unsigned* bar, unsigned x, unsigned& nloc, unsigned& nx) {
    const unsigned G = gridDim.x * gridDim.y * gridDim.z;
    unsigned sum, cnt, mine, sp = 0u;
    for (;;) {
        sum = 0u; cnt = 0u; mine = 0u;
#pragma unroll
        for (unsigned j = 0; j < 16; ++j) { const unsigned c = xb_ld(&bar[XB_XCNT(j)]); sum += c; cnt += (c > 0u) ? 1u : 0u; mine = (j == x) ? c : mine; }
        if (sum == G) break;
        __builtin_amdgcn_s_sleep(1);
        if ((++sp & 255u) == 0u) { if (xb_ld(&bar[XB_TMO])) break; if (sp > XB_SPIN_CAP) { atomicAdd(&bar[XB_TMO], 1u); break; } }
    }
    nloc = mine > 0u ? mine : 1u; nx = cnt > 0u ? cnt : 1u;
}

__device__ __forceinline__ void xcd_barrier(const XcdBarrier& b) {
    asm volatile("s_waitcnt vmcnt(0)" ::: "memory");
    __syncthreads();
    if (threadIdx.x == 0) {
        unsigned* bar = b.bar;
        __builtin_amdgcn_s_waitcnt(0);
        unsigned nloc = b.st[0], nx = b.st[1];
        if (nloc == 0u) { xcd_barrier_complete(bar, b.x, nloc, nx); b.st[0] = nloc; b.st[1] = nx; }
        const unsigned old = xb_add(&bar[XB_XSUB(b.x)], 1u);
        const unsigned gen = old / nloc;
        if (old + 1u == (gen + 1u) * nloc) {
            __builtin_amdgcn_fence(__ATOMIC_RELEASE, "agent");
            asm volatile("s_waitcnt vmcnt(0)" ::: "memory");
            const unsigned og = xb_add(&bar[XB_TOP], 1u);
            const unsigned tg = og / nx;
            if (og + 1u == (tg + 1u) * nx) xb_add(&bar[XB_TOPGEN], 1u);
            else XB_SPIN(xb_ld(&bar[XB_TOPGEN]) == tg, bar);
            __builtin_amdgcn_fence(__ATOMIC_ACQUIRE, "agent");
            xb_add(&bar[XB_XGEN(b.x)], 1u);
            asm volatile("s_waitcnt vmcnt(0)" ::: "memory");
        } else {
            XB_SPIN(xb_ld(&bar[XB_XGEN(b.x)]) == gen, bar);
            __builtin_amdgcn_fence(__ATOMIC_ACQUIRE, "agent");
            asm volatile("s_waitcnt vmcnt(0)" ::: "memory");
        }
    }
    __syncthreads();
}
typedef unsigned short bf16;
typedef unsigned v4u __attribute__((ext_vector_type(4)));
typedef unsigned v2u __attribute__((ext_vector_type(2)));
typedef float f32x4 __attribute__((ext_vector_type(4)));
typedef short bf16x8 __attribute__((ext_vector_type(8)));
constexpr int NB = 2, S = 8192, T = NB * S, D = 1024, DEPTH = 2, DFF = 2816, DIN = 5080;
constexpr int NWAVES = 8, NTHR = 512;
#ifndef MK_FAKEQ
#define MK_FAKEQ 0
#endif
constexpr float RMS_EPS = 1e-6f;
constexpr int WI_AQ = 0, WI_CKV = 512, WI_IQ = 640, WI_IK = 1152, WI_IW = 1216, WI_BQKV = 1224, WI_CQ = 3528, WI_CK = 3784, WI_CV = 4040, WI_CG = 4552, WI_CA = 5064;
constexpr int NBIG = 9216, RB0 = 0, NRB = 3072, RAC0 = 3072, NRAC = 3072, RG0 = 6144, NRG = 3072;
constexpr int LA2 = 2816, A2_QR = 0, A2_IQ = 128, A2_IK = 640, A2_IW = 704, A2_CKV = 768, A2_KR = 896, A2_CQ = 1024, A2_CK = 1280, A2_CV = 1536, A2_CG = 2048, A2_CAL = 2560;
constexpr int LPB = 2304;
constexpr float QSCALE = 0.18033688011112042f;

constexpr size_t MiB = 1u << 20;
constexpr size_t WS_CTL = 0, CTL_ZERO_BYTES = 1 * MiB;
constexpr size_t WS_W = 1 * MiB;
constexpr size_t WS_CS = 25 * MiB;
constexpr size_t WS_XN = 26 * MiB;
constexpr size_t WS_FB = 58 * MiB;
constexpr size_t WS_YB = 90 * MiB;
constexpr size_t WS_YA = 98 * MiB;
constexpr size_t WS_YC = 130 * MiB;
constexpr size_t WS_BIG = 146 * MiB;
constexpr size_t WS_DEC = 242 * MiB;
constexpr size_t WS_MW = 243 * MiB;
constexpr size_t WS_END = 253 * MiB;
constexpr int NMW = 2432;
constexpr size_t WS_YA8 = 130 * MiB;
constexpr int CW_MWMAX = 8192;
constexpr size_t WO_W1 = 0, WO_W2 = (size_t)2 * DFF * D;
constexpr size_t WO_BIG = 0, WO_MA = (size_t)NBIG * D, WO_MB = WO_MA + (size_t)D * 1024, WO_MC = WO_MB + (size_t)D * 256, WO_WO = WO_MC + (size_t)D * 512;
static_assert((WO_WO + (size_t)D * D) * 2 <= 24 * MiB && (WO_W2 + (size_t)D * DFF) * 2 <= 24 * MiB, "weights region");
constexpr int CW_BAR = 4096;

constexpr int RING_BYTES = 131072, LDS_BYTES = 163840, MISC_OFF = LDS_BYTES - 1024;

#define RLX_AGENT __ATOMIC_RELAXED, __HIP_MEMORY_SCOPE_AGENT
#define LDS_WAIT() asm volatile("s_waitcnt lgkmcnt(0)" ::: "memory")
#define VM_WAIT() asm volatile("s_waitcnt vmcnt(0)" ::: "memory")
__device__ __forceinline__ unsigned char* opaque_ptr(unsigned char* p) { GAS unsigned char* g = (GAS unsigned char*)p; asm volatile("" : "+s"(g)); return (unsigned char*)g; }
__device__ __forceinline__ int otid() { int t = threadIdx.x; asm volatile("" : "+v"(t)); return t; }
__device__ __forceinline__ int obid() { int b = blockIdx.x; asm volatile("" : "+s"(b)); return b; }
__device__ __forceinline__ unsigned f2bf(float f) { unsigned u = __builtin_bit_cast(unsigned, f); return (u + 0x7fffu + ((u >> 16) & 1u)) >> 16; }
__device__ __forceinline__ unsigned pk2(float lo, float hi) { return f2bf(lo) | (f2bf(hi) << 16); }
__device__ __forceinline__ float bf2f(bf16 v) { return __uint_as_float((unsigned)v << 16); }
__device__ __forceinline__ float blo(unsigned w) { return __uint_as_float(w << 16); }
__device__ __forceinline__ float bhi(unsigned w) { return __uint_as_float(w & 0xffff0000u); }
__device__ __forceinline__ float wave_sum(float v) {
#pragma unroll
    for (int o = 1; o < 64; o <<= 1) v += __shfl_xor(v, o);
    return v;
}
__device__ __forceinline__ float wave_max(float v) {
#pragma unroll
    for (int o = 1; o < 64; o <<= 1) v = fmaxf(v, __shfl_xor(v, o));
    return v;
}

struct Args {
    const float* in[24]; float* out; unsigned char* ws; int l, pad;
};
enum { I_X = 0, I_POS, I_F1PRE, I_F1WIN, I_F1WOUT, I_F1POST, I_MIXPRE, I_WIN, I_AKVG, I_AWKV, I_CWAL, I_CBAL, I_CNORM, I_WBA, I_WBB, I_WBC, I_WGATE, I_BGATE, I_WOUT, I_MIXPOST, I_F2PRE, I_F2WIN, I_F2WOUT, I_F2POST };

constexpr int CVT_WSCR = 64 * 65;
__device__ __forceinline__ void cvt_tile(const float* src, int ld, int col0, int ncols, int k0, bf16* dst, int K, int drow0, float scale, bool zfill, LAS float* scr, int lane) {
    const int c4 = 4 * (lane & 15), kr = lane >> 4;
    f32x4 v[16];
#pragma unroll
    for (int i = 0; i < 16; ++i) v[i] = (c4 < ncols) ? *(const f32x4*)(src + (size_t)(k0 + 4 * i + kr) * ld + col0 + c4) : (f32x4){0.f, 0.f, 0.f, 0.f};
    asm volatile("" ::: "memory");
#pragma unroll
    for (int i = 0; i < 16; ++i) { LAS float* p = scr + (4 * i + kr) * 65 + c4; p[0] = v[i][0] * scale; p[1] = v[i][1] * scale; p[2] = v[i][2] * scale; p[3] = v[i][3] * scale; }
    asm volatile("" ::: "memory");
    const int n8 = lane >> 3, c = lane & 7;
#pragma unroll
    for (int p = 0; p < 8; ++p) { const int n = 8 * p + n8; const LAS float* s = scr + (8 * c) * 65 + n;
        v4u o; o.x = pk2(s[0], s[65]); o.y = pk2(s[2 * 65], s[3 * 65]); o.z = pk2(s[4 * 65], s[5 * 65]); o.w = pk2(s[6 * 65], s[7 * 65]);
        if (n < ncols || zfill) *(v4u*)(dst + (size_t)(drow0 + n) * K + k0 + 8 * c) = o; }
    asm volatile("" ::: "memory");
}
__device__ __forceinline__ void cvt_tile8(const float* src, int ld, int col0, int ncols, int k0, signed char* dst, int K, int drow0, const float* cmax, bool zfill, float sfac, float* wsc, LAS float* scr, int lane) {
    const int c4 = 4 * (lane & 15), kr = lane >> 4;
    f32x4 v[16], sc4 = (f32x4){0.f, 0.f, 0.f, 0.f};
    if (c4 < ncols) { const f32x4 cm = *(const f32x4*)(cmax + col0 + c4);
#pragma unroll
        for (int j = 0; j < 4; ++j) sc4[j] = cm[j] > 0.f ? 127.0f / cm[j] : 0.f; }
    if (wsc && k0 == 0 && (lane < ncols || zfill)) wsc[drow0 + lane] = (lane < ncols) ? sfac * cmax[col0 + lane] * (1.0f / 127.0f) : 0.f;
#pragma unroll
    for (int i = 0; i < 16; ++i) v[i] = (c4 < ncols) ? *(const f32x4*)(src + (size_t)(k0 + 4 * i + kr) * ld + col0 + c4) : (f32x4){0.f, 0.f, 0.f, 0.f};
    asm volatile("" ::: "memory");
#pragma unroll
    for (int i = 0; i < 16; ++i) { LAS float* p = scr + (4 * i + kr) * 65 + c4; p[0] = v[i][0] * sc4[0]; p[1] = v[i][1] * sc4[1]; p[2] = v[i][2] * sc4[2]; p[3] = v[i][3] * sc4[3]; }
    asm volatile("" ::: "memory");
    const int n8 = lane >> 3, c = lane & 7;
#pragma unroll
    for (int p = 0; p < 8; ++p) { const int n = 8 * p + n8; const LAS float* s = scr + (8 * c) * 65 + n;
        unsigned w0 = 0u, w1 = 0u;
#pragma unroll
        for (int j = 0; j < 4; ++j) { const int a = __float2int_rn(s[j * 65]), b = __float2int_rn(s[(4 + j) * 65]);
            w0 |= (unsigned)((a < -127 ? -127 : (a > 127 ? 127 : a)) & 0xff) << (8 * j); w1 |= (unsigned)((b < -127 ? -127 : (b > 127 ? 127 : b)) & 0xff) << (8 * j); }
        if (n < ncols || zfill) { v2u o; o.x = w0; o.y = w1; *(v2u*)(dst + (size_t)(drow0 + n) * K + k0 + 8 * c) = o; } }
    asm volatile("" ::: "memory");
}
__device__ __forceinline__ void cvt_block8(const float* src, int ld, int col0, int ncols, int K, signed char* dst, int drow0, const float* cmax, bool zfill, float sfac, float* wsc, LAS float* scr, int& rot) {
    const int G = gridDim.x * NWAVES, nct = (ncols + 63) / 64, nkt = K / 64, nt = nct * nkt, wv = __builtin_amdgcn_readfirstlane(otid() >> 6), gw = wv * gridDim.x + obid();
    for (int t = (gw - rot % G + G) % G; t < nt; t += G) { const int ct = t / nkt, kt = t % nkt; const int nc = ncols - 64 * ct < 64 ? ncols - 64 * ct : 64;
        cvt_tile8(src, ld, col0 + 64 * ct, nc, 64 * kt, dst, K, drow0 + 64 * ct, cmax, zfill, sfac, wsc, scr + wv * CVT_WSCR, otid() & 63); }
    rot += nt;
}
__device__ __forceinline__ void colmax_phase(const float* w, int Kr, int N, unsigned* cmax, LAS float* scr, int unit0) {
    const int tid = otid(), lane = tid & 63, wv = tid >> 6, nch = (N + 255) / 256, nrb = Kr / 128, G = gridDim.x;
    for (int u = (obid() - unit0 % G + G) % G; u < nch * nrb; u += G) { const int ch = u / nrb, rb = u % nrb, c0 = 256 * ch + 4 * lane;
        f32x4 mx = (f32x4){0.f, 0.f, 0.f, 0.f};
        if (c0 < N) {
#pragma unroll
            for (int i = 0; i < 16; ++i) { const f32x4 v = *(const f32x4*)(w + (size_t)(rb * 128 + wv * 16 + i) * N + c0);
                mx[0] = fmaxf(mx[0], fabsf(v[0])); mx[1] = fmaxf(mx[1], fabsf(v[1])); mx[2] = fmaxf(mx[2], fabsf(v[2])); mx[3] = fmaxf(mx[3], fabsf(v[3])); } }
        __syncthreads(); *(LAS f32x4*)(scr + wv * 256 + 4 * lane) = mx; __syncthreads();
        if (tid < 256 && 256 * ch + tid < N) { float v = scr[tid];
#pragma unroll
            for (int g2 = 1; g2 < 8; ++g2) v = fmaxf(v, scr[g2 * 256 + tid]);
            atomicMax(cmax + 256 * ch + tid, __float_as_uint(v)); }
    }
}
__device__ __forceinline__ void wmax_phase(const float* w, size_t n4, unsigned* slot) {
    const int gt = obid() * NTHR + otid(), GT = gridDim.x * NTHR; float m = 0.f;
    for (size_t i = gt; i < n4; i += GT) { const f32x4 v = ((const f32x4*)w)[i]; m = fmaxf(m, fmaxf(fmaxf(fabsf(v[0]), fabsf(v[1])), fmaxf(fabsf(v[2]), fabsf(v[3])))); }
    m = wave_max(m);
    if ((otid() & 63) == 0) atomicMax(slot, __float_as_uint(m));
}
__device__ __forceinline__ void cvt_block(const float* src, int ld, int col0, int ncols, int K, bf16* dst, int drow0, float scale, bool zfill, LAS float* scr, int& rot) {
    const int G = gridDim.x * NWAVES, nct = (ncols + 63) / 64, nkt = K / 64, nt = nct * nkt, wv = __builtin_amdgcn_readfirstlane(otid() >> 6), gw = wv * gridDim.x + obid();
    for (int t = (gw - rot % G + G) % G; t < nt; t += G) { const int ct = t / nkt, kt = t % nkt; const int nc = ncols - 64 * ct < 64 ? ncols - 64 * ct : 64;
        cvt_tile(src, ld, col0 + 64 * ct, nc, 64 * kt, dst, K, drow0 + 64 * ct, scale, zfill, scr + wv * CVT_WSCR, otid() & 63); }
    rot += nt;
}
__device__ __forceinline__ void cvt_ffn(const float* w_in, const float* w_out, bf16* W1t, bf16* W2t, LAS float* scr, const float* cmax) {
    const int G = gridDim.x * NWAVES, wv = __builtin_amdgcn_readfirstlane(otid() >> 6), gw = wv * gridDim.x + obid();
    __syncthreads();
    constexpr int NRT = 2 * DFF / 64, NKT = D / 64;
    for (int t = gw; t < NRT * NKT; t += G) { const int rt = t / NKT, kt = t % NKT; const int pn = rt >> 2, w = (rt & 3) * 64;
        const int col = (w < 128) ? 128 * pn + w : DFF + 128 * pn + (w - 128);
        cvt_tile8(w_in, 2 * DFF, col, 64, 64 * kt, (signed char*)W1t, D, 64 * rt, cmax, false, 1.0f, nullptr, scr + wv * CVT_WSCR, otid() & 63); }
    int rot = NRT * NKT;
    cvt_block(w_out, D, 0, D, DFF, W2t, 0, 1.0f, false, scr, rot);
}
template <int NO, int NK, bool B_O_MINOR, class FA, class FB, class FS>
__device__ __forceinline__ void small_gemm_tile(FA fa, FB fb, FS fs, LAS float* lds) {
    LAS float* As = lds; LAS float* Bs = lds + 64 * (NK + 1);
    const int tid = otid();
    __syncthreads();
    for (int e = tid; e < 64 * NK; e += NTHR) { const int i = e / NK, k = e % NK; As[i * (NK + 1) + k] = fa(i, k); }
    for (int e = tid; e < NO * NK; e += NTHR) { const int o = B_O_MINOR ? e % NO : e / NK, k = B_O_MINOR ? e / NO : e % NK; Bs[o * (NK + 1) + k] = fb(o, k); }
    __syncthreads();
    constexpr int PER = NO / 8; const int i = tid & 63, oq = tid >> 6;
    float acc[PER];
#pragma unroll
    for (int mm = 0; mm < PER; ++mm) acc[mm] = 0.f;
#pragma unroll 4
    for (int k = 0; k < NK; ++k) { const float av = As[i * (NK + 1) + k];
#pragma unroll
        for (int mm = 0; mm < PER; ++mm) acc[mm] += av * Bs[(oq * PER + mm) * (NK + 1) + k]; }
#pragma unroll
    for (int mm = 0; mm < PER; ++mm) fs(oq * PER + mm, i, acc[mm]);
}
template <class C> __device__ __forceinline__ void merged_pre(const C& a, int l, bf16* MW, unsigned* mwmax, LAS float* scr, int rot2) {
    const float* w_in = a.in(I_WIN) + (size_t)l * D * DIN;
    const float* wkv = a.in(I_AWKV) + (size_t)l * 128 * 1024;
    const int G = gridDim.x;
    auto put = [&](int row, int d, float v) { MW[(size_t)row * D + d] = (bf16)f2bf(v); const float am = wave_max(fabsf(v)); if ((otid() & 63) == 0) atomicMax(mwmax + row, __float_as_uint(am)); };
    for (int un = (obid() - rot2 % G + G) % G; un < 8 * 16; un += G) { const int h = un >> 4, d0 = (un & 15) * 64;
        small_gemm_tile<128, 48, false>([&](int i, int k) { return w_in[(size_t)(d0 + i) * DIN + WI_AQ + 64 * h + 16 + k]; },
                                        [&](int o, int k) { return wkv[(size_t)o * 1024 + 128 * h + 16 + k] * QSCALE; },
                                        [&](int o, int i, float v) { put(h * 128 + o, d0 + i, v); }, scr); }
    rot2 += 128;
    const float* gkv = a.in(I_AKVG) + (size_t)l * 128;
    for (int un = (obid() - rot2 % G + G) % G; un < 16; un += G) { const int d0 = un * 64;
        small_gemm_tile<128, 128, true>([&](int i, int k) { return w_in[(size_t)(d0 + i) * DIN + WI_CKV + k]; },
                                        [&](int o, int k) { return gkv[k] * wkv[(size_t)k * 1024 + 128 * (o >> 4) + (o & 15)]; },
                                        [&](int o, int i, float v) { put(1024 + o, d0 + i, v); }, scr); }
    rot2 += 16;
    const float* wal = a.in(I_CWAL) + (size_t)l * 16 * 256;
    for (int un = (obid() - rot2 % G + G) % G; un < 32; un += G) { const int n0 = (un >> 4) * 128, d0 = (un & 15) * 64;
        small_gemm_tile<128, 16, true>([&](int i, int k) { return w_in[(size_t)(d0 + i) * DIN + WI_CA + k]; },
                                       [&](int o, int k) { return wal[k * 256 + n0 + o]; },
                                       [&](int o, int i, float v) { put(1152 + n0 + o, d0 + i, v); }, scr); }
    rot2 += 32;
    const float* wba = a.in(I_WBA) + (size_t)l * 512 * D;
    for (int un = (obid() - rot2 % G + G) % G; un < 8 * 2 * 8; un += G) { const int h = un >> 4, c0 = ((un >> 3) & 1) * 64, n0 = (un & 7) * 128;
        small_gemm_tile<128, 64, true>([&](int i, int k) { return wkv[(size_t)(c0 + i) * 1024 + 128 * h + 64 + k]; },
                                       [&](int o, int k) { return wba[(size_t)(64 * h + k) * D + n0 + o]; },
                                       [&](int o, int i, float v) { put(1408 + n0 + o, h * 128 + c0 + i, v); }, scr); }
}
template <class C> __device__ __forceinline__ void cvt_mixer(const C& a, int l, bf16* W, LAS float* scr, const float* cmw, const float* cmg, const bf16* MW, const unsigned* mwmax, float* wsc) {
    const float* w_in = a.in(I_WIN) + (size_t)l * D * DIN;
    const float* wkv = a.in(I_AWKV) + (size_t)l * 128 * 1024;
    signed char* W8 = (signed char*)(W + WO_BIG);
    int rot = 0;
    __syncthreads();
    cvt_block8(w_in, DIN, WI_BQKV, 768, D, W8, RB0, cmw, false, QSCALE, wsc, scr, rot);
    cvt_block8(w_in, DIN, WI_BQKV + 768, 1536, D, W8, RB0 + 768, cmw, false, 1.0f, wsc, scr, rot);
    const int R2 = RAC0 + 256;
#pragma unroll 1
    for (int h = 0; h < 8; ++h) cvt_block8(w_in, DIN, WI_AQ + 64 * h, 16, D, W8, R2 + A2_QR + 16 * h, cmw, false, QSCALE, wsc, scr, rot);
    cvt_block8(w_in, DIN, WI_IQ, 512, D, W8, R2 + A2_IQ, cmw, false, 1.0f, wsc, scr, rot);
    cvt_block8(w_in, DIN, WI_IK, 64, D, W8, R2 + A2_IK, cmw, false, 1.0f, wsc, scr, rot);
    cvt_block8(w_in, DIN, WI_IW, 8, D, W8, R2 + A2_IW, cmw, true, 1.0f, wsc, scr, rot);
    cvt_block8(w_in, DIN, WI_CKV, 128, D, W8, R2 + A2_CKV, cmw, false, 1.0f, wsc, scr, rot);
    cvt_block8(w_in, DIN, WI_CQ, 256, D, W8, R2 + A2_CQ, cmw, false, 0.125f, wsc, scr, rot);
    cvt_block8(w_in, DIN, WI_CK, 256 + 512 + 512, D, W8, R2 + A2_CK, cmw, false, 1.0f, wsc, scr, rot);
    cvt_block8(a.in(I_WGATE) + (size_t)l * D * 3072, 3072, 0, 3072, D, W8, RG0, cmg, false, 1.0f, wsc, scr, rot);
    cvt_block(a.in(I_WBB) + (size_t)l * 256 * D, D, 0, D, 256, W + WO_MB, 0, 1.0f, false, scr, rot);
    cvt_block(a.in(I_WBC) + (size_t)l * 512 * D, D, 0, D, 512, W + WO_MC, 0, 1.0f, false, scr, rot);
    cvt_block(a.in(I_WOUT) + (size_t)l * D * D, D, 0, D, D, W + WO_WO, 0, 1.0f, false, scr, rot);
    { const int lane = otid() & 63, gw = obid() * NWAVES + (otid() >> 6), NGW = gridDim.x * NWAVES;
      for (int r = gw; r < NMW; r += NGW) { const int dr = r < 768 ? 2304 + r : r < 1024 ? RAC0 + (r - 768) : r < 1152 ? R2 + A2_KR + (r - 1024) : r < 1408 ? R2 + A2_CAL + (r - 1152) : NBIG + (r - 1408);
          const float mx = __uint_as_float(mwmax[r]), qs = mx > 0.f ? 127.0f / mx : 0.f;
          const v4u p0 = *(const v4u*)(MW + (size_t)r * D + 16 * lane), p1 = *(const v4u*)(MW + (size_t)r * D + 16 * lane + 8);
          const unsigned pw[8] = {p0.x, p0.y, p0.z, p0.w, p1.x, p1.y, p1.z, p1.w}; unsigned ow[4];
#pragma unroll
          for (int j = 0; j < 4; ++j) { const int q0 = __float2int_rn(blo(pw[2 * j]) * qs), q1 = __float2int_rn(bhi(pw[2 * j]) * qs), q2 = __float2int_rn(blo(pw[2 * j + 1]) * qs), q3 = __float2int_rn(bhi(pw[2 * j + 1]) * qs);
              ow[j] = (unsigned)(q0 & 0xff) | ((unsigned)(q1 & 0xff) << 8) | ((unsigned)(q2 & 0xff) << 16) | ((unsigned)(q3 & 0xff) << 24); }
          v4u o; o.x = ow[0]; o.y = ow[1]; o.z = ow[2]; o.w = ow[3]; *(v4u*)(W8 + (size_t)dr * D + 16 * lane) = o;
          if (lane == 0) wsc[dr] = mx * (1.0f / 127.0f); } }
}

__device__ __forceinline__ void cs_phase(const int* pos, float* cs) {
    const int gt = obid() * NTHR + otid(), GT = gridDim.x * NTHR;
    for (int e = gt; e < T * 8; e += GT) { const int t = e >> 3, i = e & 7;
        const double frev = (i == 0) ? 0.15915494309189535 : (i == 1) ? 0.03086376340470123 : (i == 2) ? 0.005985185712713705 : (i == 3) ? 0.001160663641240061 :
                            (i == 4) ? 0.00022507907903927653 : (i == 5) ? 4.364795279280289e-05 : (i == 6) ? 8.464330808241401e-06 : 1.6414262627950345e-06;
        const double rev = (double)pos[t] * frev; const float fr = (float)(rev - __builtin_floor(rev));
        cs[(size_t)t * 16 + i] = __builtin_amdgcn_cosf(fr); cs[(size_t)t * 16 + 8 + i] = __builtin_amdgcn_sinf(fr); }
}
__device__ __forceinline__ void resid_phase(const float* hin, float* hout, const bf16* f, float w, const float* gpost, const float* gpre, bf16* xn, bool dry = false, float* rsout = nullptr, const bf16* hin16 = nullptr, bf16* hout16 = nullptr) {
    const int lane = otid() & 63, gw = obid() * NWAVES + (otid() >> 6), NGW = gridDim.x * NWAVES;
    (void)dry;
    for (int r0 = gw; r0 < T; r0 += 2 * NGW) {
        const bool two = r0 + NGW < T; const int rr[2] = {r0, two ? r0 + NGW : r0};
        f32x4 v[2][4]; v2u fp[2][4];
#pragma unroll
        for (int q = 0; q < 2; ++q)
#pragma unroll
            for (int j = 0; j < 4; ++j) { if (hin16) { const v2u p = *(const v2u*)(hin16 + (size_t)rr[q] * D + 256 * j + 4 * lane); v[q][j] = (f32x4){blo(p.x), bhi(p.x), blo(p.y), bhi(p.y)}; }
                else v[q][j] = *(const f32x4*)(hin + (size_t)rr[q] * D + 256 * j + 4 * lane);
                if (f) fp[q][j] = *(const v2u*)(f + (size_t)rr[q] * D + 256 * j + 4 * lane); }
        if (f) {
#pragma unroll
            for (int q = 0; q < 2; ++q) { f32x4 fv[4]; float s = 0.f;
#pragma unroll
                for (int j = 0; j < 4; ++j) { const v2u p = fp[q][j]; fv[j] = (f32x4){blo(p.x), bhi(p.x), blo(p.y), bhi(p.y)};
                    s += (fv[j][0] * fv[j][0] + fv[j][1] * fv[j][1]) + (fv[j][2] * fv[j][2] + fv[j][3] * fv[j][3]); }
                const float rstd = w * __builtin_amdgcn_rsqf(wave_sum(s) * (1.0f / D) + RMS_EPS);
#pragma unroll
                for (int j = 0; j < 4; ++j) { const f32x4 g = *(const f32x4*)(gpost + 256 * j + 4 * lane); v[q][j] = v[q][j] + fv[j] * rstd * g; } } }
#pragma unroll
        for (int q = 0; q < 2; ++q) { const int r = rr[q]; if (q == 1 && !two) break;
            if (hout) {
#pragma unroll
                for (int j = 0; j < 4; ++j) *(f32x4*)(hout + (size_t)r * D + 256 * j + 4 * lane) = v[q][j]; }
            if (hout16) {
#pragma unroll
                for (int j = 0; j < 4; ++j) { v2u p; p.x = pk2(v[q][j][0], v[q][j][1]); p.y = pk2(v[q][j][2], v[q][j][3]); *(v2u*)(hout16 + (size_t)r * D + 256 * j + 4 * lane) = p; } }
            if (xn) { float s = 0.f;
#pragma unroll
                for (int j = 0; j < 4; ++j) s += (v[q][j][0] * v[q][j][0] + v[q][j][1] * v[q][j][1]) + (v[q][j][2] * v[q][j][2] + v[q][j][3] * v[q][j][3]);
                const float rstd = __builtin_amdgcn_rsqf(wave_sum(s) * (1.0f / D) + RMS_EPS);
                f32x4 o[4];
#pragma unroll
                for (int j = 0; j < 4; ++j) { const f32x4 g = *(const f32x4*)(gpre + 256 * j + 4 * lane); o[j] = v[q][j] * rstd * g; }
                if (!rsout) {
#pragma unroll
                    for (int j = 0; j < 4; ++j) { v2u p; p.x = pk2(o[j][0], o[j][1]); p.y = pk2(o[j][2], o[j][3]); *(v2u*)(xn + (size_t)r * D + 256 * j + 4 * lane) = p; }
                } else { float am = 0.f;
#pragma unroll
                    for (int j = 0; j < 4; ++j) am = fmaxf(am, fmaxf(fmaxf(fabsf(o[j][0]), fabsf(o[j][1])), fmaxf(fabsf(o[j][2]), fabsf(o[j][3]))));
                    am = wave_max(am); const float qs = am > 0.f ? 127.0f / am : 0.f;
#pragma unroll
                    for (int j = 0; j < 4; ++j) { const int q0 = __float2int_rn(o[j][0] * qs), q1 = __float2int_rn(o[j][1] * qs), q2 = __float2int_rn(o[j][2] * qs), q3 = __float2int_rn(o[j][3] * qs);
                        ((unsigned*)xn)[(size_t)r * 256 + 64 * j + lane] = (unsigned)(q0 & 0xff) | ((unsigned)(q1 & 0xff) << 8) | ((unsigned)(q2 & 0xff) << 16) | ((unsigned)(q3 & 0xff) << 24); }
                    if (lane == 0) rsout[r] = am * (1.0f / 127.0f); } }
        }
    }
}
__device__ __forceinline__ void rec_phase(const bf16* pA2, const float* gkv, const float* cs, bf16* rec) {
    const int lane = otid() & 63, gw = obid() * NWAVES + (otid() >> 6), NGW = gridDim.x * NWAVES;
    for (int r = gw; r < T; r += NGW) {
        const unsigned pc = *(const unsigned*)(pA2 + (size_t)r * LA2 + A2_CKV + 2 * lane), pk = *(const unsigned*)(pA2 + (size_t)r * LA2 + A2_KR + 2 * lane);
        const float c0 = blo(pc), c1 = bhi(pc);
        const float rstd = __builtin_amdgcn_rsqf(wave_sum(c0 * c0 + c1 * c1) * (1.0f / 128.0f) + RMS_EPS);
        *(unsigned short*)((unsigned char*)rec + (size_t)r * 256 + 2 * lane) = (unsigned short)__builtin_amdgcn_cvt_pk_fp8_f32(c0 * rstd * gkv[2 * lane], c1 * rstd * gkv[2 * lane + 1], 0, false);
        const float k0 = blo(pk) * rstd, k1 = bhi(pk) * rstd;
        const float q0 = __shfl_xor(k0, 4), q1 = __shfl_xor(k1, 4);
        const int i0 = (2 * lane) & 7; const bool hi = ((2 * lane) & 8) != 0;
        const float cc0 = cs[(size_t)r * 16 + i0], cc1 = cs[(size_t)r * 16 + i0 + 1], ss0 = cs[(size_t)r * 16 + 8 + i0], ss1 = cs[(size_t)r * 16 + 8 + i0 + 1];
        const float o0 = hi ? k0 * cc0 + q0 * ss0 : k0 * cc0 - q0 * ss0, o1 = hi ? k1 * cc1 + q1 * ss1 : k1 * cc1 - q1 * ss1;
        *(unsigned short*)((unsigned char*)rec + (size_t)r * 256 + 128 + 2 * lane) = (unsigned short)__builtin_amdgcn_cvt_pk_fp8_f32(o0, o1, 0, false);
    }
}
__device__ __forceinline__ unsigned pack_score(float sc, int idx) {
    const unsigned u = __float_as_uint(sc); const unsigned m = u ^ ((u >> 31) ? 0xffffffffu : 0x80000000u);
    return (m & 0xffffe000u) | (unsigned)idx;
}
typedef short v4i16_t __attribute__((ext_vector_type(4)));
typedef float f32x4_t __attribute__((ext_vector_type(4)));
__device__ __forceinline__ v4i16_t lds_tr(LAS unsigned char* p) { return __builtin_amdgcn_ds_read_tr16_b64_v4i16((LAS v4i16_t*)p); }
__device__ __forceinline__ bf16x8 cat8(v4i16_t a, v4i16_t b) { return __builtin_shufflevector(a, b, 0, 1, 2, 3, 4, 5, 6, 7); }
__device__ __forceinline__ unsigned cvtpk(float lo, float hi) { return pg8::cvt_pk_bf16(lo, hi); }
__device__ __forceinline__ float fast_sig(float x) { return __builtin_amdgcn_rcpf(1.0f + __expf(-x)); }
__device__ __forceinline__ f32x4_t mfma16(bf16x8 a, bf16x8 b, f32x4_t c) { return __builtin_amdgcn_mfma_f32_16x16x32_bf16(a, b, c, 0, 0, 0); }

constexpr int GLA_HEAD_LDS = 39936;
template <int MODE> __device__ __forceinline__ void gla_chunk_phase(const bf16* pA2, const float* cbal, const float* cng, bf16* KVT, float* DEC, bf16* yc, LAS unsigned char* lds) {
    const int tid = otid(), lane = tid & 63, wv = __builtin_amdgcn_readfirstlane(tid >> 6), hh = wv >> 2, sub = wv & 3, ht = tid & 255;
    const int d = ht & 63, fr = lane & 15, g = lane >> 4, q4 = fr >> 2, p4 = fr & 3;
    LAS unsigned char* L = lds + hh * GLA_HEAD_LDS;
    LAS float* tot = (LAS float*)L;
    LAS unsigned char* KI = L + 1024;
    LAS unsigned char* QD = L + 1024 + 10240;
    LAS unsigned char* VI = L + 1024 + 10240 + 9216;
    for (int u = obid(); u < NB * 128 * 2; u += gridDim.x) {
        const int b = u >> 8, n = (u >> 1) & 127, h = (u & 1) * 2 + hh, bh = b * 4 + h;
        const size_t row0 = (size_t)b * S + (size_t)n * 64;
        __syncthreads();
        unsigned short xa_[16], kk_[16], qq_[16]; v4u vv_[4];
#pragma unroll
        for (int i = 0; i < 16; ++i) { const size_t rb = (row0 + sub * 16 + i) * LA2 + h * 64 + d; xa_[i] = pA2[rb + A2_CAL]; kk_[i] = pA2[rb + A2_CK]; if (MODE != 1) qq_[i] = pA2[rb + A2_CQ]; }
#pragma unroll
        for (int c = 0; c < 4; ++c) { const int idx = ht + 256 * c, t = idx >> 4, ch = idx & 15; vv_[c] = *(const v4u*)(pA2 + (row0 + t) * LA2 + A2_CV + h * 128 + ch * 8); }
        bf16x8 as_[2][8]; v2u gp_[8];
        if (MODE != 1) { const bf16* sp = KVT + ((size_t)bh * 128 + n) * 8192;
#pragma unroll
            for (int ks = 0; ks < 2; ++ks)
#pragma unroll
                for (int mb = 0; mb < 8; ++mb) as_[ks][mb] = *(const bf16x8*)(sp + (16 * mb + fr) * 64 + 32 * ks + 8 * g);
#pragma unroll
            for (int mb = 0; mb < 8; ++mb) gp_[mb] = *(const v2u*)(pA2 + (row0 + 16 * sub + fr) * LA2 + A2_CG + h * 128 + 16 * mb + 4 * g); }
        float bl_[16]; float run = 0.f; const float bias = cbal[h * 64 + d];
#pragma unroll
        for (int i = 0; i < 16; ++i) { const float x = bf2f(xa_[i]) + bias;
            run += (fminf(x, 0.f) - __logf(1.0f + __expf(-fabsf(x)))) * (1.0f / 16.0f); bl_[i] = run; }
        tot[sub * 64 + d] = run;
        __syncthreads();
        float pre = 0.f, all = 0.f;
#pragma unroll
        for (int p = 0; p < 4; ++p) { const float v = tot[p * 64 + d]; pre += (p < sub) ? v : 0.f; all += v; }
#pragma unroll
        for (int i = 0; i < 16; ++i) { const int t = sub * 16 + i; const float bt = bl_[i] + pre; const float kk = bf2f(kk_[i]);
            if (MODE == 1) { *(LAS unsigned short*)(KI + t * 160 + d * 2) = (unsigned short)f2bf(kk * __expf(all - bt)); }
            else { const float qq = bf2f(qq_[i]);
                *(LAS unsigned short*)(KI + t * 144 + d * 2) = (unsigned short)f2bf(kk * __expf(-bt)); *(LAS unsigned short*)(QD + t * 144 + d * 2) = (unsigned short)f2bf(qq * __expf(bt)); } }
        if (MODE == 1 && sub == 0) DEC[((size_t)bh * 128 + n) * 64 + d] = __expf(all);
#pragma unroll
        for (int c = 0; c < 4; ++c) { const int idx = ht + 256 * c, t = idx >> 4, ch = idx & 15;
            *(LAS v4u*)(VI + t * 288 + ch * 16) = vv_[c]; }
        __syncthreads();
        if (MODE == 1) {
            f32x4_t acc[2][4];
#pragma unroll
            for (int j = 0; j < 2; ++j)
#pragma unroll
                for (int mb = 0; mb < 4; ++mb) acc[j][mb] = (f32x4_t){0.f, 0.f, 0.f, 0.f};
#pragma unroll
            for (int ks = 0; ks < 2; ++ks) { const int r0 = 32 * ks + 4 * g + q4, r1 = r0 + 16;
                bf16x8 bfr[2];
#pragma unroll
                for (int j = 0; j < 2; ++j) { const int cb = (16 * (2 * sub + j) + 4 * p4) * 2; bfr[j] = cat8(lds_tr(VI + r0 * 288 + cb), lds_tr(VI + r1 * 288 + cb)); }
#pragma unroll
                for (int mb = 0; mb < 4; ++mb) { const int ca = (16 * mb + 4 * p4) * 2; const bf16x8 af = cat8(lds_tr(KI + r0 * 160 + ca), lds_tr(KI + r1 * 160 + ca));
#pragma unroll
                    for (int j = 0; j < 2; ++j) acc[j][mb] = mfma16(af, bfr[j], acc[j][mb]); } }
#pragma unroll
            for (int j = 0; j < 2; ++j)
#pragma unroll
                for (int mb = 0; mb < 4; ++mb) { v2u o; o.x = cvtpk(acc[j][mb][0], acc[j][mb][1]); o.y = cvtpk(acc[j][mb][2], acc[j][mb][3]);
                    *(v2u*)(KVT + (((size_t)bh * 128 + n) * 128 + 16 * (2 * sub + j) + fr) * 64 + 16 * mb + 4 * g) = o; }
        } else {
            const int tq = 16 * sub + fr;
            bf16x8 bq[2];
#pragma unroll
            for (int ks = 0; ks < 2; ++ks) bq[ks] = *(const LAS bf16x8*)(QD + tq * 144 + (32 * ks + 8 * g) * 2);
            unsigned pw[2][4];
#pragma unroll
            for (int ms = 0; ms < 4; ++ms) { f32x4_t sacc = (f32x4_t){0.f, 0.f, 0.f, 0.f};
#pragma unroll
                for (int ks = 0; ks < 2; ++ks) { const bf16x8 ak = *(const LAS bf16x8*)(KI + (16 * ms + fr) * 144 + (32 * ks + 8 * g) * 2); sacc = mfma16(ak, bq[ks], sacc); }
#pragma unroll
                for (int i = 0; i < 4; ++i) if (16 * ms + 4 * g + i > tq) sacc[i] = 0.f;
                pw[ms >> 1][(ms & 1) * 2 + 0] = cvtpk(sacc[0], sacc[1]); pw[ms >> 1][(ms & 1) * 2 + 1] = cvtpk(sacc[2], sacc[3]); }
            f32x4_t oacc[8];
#pragma unroll
            for (int mb = 0; mb < 8; ++mb) oacc[mb] = (f32x4_t){0.f, 0.f, 0.f, 0.f};
#pragma unroll
            for (int ks2 = 0; ks2 < 2; ++ks2) { const int r0 = 32 * ks2 + 4 * g + q4, r1 = r0 + 16;
                const v4u pwv = {pw[ks2][0], pw[ks2][1], pw[ks2][2], pw[ks2][3]}; const bf16x8 pf = __builtin_bit_cast(bf16x8, pwv);
#pragma unroll
                for (int mb = 0; mb < 8; ++mb) { const int ca = (16 * mb + 4 * p4) * 2; const bf16x8 av = cat8(lds_tr(VI + r0 * 288 + ca), lds_tr(VI + r1 * 288 + ca)); oacc[mb] = mfma16(av, pf, oacc[mb]); } }
#pragma unroll
            for (int ks = 0; ks < 2; ++ks)
#pragma unroll
                for (int mb = 0; mb < 8; ++mb) oacc[mb] = mfma16(as_[ks][mb], bq[ks], oacc[mb]);
            float ss = 0.f;
#pragma unroll
            for (int mb = 0; mb < 8; ++mb) ss += (oacc[mb][0] * oacc[mb][0] + oacc[mb][1] * oacc[mb][1]) + (oacc[mb][2] * oacc[mb][2] + oacc[mb][3] * oacc[mb][3]);
            ss += __shfl_xor(ss, 16); ss += __shfl_xor(ss, 32);
            const float rstd = __builtin_amdgcn_rsqf(ss * (1.0f / 128.0f) + RMS_EPS);
#pragma unroll
            for (int mb = 0; mb < 8; ++mb) { const int v0 = 16 * mb + 4 * g; const v2u gp = gp_[mb]; const f32x4_t cn = *(const f32x4_t*)(cng + v0);
                const float g0 = blo(gp.x), g1 = bhi(gp.x), g2 = blo(gp.y), g3 = bhi(gp.y);
                const float y0 = oacc[mb][0] * rstd * cn[0] * g0 * fast_sig(g0), y1 = oacc[mb][1] * rstd * cn[1] * g1 * fast_sig(g1), y2 = oacc[mb][2] * rstd * cn[2] * g2 * fast_sig(g2), y3 = oacc[mb][3] * rstd * cn[3] * g3 * fast_sig(g3);
                v2u o; o.x = pk2(y0, y1); o.y = pk2(y2, y3); *(v2u*)(yc + (row0 + tq) * 512 + h * 128 + v0) = o; }
        }
    }
}
__device__ __forceinline__ void gla_scan_phase(bf16* KVT, const float* DEC, bool dry = false) {
    const int tid = otid();
    if (tid < 256) for (int e = obid() * 256 + tid; e < 8 * 8192; e += gridDim.x * 256) { const int bh = e >> 13, vd = e & 8191, d = vd & 63;
        float St = 0.f; bf16* kp = KVT + (size_t)bh * 128 * 8192 + vd; const float* dp = DEC + (size_t)bh * 128 * 64 + d;
#pragma unroll 1
        for (int n0 = 0; n0 < 128; n0 += 32) {
            float kv[32], dc[32];
#pragma unroll
            for (int j = 0; j < 32; ++j) { kv[j] = bf2f(kp[(size_t)(n0 + j) * 8192]); dc[j] = dp[(n0 + j) * 64]; }
#pragma unroll
            for (int j = 0; j < 32; ++j) { if (!(dry && St != 12345.0f)) kp[(size_t)(n0 + j) * 8192] = (bf16)f2bf(St); St = dc[j] * St + kv[j]; } } }
}

typedef float f32x16_t __attribute__((ext_vector_type(16)));
#ifndef IDX_PMAX
#define IDX_PMAX 384
#define IDX_PLO 448
#endif
constexpr int IDX_C = 960, IDX_KT = 128, IDX_KROW = 144, IDX_KBUF = IDX_KT * IDX_KROW, IDX_KT_OFF = 8 * 4 * IDX_C * 4;
static_assert(IDX_KT_OFF + 2 * IDX_KBUF <= MISC_OFF, "indexer LDS map");
__device__ __forceinline__ float score_floor(unsigned thr) {
    const unsigned m = thr & 0xffffe000u; const unsigned u = (m & 0x80000000u) ? (m ^ 0x80000000u) : ~m;
    return thr == 0u ? -INFINITY : __uint_as_float(u);
}
template <int NV> __device__ __forceinline__ unsigned wave_select(const unsigned (&v)[NV], unsigned lo0, unsigned& hi_io, int cmax, int& cout) {
    unsigned lo = lo0, hi = hi_io; int c = 0;
#pragma unroll 1
    for (int it = 0; it < 40; ++it) { const unsigned mid = lo + ((hi - lo) >> 1); c = 0;
#pragma unroll
        for (int i = 0; i < NV; ++i) c += __popcll(__ballot(v[i] >= mid));
        if (c >= 256 && c <= cmax) { cout = c; hi_io = hi; return mid; }
        if (c > cmax) lo = mid; else hi = mid; }
    cout = c; hi_io = hi; return lo;
}
__device__ __forceinline__ void wave_prune(LAS unsigned* list, int& cnt, unsigned& thr, int lane, int cmax) {
    unsigned hi;
    if (cnt > 384) {
    unsigned v[16]; unsigned vmax = 0u;
#pragma unroll
    for (int i = 0; i < 16; ++i) { const int idx = lane + 64 * i; v[i] = idx < cnt ? list[idx] : 0u; vmax = v[i] > vmax ? v[i] : vmax; }
#pragma unroll
    for (int o = 1; o < 64; o <<= 1) { const unsigned t = __shfl_xor(vmax, o); vmax = t > vmax ? t : vmax; }
    hi = __builtin_amdgcn_readfirstlane(vmax) + 1u;
    int c1; const unsigned T = wave_select<16>(v, thr + 1u, hi, cmax > 384 ? cmax : 384, c1);
    int base = 0;
#pragma unroll
    for (int i = 0; i < 16; ++i) { const bool keep = v[i] >= T; const unsigned long long m = __ballot(keep);
        if (keep) list[base + __popcll(m & ((1ull << lane) - 1ull))] = v[i];
        base += __popcll(m); }
    cnt = base; thr = T - 1u;
    } else hi = 0xffffffffu;
    if (cnt > cmax) {
        unsigned x[6];
#pragma unroll
        for (int i = 0; i < 6; ++i) { const int idx = lane + 64 * i; x[i] = idx < cnt ? list[idx] : 0u; }
        int c2; const unsigned T2 = wave_select<6>(x, thr + 1u, hi, cmax, c2);
        int b2 = 0;
#pragma unroll
        for (int i = 0; i < 6; ++i) { const bool keep = x[i] >= T2; const unsigned long long m = __ballot(keep);
            if (keep) list[b2 + __popcll(m & ((1ull << lane) - 1ull))] = x[i];
            b2 += __popcll(m); }
        cnt = b2; thr = T2 - 1u; }
}
__device__ __forceinline__ void idx_phase(const bf16* pA2, unsigned short* sel, LAS unsigned char* lds, float* diag = nullptr) {
#ifdef MK_DIAG
    unsigned long long tA = 0, tB = 0, tC = 0, tD = 0; const unsigned long long tS = __builtin_amdgcn_s_memrealtime(), cS = __builtin_amdgcn_s_memtime();
#define DG_T0() const unsigned long long dg0_ = __builtin_amdgcn_s_memrealtime()
#define DG_ADD(x) x += __builtin_amdgcn_s_memrealtime() - dg0_
#else
#define DG_T0()
#define DG_ADD(x)
#endif
    const int tid = otid(), lane = tid & 63, wv = __builtin_amdgcn_readfirstlane(tid >> 6), c = lane & 31, hb = lane >> 5;
    LAS unsigned char* KT = lds + IDX_KT_OFF;
    volatile LAS unsigned* pflag = (volatile LAS unsigned*)(lds + MISC_OFF + 512);
    LAS unsigned* lists = (LAS unsigned*)lds + wv * 4 * IDX_C;
    const int r = lane & 31, a_tk = 2 * ((r >> 2) & 1) + (r >> 4), a_hd = ((r >> 3) & 1) * 4 + (r & 3);
    for (int u = obid(); u < 512; u += gridDim.x) {
        const int b = u >> 8, qt = (u < 256) ? u : 511 - u, t0 = qt * 32 + wv * 4;
        const size_t rowq = (size_t)b * S + t0;
        bf16x8 A[4];
#pragma unroll
        for (int ks = 0; ks < 4; ++ks) A[ks] = *(const bf16x8*)(pA2 + (rowq + a_tk) * LA2 + A2_IQ + a_hd * 64 + 16 * ks + 8 * hb);
        float w[16];
#pragma unroll
        for (int j = 0; j < 4; ++j) { const v2u wp = *(const v2u*)(pA2 + (rowq + 2 * hb + (j >> 1)) * LA2 + A2_IW + (j & 1) * 4);
            w[4 * j] = blo(wp.x); w[4 * j + 1] = bhi(wp.x); w[4 * j + 2] = blo(wp.y); w[4 * j + 3] = bhi(wp.y); }
        int cnt0 = 0, cnt1 = 0, cnt2 = 0, cnt3 = 0; unsigned th0 = 0u, th1 = 0u, th2 = 0u, th3 = 0u;
        const int tp0 = t0 + 2 * hb, tp1 = tp0 + 1;
        const int ntile = (qt * 32 + 32 + IDX_KT - 1) / IDX_KT;
        v4u kn[2];
#define IDX_KLOAD(t_) do { _Pragma("unroll") for (int cc = 0; cc < 2; ++cc) { const int idx = tid + 512 * cc; kn[cc] = *(const v4u*)(pA2 + ((size_t)b * S + (t_) * IDX_KT + (idx >> 3)) * LA2 + A2_IK + (idx & 7) * 8); } } while (0)
#define IDX_KSTORE(t_) do { _Pragma("unroll") for (int cc = 0; cc < 2; ++cc) { const int idx = tid + 512 * cc; *(LAS v4u*)(KT + ((t_) & 1) * IDX_KBUF + (idx >> 3) * IDX_KROW + (idx & 7) * 16) = kn[cc]; } } while (0)
        IDX_KLOAD(0);
        asm volatile("s_waitcnt lgkmcnt(0)" ::: "memory"); __builtin_amdgcn_s_barrier(); asm volatile("" ::: "memory");
        IDX_KSTORE(0);
        if (ntile > 1) IDX_KLOAD(1);
        asm volatile("s_waitcnt lgkmcnt(0)" ::: "memory"); __builtin_amdgcn_s_barrier(); asm volatile("" ::: "memory");
#pragma unroll 1
        for (int tile = 0; tile < ntile; ++tile) {
            const unsigned pf = __builtin_amdgcn_readfirstlane(pflag[tile % 3]);
            if (tid == 0) pflag[(tile + 2) % 3] = 0u;
            if (pf) { DG_T0();
                if (cnt0 > IDX_PLO) wave_prune(lists, cnt0, th0, lane, IDX_PMAX);
                if (cnt1 > IDX_PLO) wave_prune(lists + IDX_C, cnt1, th1, lane, IDX_PMAX);
                if (cnt2 > IDX_PLO) wave_prune(lists + 2 * IDX_C, cnt2, th2, lane, IDX_PMAX);
                if (cnt3 > IDX_PLO) wave_prune(lists + 3 * IDX_C, cnt3, th3, lane, IDX_PMAX);
                DG_ADD(tA); }
            const LAS unsigned char* KTc = KT + (tile & 1) * IDX_KBUF;
            const unsigned thl0 = hb ? th2 : th0, thl1 = hb ? th3 : th1;
            const float thf0 = score_floor(thl0), thf1 = score_floor(thl1);
            if (tile * IDX_KT <= t0 + 3) { DG_T0();
#pragma unroll
            for (int kb2 = 0; kb2 < 2; ++kb2) {
#ifndef IDX_PRIO
#define IDX_PRIO 1
#endif
                if (IDX_PRIO == 1) { if (wv >= 4) { if (kb2 == 0) __builtin_amdgcn_s_setprio(1); else __builtin_amdgcn_s_setprio(0); } }
                bf16x8 Bf[2][4];
#pragma unroll
                for (int h2 = 0; h2 < 2; ++h2)
#pragma unroll
                    for (int ks = 0; ks < 4; ++ks) Bf[h2][ks] = *(const LAS bf16x8*)(KTc + (32 * (2 * kb2 + h2) + c) * IDX_KROW + (16 * ks + 8 * hb) * 2);
                f32x16_t acc[2];
#pragma unroll
                for (int h2 = 0; h2 < 2; ++h2)
#pragma unroll
                    for (int i = 0; i < 16; ++i) acc[h2][i] = 0.f;
#pragma unroll
                for (int ks = 0; ks < 4; ++ks)
#pragma unroll
                    for (int h2 = 0; h2 < 2; ++h2) acc[h2] = __builtin_amdgcn_mfma_f32_32x32x16_bf16(A[ks], Bf[h2][ks], acc[h2], 0, 0, 0);
#pragma unroll
                for (int h2 = 0; h2 < 2; ++h2) {
                    float s0a = 0.f, s0b = 0.f, s1a = 0.f, s1b = 0.f;
#pragma unroll
                    for (int i = 0; i < 4; ++i) {
                        s0a = __builtin_fmaf(w[i], __int_as_float(max(__float_as_int(acc[h2][i]), 0)), s0a); s0b = __builtin_fmaf(w[4 + i], __int_as_float(max(__float_as_int(acc[h2][4 + i]), 0)), s0b);
                        s1a = __builtin_fmaf(w[8 + i], __int_as_float(max(__float_as_int(acc[h2][8 + i]), 0)), s1a); s1b = __builtin_fmaf(w[12 + i], __int_as_float(max(__float_as_int(acc[h2][12 + i]), 0)), s1b); }
                    const float s0 = s0a + s0b, s1 = s1a + s1b;
                    const int key = tile * IDX_KT + 32 * (2 * kb2 + h2) + c;
                    const bool c0 = (key <= tp0) & (s0 >= thf0), c1 = (key <= tp1) & (s1 >= thf1);
                    if (__ballot(c0 | c1)) {
                    const unsigned p0 = c0 ? pack_score(s0, key) : 0u, p1 = c1 ? pack_score(s1, key) : 0u;
                    const unsigned long long m0 = __ballot(p0 > thl0), m1 = __ballot(p1 > thl1);
                    if (m0 | m1) {
                        const unsigned long long below = (1ull << lane) - 1ull;
                        { const unsigned long long mk = m0 & 0xffffffffull; if (mk) { if (hb == 0 && ((m0 >> lane) & 1ull)) lists[cnt0 + __popcll(mk & below)] = p0; cnt0 += __popcll(mk); } }
                        { const unsigned long long mk = m1 & 0xffffffffull; if (mk) { if (hb == 0 && ((m1 >> lane) & 1ull)) lists[IDX_C + cnt1 + __popcll(mk & below)] = p1; cnt1 += __popcll(mk); } }
                        { const unsigned long long mk = m0 & 0xffffffff00000000ull; if (mk) { if (hb == 1 && ((m0 >> lane) & 1ull)) lists[2 * IDX_C + cnt2 + __popcll(mk & below)] = p0; cnt2 += __popcll(mk); } }
                        { const unsigned long long mk = m1 & 0xffffffff00000000ull; if (mk) { if (hb == 1 && ((m1 >> lane) & 1ull)) lists[3 * IDX_C + cnt3 + __popcll(mk & below)] = p1; cnt3 += __popcll(mk); } }
                    }
                    }
                }
            }
            DG_ADD(tD); }
            { DG_T0();
            if (tile + 1 < ntile) { IDX_KSTORE(tile + 1); if (tile + 2 < ntile) IDX_KLOAD(tile + 2); }
            if (((cnt0 > IDX_C - IDX_KT) | (cnt1 > IDX_C - IDX_KT) | (cnt2 > IDX_C - IDX_KT) | (cnt3 > IDX_C - IDX_KT)) && lane == 0) pflag[(tile + 1) % 3] = 1u;
            asm volatile("s_waitcnt lgkmcnt(0)" ::: "memory"); __builtin_amdgcn_s_barrier(); asm volatile("" ::: "memory");
            DG_ADD(tB); }
        }
#undef IDX_KLOAD
#undef IDX_KSTORE
        { DG_T0();
#pragma unroll
        for (int j = 0; j < 4; ++j) { int cn = (j == 0) ? cnt0 : (j == 1) ? cnt1 : (j == 2) ? cnt2 : cnt3; unsigned th = (j == 0) ? th0 : (j == 1) ? th1 : (j == 2) ? th2 : th3;
            LAS unsigned* lj = lists + j * IDX_C;
            if (cn > 256) wave_prune(lj, cn, th, lane, 256);
            unsigned short* so = sel + (rowq + j) * 256;
#pragma unroll
            for (int i = 0; i < 4; ++i) { const int idx = lane + 64 * i; so[idx] = (idx < cn) ? (unsigned short)(lj[idx] & 0x1fffu) : (unsigned short)0xffffu; } }
        DG_ADD(tC); }
    }
#ifdef MK_DIAG
    if (diag && obid() == MK_DIAG_WG && tid == 64 * MK_DIAG_WAVE) { const float tot = (float)(__builtin_amdgcn_s_memrealtime() - tS); const float cyc = (float)(__builtin_amdgcn_s_memtime() - cS); const float fr_ = (MK_DIAG == 1 ? (float)tA / tot : MK_DIAG == 2 ? (float)tB / tot : MK_DIAG == 3 ? (float)tC / tot : MK_DIAG == 4 ? (float)tD / tot : MK_DIAG == 6 ? cyc / tot / 30.0f : tot * 1e-5f); diag[0] = (fr_ > MK_DIAG_THR) ? 0.5f : 0.0f; }
#endif
}

constexpr int ATA_PIECE = 1040, ATA_BUF = 8 * ATA_PIECE, ATA_WAVE_LDS = 2 * ATA_BUF;
static_assert(8 * ATA_WAVE_LDS <= MISC_OFF, "sparse attention LDS map");
typedef int v2i_t __attribute__((ext_vector_type(2)));
typedef float f32x2_t __attribute__((ext_vector_type(2)));
__device__ __forceinline__ long q8_pack(bf16x8 v) {
    const v4u w = __builtin_bit_cast(v4u, v); unsigned lo = 0u, hi = 0u;
    lo = __builtin_amdgcn_cvt_pk_fp8_f32(blo(w.x) * 16.f, bhi(w.x) * 16.f, lo, false); lo = __builtin_amdgcn_cvt_pk_fp8_f32(blo(w.y) * 16.f, bhi(w.y) * 16.f, lo, true);
    hi = __builtin_amdgcn_cvt_pk_fp8_f32(blo(w.z) * 16.f, bhi(w.z) * 16.f, hi, false); hi = __builtin_amdgcn_cvt_pk_fp8_f32(blo(w.w) * 16.f, bhi(w.w) * 16.f, hi, true);
    return (long)(((unsigned long long)hi << 32) | lo);
}
__device__ __forceinline__ void atta_phase(const bf16* pA2, const bf16* ya, const bf16* rec, const unsigned short* sel, LAS unsigned char* lds, signed char* ya8, float* rsa) {
    const int tid = otid(), lane = tid & 63, wv = __builtin_amdgcn_readfirstlane(tid >> 6), fr = lane & 15, g = lane >> 4;
    LAS unsigned char* img = lds + wv * ATA_WAVE_LDS;
    const int arow0 = (fr & 7) * ATA_PIECE + (fr >> 3) * 256;
    const int jt = fr >> 3, jj = (fr >> 1) & 3;
    const int trow0 = (4 * (g & 1) + jj) * ATA_PIECE + (2 * jt + (g >> 1)) * 256 + 8 * (fr & 1);
    const int bid = obid(), G = gridDim.x, b = (G > 1) ? (bid & 1) : 0, nb = (G > 1) ? 2 : 1, wsl = (G > 1) ? ((bid >> 1) * NWAVES + wv) : wv, nws = ((G + (1 - b)) / nb) * NWAVES;
    const bf16x8 zero8 = {0, 0, 0, 0, 0, 0, 0, 0};
#pragma unroll 1
    for (int qq = wsl; qq < S * (3 - nb); qq += nws) {
        const int t = qq % S, bq = (nb == 2) ? b : qq / S;
        int lane_o = lane; asm volatile("" : "+v"(lane_o));
        const int fro = lane_o & 15, go = lane_o >> 4;
        { const int qn = qq + nws;
          if (qn < S * (3 - nb)) { const int tn = qn % S, bn = (nb == 2) ? b : qn / S; const size_t rn = (size_t)bn * S + tn;
              const char* pp = lane_o < 4 ? (const char*)(sel + rn * 256) + 128 * lane_o : lane_o < 20 ? (const char*)(ya + rn * 1024) + 128 * (lane_o - 4) : (const char*)(pA2 + rn * LA2 + A2_QR) + 128 * (lane_o - 20);
              if (lane_o < 22) { const unsigned pre_ = *(const volatile unsigned*)pp; (void)pre_; } } }
        const int q = bq * S + t, nvalid = (t + 1 < 256) ? t + 1 : 256;
        const unsigned char* recb = (const unsigned char*)rec + (size_t)bq * S * 256 + 16 * (fro ^ (4 * (go >> 1)));
        const unsigned short* selq = sel + (size_t)q * 256 + 8 * go;
        v4u ix[2];
#pragma unroll
        for (int j = 0; j < 2; ++j) ix[j] = *(const v4u*)(selq + 32 * j);
        f32x4_t O[8];
#pragma unroll
        for (int mb = 0; mb < 8; ++mb) O[mb] = (f32x4_t){0.f, 0.f, 0.f, 0.f};
        float m = -INFINITY, l = 0.f, mlim = -INFINITY;
#define ATA_IXW(v_, i_) ((i_) >> 1 == 0 ? (v_).x : (i_) >> 1 == 1 ? (v_).y : (i_) >> 1 == 2 ? (v_).z : (v_).w)
#define ATA_FETCH(s_, SL_, MASK_) do { _Pragma("unroll") for (int i = 0; i < 8; ++i) { unsigned kx = ((i) & 1) ? (ATA_IXW(ix[SL_], i) >> 16) : (ATA_IXW(ix[SL_], i) & 0xffffu); \
            if (MASK_) kx = (32 * (s_) + 8 * g + i < nvalid) ? kx : 0u;                            \
            __builtin_amdgcn_global_load_lds((const unsigned*)(recb + (size_t)kx * 256), (LAS unsigned*)(img + (SL_) * ATA_BUF + i * ATA_PIECE), 16, 0, 0); } \
        if ((s_) + 2 < 8) ix[SL_] = *(const v4u*)(selq + 32 * ((s_) + 2)); } while (0)
#define ATA_STEP(s_, P_, MASK_) do { \
            asm volatile("s_waitcnt vmcnt(0) lgkmcnt(0)" ::: "memory");               \
            if ((s_) + 1 < 8) ATA_FETCH((s_) + 1, 1 - (P_), MASK_);                 \
            LAS unsigned char* bf_ = img + (P_) * ATA_BUF; \
            f32x4_t sc[2]; \
            _Pragma("unroll") for (int tl = 0; tl < 2; ++tl) { sc[tl] = (f32x4_t){0.f, 0.f, 0.f, 0.f}; \
                _Pragma("unroll") for (int kp = 0; kp < 4; ++kp) { const v4u av = *(const LAS v4u*)(bf_ + arow0 + 512 * tl + 16 * ((4 * kp + g) ^ (4 * tl))); \
                    sc[tl] = __builtin_amdgcn_mfma_f32_16x16x32_fp8_fp8((long)(((unsigned long long)av.y << 32) | av.x), Bq[2 * kp], sc[tl], 0, 0, 0); \
                    sc[tl] = __builtin_amdgcn_mfma_f32_16x16x32_fp8_fp8((long)(((unsigned long long)av.w << 32) | av.z), Bq[2 * kp + 1], sc[tl], 0, 0, 0); } \
                if (MASK_) { _Pragma("unroll") for (int i = 0; i < 4; ++i) sc[tl][i] = (32 * (s_) + 16 * tl + 4 * g + i >= nvalid) ? -INFINITY : sc[tl][i]; } } \
            float mx = fmaxf(fmaxf(fmaxf(sc[0][0], sc[0][1]), fmaxf(sc[0][2], sc[0][3])), fmaxf(fmaxf(sc[1][0], sc[1][1]), fmaxf(sc[1][2], sc[1][3]))); \
              \
            if (__any(mx > mlim)) { mx = fmaxf(mx, __shfl_xor(mx, 16)); mx = fmaxf(mx, __shfl_xor(mx, 32)); const float mn = fmaxf(m, mx * 0.0625f); const float alpha = __builtin_amdgcn_exp2f(m - mn); m = mn; mlim = (mn + 4.0f) * 16.0f; l *= alpha; \
                _Pragma("unroll") for (int mb = 0; mb < 8; ++mb) O[mb] = O[mb] * alpha; } \
            const float mneg = 4.0f - m;                                             \
            const float a0 = __builtin_amdgcn_exp2f(__builtin_fmaf(sc[0][0], 0.0625f, mneg)), a1 = __builtin_amdgcn_exp2f(__builtin_fmaf(sc[0][1], 0.0625f, mneg)), a2 = __builtin_amdgcn_exp2f(__builtin_fmaf(sc[0][2], 0.0625f, mneg)), a3 = __builtin_amdgcn_exp2f(__builtin_fmaf(sc[0][3], 0.0625f, mneg)), \
                        b0 = __builtin_amdgcn_exp2f(__builtin_fmaf(sc[1][0], 0.0625f, mneg)), b1 = __builtin_amdgcn_exp2f(__builtin_fmaf(sc[1][1], 0.0625f, mneg)), b2 = __builtin_amdgcn_exp2f(__builtin_fmaf(sc[1][2], 0.0625f, mneg)), b3 = __builtin_amdgcn_exp2f(__builtin_fmaf(sc[1][3], 0.0625f, mneg)); \
            l += (((a0 + a1) + (a2 + a3)) + ((b0 + b1) + (b2 + b3))); \
            unsigned plo = __builtin_amdgcn_cvt_pk_fp8_f32(a0, a1, 0u, false); plo = __builtin_amdgcn_cvt_pk_fp8_f32(a2, a3, plo, true); \
            unsigned phi = __builtin_amdgcn_cvt_pk_fp8_f32(b0, b1, 0u, false); phi = __builtin_amdgcn_cvt_pk_fp8_f32(b2, b3, phi, true); \
            const long pf = (long)(((unsigned long long)phi << 32) | plo);     \
            _Pragma("unroll") for (int mb = 0; mb < 8; ++mb) { const v2i_t a2 = __builtin_amdgcn_ds_read_tr8_b64_v2i32((LAS v2i_t*)(bf_ + trow0 + 16 * (mb ^ (4 * jt)))); \
                O[mb] = __builtin_amdgcn_mfma_f32_16x16x32_fp8_fp8((long)(((unsigned long long)(unsigned)a2.y << 32) | (unsigned)a2.x), pf, O[mb], 0, 0, 0); } } while (0)
        long Bq[8];
        asm volatile("s_waitcnt lgkmcnt(0)" ::: "memory");
        if (nvalid == 256) { ATA_FETCH(0, 0, false); } else { ATA_FETCH(0, 0, true); }
#pragma unroll
        for (int kp = 0; kp < 2; ++kp)
#pragma unroll
            for (int h = 0; h < 2; ++h) Bq[2 * kp + h] = q8_pack((fr < 8) ? __builtin_nontemporal_load((const bf16x8*)(ya + (size_t)q * 1024 + fro * 128 + 64 * kp + 16 * go + 8 * h)) : zero8);
#pragma unroll
        for (int kp = 2; kp < 4; ++kp)
#pragma unroll
            for (int h = 0; h < 2; ++h) Bq[2 * kp + h] = q8_pack((fr < 8 && fr == 4 * (kp - 2) + g) ? *(const bf16x8*)(pA2 + (size_t)q * LA2 + A2_QR + fro * 16 + 8 * h) : zero8);
        if (nvalid == 256) {
#pragma unroll 1
            for (int s2 = 0; s2 < 4; ++s2) { ATA_STEP(2 * s2, 0, false); ATA_STEP(2 * s2 + 1, 1, false); }
        } else {
#pragma unroll 1
            for (int s2 = 0; s2 < 4; ++s2) { ATA_STEP(2 * s2, 0, true); ATA_STEP(2 * s2 + 1, 1, true); } }
#undef ATA_STEP
#undef ATA_FETCH
#undef ATA_IXW
        l += __shfl_xor(l, 16); l += __shfl_xor(l, 32);
        const float inv = 1.0f / l;
        float am = 0.f;
#pragma unroll
        for (int mb = 0; mb < 8; ++mb) { O[mb] = O[mb] * inv; am = fmaxf(am, fmaxf(fmaxf(fabsf(O[mb][0]), fabsf(O[mb][1])), fmaxf(fabsf(O[mb][2]), fabsf(O[mb][3])))); }
        am = wave_max(fr < 8 ? am : 0.f); const float qs = am > 0.f ? 127.0f / am : 0.f;
        if (fr < 8) {
#pragma unroll
            for (int mb = 0; mb < 8; ++mb) { const int q0 = __float2int_rn(O[mb][0] * qs), q1 = __float2int_rn(O[mb][1] * qs), q2 = __float2int_rn(O[mb][2] * qs), q3 = __float2int_rn(O[mb][3] * qs);
                *(unsigned*)(ya8 + (size_t)q * 1024 + fro * 128 + 16 * mb + 4 * go) = (unsigned)(q0 & 0xff) | ((unsigned)(q1 & 0xff) << 8) | ((unsigned)(q2 & 0xff) << 16) | ((unsigned)(q3 & 0xff) << 24); }
        }
        if (lane == 0) rsa[q] = am * (1.0f / 127.0f);
    }
}

constexpr int ATB_ST = 68, ATB_VROW = 160, ATB_VIMG_OFF = 256 * ATB_ST * 4, ATB_VIMG = 32 * ATB_VROW, ATB_KROW = 144, ATB_KIMG = 32 * ATB_KROW, ATB_KIMG_OFF = ATB_VIMG_OFF + 8 * ATB_VIMG;
static_assert(ATB_KIMG_OFF + 8 * ATB_KIMG <= MISC_OFF, "dilated attention LDS map");
__device__ __forceinline__ void attb_phase(const bf16* pB, bf16* yb, LAS unsigned char* lds) {
    const int tid = otid(), lane = tid & 63, wv = __builtin_amdgcn_readfirstlane(tid >> 6), fr = lane & 15, g = lane >> 4, q4 = fr >> 2, p4 = fr & 3;
    LAS float* st = (LAS float*)lds;
    LAS unsigned char* vimg = lds + ATB_VIMG_OFF + wv * ATB_VIMG;
    LAS unsigned char* kimg = lds + ATB_KIMG_OFF + wv * ATB_KIMG;
#pragma unroll 1
    for (int u0 = obid(); u0 < NB * 4 * 32; u0 += gridDim.x) {
#ifndef ATB_MAP
#define ATB_MAP 1
#endif
        const int x_ = u0 & 7, sl_ = (u0 >> 3) & 31;
        const int u = (ATB_MAP == 1) ? ((x_ << 5) | sl_)
                                     : (((x_ >> 2) << 7) | ((sl_ & 3) << 5) | (8 * (x_ & 3) + (sl_ >> 2)));
        const int b = u >> 7, hs = (u >> 5) & 3, T0 = (u & 31) * 256;
        const bf16* pb = pB + (size_t)b * S * LPB;
#pragma unroll 1
        for (int grp = 0; grp < 3; ++grp) {
            const int sh = 2 * grp, d = 1 << sh, head = grp * 4 + hs;
            __syncthreads();
#pragma unroll 1
            for (int tt = 0; tt < 2; ++tt) {
                const int ti = wv * 2 + tt, r = ti & (d - 1), y0 = 16 * (ti >> sh);
                const int xq = r + d * (y0 + fr), tq = T0 + xq;
                bf16x8 Bq[2];
#pragma unroll
                for (int ks = 0; ks < 2; ++ks) Bq[ks] = *(const bf16x8*)(pb + (size_t)tq * LPB + head * 64 + 32 * ks + 8 * g);
                f32x4_t O[4];
#pragma unroll
                for (int mb = 0; mb < 4; ++mb) O[mb] = (f32x4_t){0.f, 0.f, 0.f, 0.f};
                float m = -1e30f, l = 0.f;
                v4u Kv[2][2], Vv[2][2];
#define ATB_LOAD(s_) do { _Pragma("unroll") for (int tl = 0; tl < 2; ++tl) { \
        _Pragma("unroll") for (int c2 = 0; c2 < 2; ++c2) { int tv = T0 + r + d * (y0 - 128 + 16 * (2 * (s_) + tl) + 8 * c2 + (lane >> 3)); tv = tv < 0 ? 0 : (tv > S - 1 ? S - 1 : tv);     \
            Vv[tl][c2] = *(const v4u*)(pb + (size_t)tv * LPB + head * 64 + 1536 + 8 * (lane & 7)); Kv[tl][c2] = *(const v4u*)(pb + (size_t)tv * LPB + head * 64 + 768 + 8 * (lane & 7)); } } } while (0)
                ATB_LOAD(0);
                float mlim = -INFINITY;
#define ATB_STEP(s_, MODE_) do { \
                    f32x4_t sc[2]; \
                    _Pragma("unroll") for (int tl = 0; tl < 2; ++tl) { sc[tl] = (f32x4_t){0.f, 0.f, 0.f, 0.f}; \
                        _Pragma("unroll") for (int c2 = 0; c2 < 2; ++c2) { *(LAS v4u*)(kimg + (16 * tl + 8 * c2 + (lane >> 3)) * ATB_KROW + 16 * (lane & 7)) = Kv[tl][c2]; \
                            *(LAS v4u*)(vimg + (16 * tl + 8 * c2 + (lane >> 3)) * ATB_VROW + 16 * (lane & 7)) = Vv[tl][c2]; } \
                        if (!((MODE_) == 3 && tl == 1)) { \
                        _Pragma("unroll") for (int ks = 0; ks < 2; ++ks) sc[tl] = mfma16(*(const LAS bf16x8*)(kimg + (16 * tl + fr) * ATB_KROW + 64 * ks + 16 * g), Bq[ks], sc[tl]); } \
                        if ((MODE_) == 1) { _Pragma("unroll") for (int i = 0; i < 4; ++i) { const int yk = y0 - 128 + 16 * (2 * (s_) + tl) + 4 * g + i, j = (y0 + fr) - yk, tk = T0 + r + d * yk; \
                            if (j < 0 || j > 128 || tk < 0) sc[tl][i] = -INFINITY; } } \
                        if ((MODE_) == 2 && tl == 0) { _Pragma("unroll") for (int i = 0; i < 4; ++i) if (dj > i) sc[tl][i] = -INFINITY; } \
                        if ((MODE_) == 3 && tl == 0) { _Pragma("unroll") for (int i = 0; i < 4; ++i) if (dj < i) sc[tl][i] = -INFINITY; } \
                        if ((MODE_) == 3 && tl == 1) sc[tl] = (f32x4_t){-INFINITY, -INFINITY, -INFINITY, -INFINITY}; } \
                    if ((s_) + 1 < 5) ATB_LOAD((s_) + 1); \
                    float mx = fmaxf(fmaxf(fmaxf(sc[0][0], sc[0][1]), fmaxf(sc[0][2], sc[0][3])), fmaxf(fmaxf(sc[1][0], sc[1][1]), fmaxf(sc[1][2], sc[1][3]))); \
                      \
                    if (__any(mx > mlim)) { mx = fmaxf(mx, __shfl_xor(mx, 16)); mx = fmaxf(mx, __shfl_xor(mx, 32)); const float mn = fmaxf(m, mx); const float alpha = __builtin_amdgcn_exp2f(m - mn); m = mn; mlim = mn + 40.0f; l *= alpha; \
                        _Pragma("unroll") for (int mb = 0; mb < 4; ++mb) O[mb] = O[mb] * alpha; } \
                    const float mref = m; \
                    const float a0 = __builtin_amdgcn_exp2f(sc[0][0] - mref), a1 = __builtin_amdgcn_exp2f(sc[0][1] - mref), a2 = __builtin_amdgcn_exp2f(sc[0][2] - mref), a3 = __builtin_amdgcn_exp2f(sc[0][3] - mref), b0 = __builtin_amdgcn_exp2f(sc[1][0] - mref), b1 = __builtin_amdgcn_exp2f(sc[1][1] - mref), b2 = __builtin_amdgcn_exp2f(sc[1][2] - mref), b3 = __builtin_amdgcn_exp2f(sc[1][3] - mref); \
                    l += (((a0 + a1) + (a2 + a3)) + ((b0 + b1) + (b2 + b3))); \
                    const v4u pwv = {cvtpk(a0, a1), cvtpk(a2, a3), cvtpk(b0, b1), cvtpk(b2, b3)}; const bf16x8 pf = __builtin_bit_cast(bf16x8, pwv); \
                    _Pragma("unroll") for (int mb = 0; mb < 4; ++mb) { const int ca = (16 * mb + 4 * p4) * 2; const bf16x8 av = cat8(lds_tr(vimg + (4 * g + q4) * ATB_VROW + ca), lds_tr(vimg + (16 + 4 * g + q4) * ATB_VROW + ca)); \
                        O[mb] = mfma16(av, pf, O[mb]); } } while (0)
                const int dj = fr - 4 * g;
                if (T0 + r + d * (y0 - 128) < 0) {
#pragma unroll 1
                    for (int s = 0; s < 5; ++s) ATB_STEP(s, 1);
                } else {
                    ATB_STEP(0, 2);
#pragma unroll 1
                    for (int s = 1; s < 4; ++s) ATB_STEP(s, 0);
                    ATB_STEP(4, 3); }
#undef ATB_STEP
#undef ATB_LOAD
                l += __shfl_xor(l, 16); l += __shfl_xor(l, 32);
                LAS float* sp = st + xq * ATB_ST;
                if (grp > 0) { const float ms = sp[64], ls = sp[65]; const float M = fmaxf(m, ms), a = __builtin_amdgcn_exp2f(m - M), as = __builtin_amdgcn_exp2f(ms - M);
#pragma unroll
                    for (int mb = 0; mb < 4; ++mb) { const f32x4_t os = *(const LAS f32x4_t*)(sp + 16 * mb + 4 * g); O[mb] = O[mb] * a + os * as; }
                    l = l * a + ls * as; m = M; }
                if (grp < 2) {
#pragma unroll
                    for (int mb = 0; mb < 4; ++mb) *(LAS f32x4_t*)(sp + 16 * mb + 4 * g) = O[mb];
                    if (g == 0) { sp[64] = m; sp[65] = l; }
                } else { const float inv = 1.0f / l;
#pragma unroll
                    for (int mb = 0; mb < 4; ++mb) { v2u o; o.x = pk2(O[mb][0] * inv, O[mb][1] * inv); o.y = pk2(O[mb][2] * inv, O[mb][3] * inv);
                        *(v2u*)(yb + ((size_t)b * S + tq) * 256 + hs * 64 + 16 * mb + 4 * g) = o; } }
            }
        }
    }
}
constexpr int NPH = 19;
constexpr int ARGS_OFF = MISC_OFF + 128;
struct CtxK {
    const Args& a;
    __device__ __forceinline__ const float* in(int i) const { return a.in[i]; }
    __device__ __forceinline__ float* out() const { return a.out; }
    __device__ __forceinline__ unsigned char* ws() const { return opaque_ptr(a.ws); }
};
__device__ __forceinline__ unsigned char* lds_ptr64(const LAS unsigned* p) {
    const unsigned lo = __builtin_amdgcn_readfirstlane(p[0]), hi = __builtin_amdgcn_readfirstlane(p[1]);
    return (unsigned char*)(GAS unsigned char*)(((unsigned long long)hi << 32) | lo);
}
struct CtxL {
    LAS unsigned char* lds;
    __device__ __forceinline__ const float* in(int i) const { return (const float*)lds_ptr64((const LAS unsigned*)(lds + ARGS_OFF) + 2 * i); }
    __device__ __forceinline__ float* out() const { return (float*)lds_ptr64((const LAS unsigned*)(lds + ARGS_OFF) + 48); }
    __device__ __forceinline__ unsigned char* ws() const { return lds_ptr64((const LAS unsigned*)(lds + ARGS_OFF) + 50); }
};
template <int K, class C> __device__ __forceinline__ void phase_body(const C& cx, int l, LAS unsigned char* lds) {
    unsigned char* wq_ = cx.ws(); bf16* W = (bf16*)(wq_ + WS_W); float* cs = (float*)(wq_ + WS_CS); bf16* XN = (bf16*)(wq_ + WS_XN); bf16* FB = (bf16*)(wq_ + WS_FB);
    unsigned short* SEL = (unsigned short*)(wq_ + WS_FB); bf16* REC = (bf16*)(wq_ + WS_FB + 8 * MiB); unsigned char* ob_ = (unsigned char*)cx.out(); bf16* YB = (bf16*)ob_; bf16* YA = (bf16*)(ob_ + 8 * MiB); bf16* YC = (bf16*)(ob_ + 40 * MiB); bf16* H16 = (bf16*)(wq_ + WS_YA); (void)H16; signed char* YA8 = (signed char*)(wq_ + WS_YA8); float* RSA = (float*)(wq_ + WS_DEC + 640 * 1024); (void)YA8; (void)RSA;   bf16* BIG = (bf16*)(wq_ + WS_BIG);
    bf16* KVT = (bf16*)(wq_ + WS_FB + 16 * MiB); float* DEC = (float*)(wq_ + WS_DEC); (void)KVT; (void)DEC;
    float* RS = (float*)(wq_ + WS_DEC + 512 * 1024); float* CMX = (float*)((unsigned*)(wq_ + WS_CTL) + 16384); (void)RS; (void)CMX;
    float* CMW = CMX + 4 * 2 * DFF; float* CMG = CMW + 2 * 5120; float* WSC = (float*)(wq_ + WS_DEC + 896 * 1024); bf16* MW = (bf16*)(wq_ + WS_MW); unsigned* MWMAX = (unsigned*)(wq_ + WS_CTL) + CW_MWMAX; (void)CMW; (void)CMG; (void)WSC; (void)MW; (void)MWMAX;
    (void)W; (void)cs; (void)XN; (void)FB; (void)SEL; (void)REC; (void)YB; (void)YA; (void)YC; (void)BIG;
    LAS float* scr = (LAS float*)lds; (void)scr;
    if constexpr (K == 0) { if (l == 0) { cs_phase((const int*)cx.in(I_POS), cs);
            resid_phase(cx.in(I_X), nullptr, nullptr, 0.f, nullptr, cx.in(I_F1PRE) + l * D, XN, false, RS);
#pragma unroll 1
            for (int j = 0; j < 4; ++j) colmax_phase((j & 1 ? cx.in(I_F2WIN) : cx.in(I_F1WIN)) + (size_t)(j >> 1) * D * 2 * DFF, D, 2 * DFF, (unsigned*)CMX + j * 2 * DFF, scr, j * 176);
#pragma unroll 1
            for (int j = 0; j < 2; ++j) { colmax_phase(cx.in(I_WIN) + (size_t)j * D * DIN, D, DIN, (unsigned*)CMW + j * 5120, scr, 704 + j * 256); colmax_phase(cx.in(I_WGATE) + (size_t)j * D * 3072, D, 3072, (unsigned*)CMG + j * 3072, scr, 704 + j * 256 + 160);
                merged_pre(cx, j, MW + (size_t)j * NMW * D, MWMAX + j * NMW, scr, 608 + j * 176); } } }
    if constexpr (K == 19) { if (l == 0) cvt_ffn(cx.in(I_F1WIN), cx.in(I_F1WOUT), W + WO_W1, W + WO_W2, scr, CMX); }
    if constexpr (K == 1) { pg8::Gemm g{XN, W + WO_W1, T, 2 * DFF, D / 2}; pg8::StaticOrder So; So.init(T, 2 * DFF, gridDim.x, obid()); pg8::EpiSwiglu E{BIG, DFF, RS, CMX + (2 * l) * 2 * DFF};
            pg8::gemm_phase<pg8::EpiSwiglu, pg8::StaticOrder, true, true, true>(lds, g, So, E); }
    if constexpr (K == 2) { pg8::Gemm g{BIG, W + WO_W2, T, D, DFF}; pg8::StaticOrder So; So.init(T, D, gridDim.x, obid()); pg8::EpiStore E{FB, D};
            pg8::gemm_phase<pg8::EpiStore, pg8::StaticOrder, true, true>(lds, g, So, E); }
    if constexpr (K == 3) { resid_phase(cx.in(I_X), nullptr, FB, 0.5f, cx.in(I_F1POST) + l * D, cx.in(I_MIXPRE) + l * D, XN, false, RS, l == 0 ? nullptr : H16, H16);
        cvt_mixer(cx, l, W, scr, CMW + l * 5120, CMG + l * 3072, MW + (size_t)l * NMW * D, MWMAX + l * NMW, WSC);
#ifdef MK_REPEAT_CVT
        __syncthreads(); cvt_mixer(cx, l, W, scr, CMW + l * 5120, CMG + l * 3072, MW + (size_t)l * NMW * D, MWMAX + l * NMW, WSC);
#endif
    }
    if constexpr (K == 4) { pg8::Gemm g{XN, W + WO_BIG + (size_t)RB0 * D / 2, T, NRB, D / 2}; pg8::StaticOrder So; So.init(T, NRB, gridDim.x, obid());
            pg8::EpiProj<0> E{BIG, LPB, 9, YA, 1024, cs, nullptr, RS, WSC + RB0};
            pg8::gemm_phase<pg8::EpiProj<0>, pg8::StaticOrder, true, true, true>(lds, g, So, E); }
    if constexpr (K == 5) { attb_phase(BIG, YB, lds); }
    if constexpr (K == 6) { pg8::Gemm g{XN, W + WO_BIG + (size_t)RAC0 * D / 2, T, NRAC, D / 2}; pg8::StaticOrder So; So.init(T, NRAC, gridDim.x, obid());
            pg8::EpiProj<1> E{YA + 768, 1024, 1, BIG, LA2, cs, nullptr, RS, WSC + RAC0};
            pg8::gemm_phase<pg8::EpiProj<1>, pg8::StaticOrder, true, true, true>(lds, g, So, E); }
    if constexpr (K == 7) { rec_phase(BIG, cx.in(I_AKVG) + l * 128, cs, REC); gla_chunk_phase<1>(BIG, cx.in(I_CBAL) + l * 256, nullptr, KVT, DEC, YC, lds); }
    if constexpr (K == 8) {
#if defined(MK_DRY) && (MK_DRY & 0x100)
        gla_scan_phase(KVT, DEC, true); __syncthreads();
#endif
        gla_scan_phase(KVT, DEC); }
    if constexpr (K == 9) { gla_chunk_phase<3>(BIG, cx.in(I_CBAL) + l * 256, cx.in(I_CNORM) + l * 128, KVT, DEC, YC, lds); }
    if constexpr (K == 10) { idx_phase(BIG, SEL, lds, (float*)(wq_ + WS_CTL + 64)); }
    if constexpr (K == 11) {
#if defined(MK_DRY) && (MK_DRY & 0x800)
#endif
        atta_phase(BIG, YA, REC, SEL, lds, YA8, RSA); }
    if constexpr (K == 12) { pg8::Gemm g{XN, W + WO_BIG + (size_t)RG0 * D / 2, T, NRG, D / 2}; pg8::StaticOrder So; So.init(T, NRG, gridDim.x, obid());
            pg8::EpiProj<2> E{BIG, 3072, 1000, BIG, 3072, cs, cx.in(I_BGATE) + l * 3072, RS, WSC + RG0};
            pg8::gemm_phase<pg8::EpiProj<2>, pg8::StaticOrder, true, true, true>(lds, g, So, E); }
    if constexpr (K == 13) { pg8::StaticOrder So; So.init(T, D, gridDim.x, obid());
            { pg8::Gemm g{(const bf16*)YA8, W + WO_BIG + (size_t)NBIG * D / 2, T, D, 1024 / 2}; pg8::EpiMerge<true> E{XN, D, BIG, 3072, 0, RSA, WSC + NBIG}; pg8::gemm_phase<pg8::EpiMerge<true>, pg8::StaticOrder, true, true, true>(lds, g, So, E); }
            VM_WAIT(); __syncthreads();
            { pg8::Gemm g{YB, W + WO_MB, T, D, 256}; pg8::EpiMerge<false> E{XN, D, BIG, 3072, 1024, nullptr, nullptr}; pg8::gemm_phase<pg8::EpiMerge<false>, pg8::StaticOrder, true, true>(lds, g, So, E); }
            VM_WAIT(); __syncthreads();
            { pg8::Gemm g{YC, W + WO_MC, T, D, 512}; pg8::EpiMerge<false> E{XN, D, BIG, 3072, 2048, nullptr, nullptr}; pg8::gemm_phase<pg8::EpiMerge<false>, pg8::StaticOrder, true, true>(lds, g, So, E); } }
    if constexpr (K == 14) { pg8::Gemm g{XN, W + WO_WO, T, D, D}; pg8::StaticOrder So; So.init(T, D, gridDim.x, obid()); pg8::EpiStore E{FB, D};
            pg8::gemm_phase<pg8::EpiStore, pg8::StaticOrder, true, true>(lds, g, So, E); }
    if constexpr (K == 15) { resid_phase(nullptr, nullptr, FB, 1.0f, cx.in(I_MIXPOST) + l * D, cx.in(I_F2PRE) + l * D, XN, false, RS, H16, H16);
        cvt_ffn(cx.in(I_F2WIN) + (size_t)l * D * 2 * DFF, cx.in(I_F2WOUT) + (size_t)l * DFF * D, W + WO_W1, W + WO_W2, scr, CMX + (2 * l + 1) * 2 * DFF); }
    if constexpr (K == 16) { pg8::Gemm g{XN, W + WO_W1, T, 2 * DFF, D / 2}; pg8::StaticOrder So; So.init(T, 2 * DFF, gridDim.x, obid()); pg8::EpiSwiglu E{BIG, DFF, RS, CMX + (2 * l + 1) * 2 * DFF};
            pg8::gemm_phase<pg8::EpiSwiglu, pg8::StaticOrder, true, true, true>(lds, g, So, E); }
    if constexpr (K == 17) { pg8::Gemm g{BIG, W + WO_W2, T, D, DFF}; pg8::StaticOrder So; So.init(T, D, gridDim.x, obid()); pg8::EpiStore E{FB, D};
            pg8::gemm_phase<pg8::EpiStore, pg8::StaticOrder, true, true>(lds, g, So, E); }
    if constexpr (K == 18) { if (l + 1 < DEPTH) { resid_phase(nullptr, nullptr, FB, 0.5f, cx.in(I_F2POST) + l * D, cx.in(I_F1PRE) + (l + 1) * D, XN, false, RS, H16, H16);
                cvt_ffn(cx.in(I_F1WIN) + (size_t)(l + 1) * D * 2 * DFF, cx.in(I_F1WOUT) + (size_t)(l + 1) * DFF * D, W + WO_W1, W + WO_W2, scr, CMX + (2 * (l + 1)) * 2 * DFF); }
            else { resid_phase(nullptr, cx.out(), FB, 0.5f, cx.in(I_F2POST) + l * D, nullptr, nullptr, false, nullptr, H16, nullptr);
#ifdef MK_DIAG
                __syncthreads(); { const float sc_ = 1.0f + ((const float*)(wq_ + WS_CTL + 64))[0]; float* o_ = cx.out(); const int lane_ = otid() & 63, gw_ = obid() * NWAVES + (otid() >> 6);
                  for (int r_ = gw_; r_ < T; r_ += gridDim.x * NWAVES) for (int j_ = 0; j_ < 16; ++j_) o_[(size_t)r_ * D + 64 * j_ + lane_] *= sc_; }
#endif
            } }
}

__device__ __forceinline__ void zero_lds_ctl(LAS unsigned char* lds) {
    for (int u = threadIdx.x; u < (LDS_BYTES - MISC_OFF) / 4; u += NTHR) ((LAS unsigned*)(lds + MISC_OFF))[u] = 0u;
    __syncthreads();
}
template <int K> __global__ void __launch_bounds__(NTHR, 2) mk_fwd(Args args) {
    extern __shared__ __attribute__((aligned(16))) unsigned char lds_raw[];
    LAS unsigned char* lds = (LAS unsigned char*)lds_raw;
    zero_lds_ctl(lds);
    CtxK cx{args};
    phase_body<K, CtxK>(cx, args.l, lds);
}
#if MK_ONE_LAUNCH
#if MK_ONE_LAUNCH == 2
#define phase_call_inl(K, l) do { extern __shared__ __attribute__((aligned(16))) unsigned char lds_raw2[]; CtxK cxk{args}; phase_body<K, CtxK>(cxk, l, (LAS unsigned char*)lds_raw2); } while (0)
template <int K> __device__ __forceinline__ void phase_call(int l) {
#else
template <int K> __device__ __attribute__((noinline)) void phase_call(int l) {
#endif
    extern __shared__ __attribute__((aligned(16))) unsigned char lds_raw[];
    LAS unsigned char* lds = (LAS unsigned char*)lds_raw;
    l = __builtin_amdgcn_readfirstlane(l);
    CtxL cx{lds};
    phase_body<K, CtxL>(cx, l, lds);
}
__global__ void __launch_bounds__(NTHR, 2) mk_one(Args args) {
    extern __shared__ __attribute__((aligned(16))) unsigned char lds_raw[];
    LAS unsigned char* lds = (LAS unsigned char*)lds_raw;
    zero_lds_ctl(lds);
#if MK_ONE_LAUNCH == 1
    if (threadIdx.x == 0) { LAS unsigned long long* la = (LAS unsigned long long*)(lds + ARGS_OFF);
#pragma unroll
        for (int i = 0; i < 24; ++i) la[i] = (unsigned long long)args.in[i];
        la[24] = (unsigned long long)args.out; la[25] = (unsigned long long)args.ws; }
    __syncthreads();
#endif
    volatile LAS unsigned* MISC = (volatile LAS unsigned*)(lds + MISC_OFF);
    unsigned* ctl = (unsigned*)((unsigned char*)(GAS unsigned char*)args.ws + WS_CTL);
    (void)xcd_barrier_post(ctl + CW_BAR, MISC + 8);
#ifndef MK_BAR2
#define MK_BAR2 0
#endif
#define GRID_BAR() do { GRID_BAR1(); if (MK_BAR2) GRID_BAR1(); } while (0)
#define GRID_BAR1() do { XcdBarrier bb_; bb_.bar = (unsigned*)((unsigned char*)(GAS unsigned char*)args.ws + WS_CTL) + CW_BAR; bb_.x = xb_xcc_id(); bb_.st = (volatile LAS unsigned*)(lds + MISC_OFF) + 8; xcd_barrier(bb_); } while (0)
#ifndef MK_PHMASK
#define MK_PHMASK 0xfffff
#endif
#if MK_ONE_LAUNCH == 2
#ifndef MK_REPEAT
#define MK_REPEAT 0
#endif
#define PH(K) do { if ((MK_PHMASK >> K) & 1) { phase_call_inl(K, l); if ((MK_REPEAT >> K) & 1) { __syncthreads(); phase_call_inl(K, l); } GRID_BAR(); } } while (0)
#else
#define PH(K) do { if ((MK_PHMASK >> K) & 1) { phase_call<K>(l); GRID_BAR(); } } while (0)
#endif
    { const int l = 0; PH(0); PH(19); }
#pragma unroll 1
    for (int l = 0; l < DEPTH; ++l) {
#if MK_ONE_LAUNCH == 2
        PH(1); PH(2); PH(3); PH(4); PH(5); PH(6);
        phase_call_inl(10, l); __syncthreads();
        if ((MK_REPEAT >> 10) & 1) { phase_call_inl(10, l); __syncthreads(); }
        phase_call_inl(7, l); GRID_BAR();
        phase_call_inl(8, l); __syncthreads(); phase_call_inl(11, l); GRID_BAR();
        PH(9); PH(12); PH(13); PH(14); PH(15); PH(16); PH(17);
#else
        PH(1); PH(2); PH(3); PH(4); PH(5); PH(6); PH(7); PH(8); PH(9); PH(10); PH(11); PH(12); PH(13); PH(14); PH(15); PH(16); PH(17);
#endif
#if MK_ONE_LAUNCH == 2
        phase_call_inl(18, l);
#else
        phase_call<18>(l);
#endif
        if (l + 1 < DEPTH) GRID_BAR();
    }
#undef PH
}
#endif

#define MK_PHASES(X) X(0) X(1) X(2) X(3) X(4) X(5) X(6) X(7) X(8) X(9) X(10) X(11) X(12) X(13) X(14) X(15) X(16) X(17) X(18) X(19)
#if !MK_ONE_LAUNCH
static void launch_phase(int k, int grid, hipStream_t stream, const Args& a) {
    switch (k) {
#define X(K) case K: hipLaunchKernelGGL(mk_fwd<K>, dim3(grid), dim3(NTHR), LDS_BYTES, stream, a); break;
        MK_PHASES(X)
#undef X
        default: break;
    }
}
#endif
static bool set_lds_attr() {
    bool ok = true;
#if MK_ONE_LAUNCH
    ok = ok && (hipFuncSetAttribute((const void*)mk_one, hipFuncAttributeMaxDynamicSharedMemorySize, LDS_BYTES) == hipSuccess);
#else
#define X(K) ok = ok && (hipFuncSetAttribute((const void*)mk_fwd<K>, hipFuncAttributeMaxDynamicSharedMemorySize, LDS_BYTES) == hipSuccess);
    MK_PHASES(X)
#undef X
#endif
    return ok;
}
extern "C" void kernel_launch(void* const* d_in, const int* in_sizes, int n_in, void* d_out, int out_size, void* d_ws, size_t ws_size, hipStream_t stream) {
    static int grid = 0;
    if (grid == 0) {
        if (n_in != 24 || out_size != T * D || ws_size < WS_END) { fprintf(stderr, "kernel_launch: unexpected shapes (n_in %d out %d ws %zu)\n", n_in, out_size, ws_size); grid = -1; return; }
        int dev = 0, cus = 0;
        if (hipGetDevice(&dev) != hipSuccess || hipDeviceGetAttribute(&cus, hipDeviceAttributeMultiprocessorCount, dev) != hipSuccess) { grid = -1; return; }
        if (!set_lds_attr()) { fprintf(stderr, "kernel_launch: hipFuncSetAttribute failed\n"); grid = -1; return; }
        int per_cu = 0;
#if MK_ONE_LAUNCH
        if (hipOccupancyMaxActiveBlocksPerMultiprocessor(&per_cu, (const void*)mk_one, NTHR, LDS_BYTES) != hipSuccess || per_cu < 1) { fprintf(stderr, "kernel_launch: occupancy query reports %d\n", per_cu); grid = -1; return; }
#endif
        (void)hipGetLastError();
        grid = cus;
    }
    if (grid < 0) return;
    (void)hipMemsetAsync((char*)d_ws + WS_CTL, 0, CTL_ZERO_BYTES, stream);
    Args a{};
    for (int i = 0; i < 24; ++i) a.in[i] = (const float*)d_in[i];
    a.out = (float*)d_out; a.ws = (unsigned char*)d_ws;
#if MK_ONE_LAUNCH
    hipLaunchKernelGGL(mk_one, dim3(grid), dim3(NTHR), LDS_BYTES, stream, a);
#else
    for (int p = 0; p < DEPTH * NPH; ++p) {
        const int k = p % NPH, l = p / NPH;
        if (k == 0 && l > 0) continue;
        a.l = l;
        launch_phase(k, grid, stream, a);
        if (k == 0) launch_phase(19, grid, stream, a);
    }
#endif
}
```
